# Optimizing an MI355X kernel written in HIP

```python
import math
import jax
import jax.numpy as jnp
from jax import lax
import numpy as np

D_MODEL = 1024
BATCH = 16
SEQ = 4096
DEPTH = 2

GRID_W = 64
CTX_LEN = 256
MIX_W = D_MODEL
HEAD_DIM = 64
ATTN_W = MIX_W // 2
N_ATTN_HEADS = ATTN_W // HEAD_DIM
QK_DIM = HEAD_DIM // 2
CONV_W = MIX_W // 4
CONV_K = 3
POOL_W = MIX_W - ATTN_W - CONV_W
POOL_WINDOWS = (2, 4, 8, 16)
POOL_GC = POOL_W // len(POOL_WINDOWS)
Q_OFF = 0
K_OFF = ATTN_W
V_OFF = 2 * ATTN_W
CB_OFF = 3 * ATTN_W
CC_OFF = CB_OFF + CONV_W
CU_OFF = CC_OFF + CONV_W
POOL_OFF = CU_OFF + CONV_W
IN_W = POOL_OFF + POOL_W
ROPE_BASE = 10000.0
ROPE_PAIRS = QK_DIM // 4
N_EXPERTS = 32
TOP_K = 4
D_FF = D_MODEL
SWIGLU_ALPHA = 1.702
SWIGLU_LIMIT = 7.0
EXPERT_BLOCK = 256
Q_BLOCK = 128
N_MOD = 6
EPS = 1e-6

kernel_name = "hymba_diffattn_conv_pool_moe_dit"


def rms_norm(t, g):
    tf = t.astype(jnp.float32)
    y = tf * lax.rsqrt(jnp.mean(tf * tf, axis=-1, keepdims=True) + EPS)
    return y.astype(t.dtype) * g


def modulate(t, shift, scale):
    return t * (1 + scale) + shift


def split_heads(t, dh):
    b, l, _ = t.shape
    return t.reshape(b, l, -1, dh).transpose(0, 2, 1, 3)


def axial_rope(L):
    rows = L // GRID_W
    row = jnp.broadcast_to(jnp.arange(rows, dtype=jnp.float32)[:, None], (rows, GRID_W)).reshape(L)
    col = jnp.broadcast_to(jnp.arange(GRID_W, dtype=jnp.float32)[None, :], (rows, GRID_W)).reshape(L)
    inv = ROPE_BASE ** (-jnp.arange(ROPE_PAIRS, dtype=jnp.float32) / ROPE_PAIRS)
    ang = jnp.stack([row, col], axis=-1)[..., None] * inv
    return jnp.cos(ang), jnp.sin(ang)


def apply_rope(t, cos, sin):
    ts = t.reshape(*t.shape[:-1], 2, 2, ROPE_PAIRS)
    t1, t2 = ts[..., 0, :], ts[..., 1, :]
    cos = cos.astype(t.dtype)
    sin = sin.astype(t.dtype)
    out = jnp.stack([t1 * cos - t2 * sin, t2 * cos + t1 * sin], axis=-2)
    return out.reshape(t.shape)


def qk_pair(t, g, rope):
    t = split_heads(t, HEAD_DIM)
    t1 = rms_norm(t[..., :QK_DIM], g)
    t2 = rms_norm(t[..., QK_DIM:], g)
    if rope is not None:
        t1 = apply_rope(t1, *rope)
        t2 = apply_rope(t2, *rope)
    return t1, t2


def keys_values(pkv, g, rope):
    k1, k2 = qk_pair(pkv[..., :ATTN_W], g, rope)
    v = split_heads(pkv[..., ATTN_W:], HEAD_DIM)
    return k1, k2, v


def diff_attention(q1, q2, k1, k2, v, lam):
    b, h, lq, dq = q1.shape
    nb = lq // Q_BLOCK
    scale = dq ** -0.5

    def to_blocks(q):
        return jnp.moveaxis(q.reshape(b, h, nb, Q_BLOCK, dq), 2, 0)

    def block(qs):
        a1, a2 = qs
        s1 = jnp.einsum('bhqd,bhkd->bhqk', a1, k1).astype(jnp.float32) * scale
        s2 = jnp.einsum('bhqd,bhkd->bhqk', a2, k2).astype(jnp.float32) * scale
        pmap = jax.nn.softmax(s1, axis=-1) - lam * jax.nn.softmax(s2, axis=-1)
        return jnp.einsum('bhqk,bhkd->bhqd', pmap.astype(v.dtype), v)

    o = lax.map(block, (to_blocks(q1), to_blocks(q2)))
    return jnp.moveaxis(o, 0, 2).reshape(b, h, lq, v.shape[-1])


def short_conv(gate_b, gate_c, u, w):
    z = gate_c * u
    zp = jnp.pad(z, ((0, 0), (1, 1), (0, 0)))
    conv = w[0] * zp[:, :-2] + w[1] * zp[:, 1:-1] + w[2] * zp[:, 2:]
    return gate_b * conv


def multiscale_pool(u, w_pool, scale):
    bn, L, C = u.shape
    cs = jnp.cumsum(u.astype(jnp.float32), axis=1)
    S = jnp.concatenate([jnp.zeros((bn, 1, C), jnp.float32), cs], axis=1)
    t = jnp.arange(L)
    groups = []
    for g, win in enumerate(POOL_WINDOWS):
        half = win // 2
        lo = jnp.clip(t - half, 0, L)
        hi = jnp.clip(t + half, 0, L)
        Sg = S[..., g * POOL_GC:(g + 1) * POOL_GC]
        mean = (Sg[:, hi] - Sg[:, lo]) / (hi - lo).astype(jnp.float32)[:, None]
        groups.append(mean - u[..., g * POOL_GC:(g + 1) * POOL_GC].astype(jnp.float32))
    d = jnp.stack(groups, axis=2).astype(u.dtype)
    y = jnp.einsum('blgc,gcd->blgd', d, w_pool).reshape(bn, L, POOL_W)
    return y * scale


def mix_tokens(p, keys, rope, lam, lam_init, q_g, subln_g, conv_w, pool_w, pool_scale, w_out):
    bn, L, _ = p.shape
    q1, q2 = qk_pair(p[..., Q_OFF:K_OFF], q_g, rope)
    k1, k2, v = keys
    o = diff_attention(q1, q2, k1, k2, v, lam)
    o = rms_norm(o, subln_g) * (1.0 - lam_init)
    o_att = o.transpose(0, 2, 1, 3).reshape(bn, L, ATTN_W)
    o_conv = short_conv(p[..., CB_OFF:CC_OFF], p[..., CC_OFF:CU_OFF], p[..., CU_OFF:POOL_OFF], conv_w)
    o_pool = multiscale_pool(p[..., POOL_OFF:IN_W], pool_w, pool_scale)
    return jnp.concatenate([o_att, o_conv, o_pool], axis=-1) @ w_out


def moe_ffn(h, w_r, b_r, w_gu, b_gu, w_dn, b_dn):
    T, D = h.shape
    logits = (h @ w_r).astype(jnp.float32) + b_r.astype(jnp.float32)
    top_logit, top_e = lax.top_k(logits, TOP_K)
    gate_w = jax.nn.softmax(top_logit, axis=-1)
    n_assign = T * TOP_K
    flat_e = top_e.reshape(-1)
    order = jnp.argsort(flat_e)
    e_sorted = flat_e[order]
    tok_sorted = (order // TOP_K).astype(jnp.int32)
    w_sorted = gate_w.reshape(-1)[order]
    counts = jax.ops.segment_sum(jnp.ones_like(flat_e), flat_e, num_segments=N_EXPERTS)
    padded = (counts + EXPERT_BLOCK - 1) // EXPERT_BLOCK * EXPERT_BLOCK
    pad_end = jnp.cumsum(padded)
    pad_start = pad_end - padded
    start = jnp.cumsum(counts) - counts
    dest = pad_start[e_sorted] + (jnp.arange(n_assign) - start[e_sorted])
    n_blocks = -(-(n_assign + N_EXPERTS * (EXPERT_BLOCK - 1)) // EXPERT_BLOCK)
    n_rows = n_blocks * EXPERT_BLOCK
    row_tok = jnp.full((n_rows,), T, jnp.int32).at[dest].set(tok_sorted)
    row_w = jnp.zeros((n_rows,), jnp.float32).at[dest].set(w_sorted)
    block_e = jnp.minimum(jnp.searchsorted(pad_end, jnp.arange(n_blocks) * EXPERT_BLOCK, side='right'),
                          N_EXPERTS - 1)
    h_pad = jnp.concatenate([h, jnp.zeros((1, D), h.dtype)], axis=0)

    def expert_block(args):
        toks, wts, e = args
        xb = h_pad[toks]
        gu = xb @ w_gu[e] + b_gu[e]
        glu = jnp.minimum(gu[:, :D_FF], SWIGLU_LIMIT)
        lin = jnp.clip(gu[:, D_FF:], -SWIGLU_LIMIT, SWIGLU_LIMIT)
        act = glu * jax.nn.sigmoid(SWIGLU_ALPHA * glu) * (lin + 1)
        y = act @ w_dn[e] + b_dn[e]
        return y * wts[:, None].astype(y.dtype)

    y = lax.map(expert_block, (row_tok.reshape(n_blocks, EXPERT_BLOCK),
                               row_w.reshape(n_blocks, EXPERT_BLOCK), block_e))
    return jax.ops.segment_sum(y.reshape(n_rows, D), row_tok, num_segments=T + 1)[:T]


def setup_inputs(seed: int = 0) -> dict:
    key = jax.random.key(seed)
    ks = jax.random.split(key, 26)
    f32 = jnp.float32

    def nrm(k, shape, s):
        return jax.random.normal(k, shape, f32) * s

    return {
        "x": nrm(ks[0], (BATCH, SEQ, D_MODEL), 1.0),
        "c": nrm(ks[1], (BATCH, D_MODEL), 1.0),
        "ctx": nrm(ks[2], (BATCH, CTX_LEN, D_MODEL), 1.0),
        "c_ctx": nrm(ks[3], (D_MODEL,), 1.0),
        "w_mod": nrm(ks[4], (DEPTH, D_MODEL, N_MOD * D_MODEL), 0.3 * D_MODEL ** -0.5),
        "b_mod": nrm(ks[5], (DEPTH, N_MOD * D_MODEL), 0.02),
        "norm1_g": 1.0 + nrm(ks[6], (DEPTH, D_MODEL), 0.05),
        "norm2_g": 1.0 + nrm(ks[7], (DEPTH, D_MODEL), 0.05),
        "w_in": nrm(ks[8], (DEPTH, D_MODEL, IN_W), D_MODEL ** -0.5),
        "q_norm_g": 1.0 + nrm(ks[9], (DEPTH, QK_DIM), 0.05),
        "k_norm_g": 1.0 + nrm(ks[10], (DEPTH, QK_DIM), 0.05),
        "lambda_q1": nrm(ks[11], (DEPTH, QK_DIM), 0.1),
        "lambda_k1": nrm(ks[12], (DEPTH, QK_DIM), 0.1),
        "lambda_q2": nrm(ks[13], (DEPTH, QK_DIM), 0.1),
        "lambda_k2": nrm(ks[14], (DEPTH, QK_DIM), 0.1),
        "subln_g": 1.0 + nrm(ks[15], (DEPTH, HEAD_DIM), 0.05),
        "conv_w": nrm(ks[16], (DEPTH, CONV_K, CONV_W), CONV_K ** -0.5),
        "pool_w": nrm(ks[17], (DEPTH, len(POOL_WINDOWS), POOL_GC, POOL_GC), POOL_GC ** -0.5),
        "pool_scale": 1.0 + nrm(ks[18], (DEPTH, POOL_W), 0.1),
        "w_out": nrm(ks[19], (DEPTH, MIX_W, D_MODEL), MIX_W ** -0.5),
        "router_w": nrm(ks[20], (DEPTH, D_MODEL, N_EXPERTS), D_MODEL ** -0.5),
        "router_b": nrm(ks[21], (DEPTH, N_EXPERTS), 0.01),
        "w_gate_up": nrm(ks[22], (DEPTH, N_EXPERTS, D_MODEL, 2 * D_FF), D_MODEL ** -0.5),
        "b_gate_up": nrm(ks[23], (DEPTH, N_EXPERTS, 2 * D_FF), 0.02),
        "w_down": nrm(ks[24], (DEPTH, N_EXPERTS, D_FF, D_MODEL), D_FF ** -0.5),
        "b_down": nrm(ks[25], (DEPTH, N_EXPERTS, D_MODEL), 0.02),
    }


def reference(x, c, ctx, c_ctx, w_mod, b_mod, norm1_g, norm2_g, w_in, q_norm_g, k_norm_g,
              lambda_q1, lambda_k1, lambda_q2, lambda_k2, subln_g, conv_w, pool_w, pool_scale, w_out,
              router_w, router_b, w_gate_up, b_gate_up, w_down, b_down):
    B, L, D = x.shape
    rope = axial_rope(L)
    f32 = jnp.float32
    for l in range(DEPTH):
        has_next = l + 1 < DEPTH
        lam_init = 0.8 - 0.6 * math.exp(-0.3 * l)
        lam = (jnp.exp(jnp.sum(lambda_q1[l].astype(f32) * lambda_k1[l].astype(f32)))
               - jnp.exp(jnp.sum(lambda_q2[l].astype(f32) * lambda_k2[l].astype(f32))) + lam_init)
        mod = (jax.nn.silu(c) @ w_mod[l] + b_mod[l]).reshape(B, 1, N_MOD, D)
        mod_c = (jax.nn.silu(c_ctx) @ w_mod[l] + b_mod[l]).reshape(N_MOD, D)

        h = modulate(rms_norm(x, norm1_g[l]), mod[:, :, 0], mod[:, :, 1])
        hc = modulate(rms_norm(ctx, norm1_g[l]), mod_c[0], mod_c[1])
        p = h @ w_in[l]
        if has_next:
            pc = hc @ w_in[l]
            pc_kv = pc[..., K_OFF:CB_OFF]
        else:
            pc_kv = hc @ w_in[l][:, K_OFF:CB_OFF]
        ck1, ck2, cv = keys_values(pc_kv, k_norm_g[l], None)
        k1, k2, v = keys_values(p[..., K_OFF:CB_OFF], k_norm_g[l], rope)
        lat_keys = (jnp.concatenate([ck1, k1], axis=2),
                    jnp.concatenate([ck2, k2], axis=2),
                    jnp.concatenate([cv, v], axis=2))
        layer_w = (q_norm_g[l], subln_g[l], conv_w[l], pool_w[l], pool_scale[l], w_out[l])
        x = x + mod[:, :, 2] * mix_tokens(p, lat_keys, rope, lam, lam_init, *layer_w)
        if has_next:
            ctx = ctx + mod_c[2] * mix_tokens(pc, (ck1, ck2, cv), None, lam, lam_init, *layer_w)

        moe_w = (router_w[l], router_b[l], w_gate_up[l], b_gate_up[l], w_down[l], b_down[l])
        h2 = modulate(rms_norm(x, norm2_g[l]), mod[:, :, 3], mod[:, :, 4])
        if has_next:
            h2c = modulate(rms_norm(ctx, norm2_g[l]), mod_c[3], mod_c[4])
            n_c = h2c.shape[0] * h2c.shape[1]
            y = moe_ffn(jnp.concatenate([h2c.reshape(-1, D), h2.reshape(-1, D)], axis=0), *moe_w)
            ctx = ctx + mod_c[5] * y[:n_c].reshape(ctx.shape)
            x = x + mod[:, :, 5] * y[n_c:].reshape(x.shape)
        else:
            x = x + mod[:, :, 5] * moe_ffn(h2.reshape(-1, D), *moe_w).reshape(x.shape)
    return x
```

```cpp
#include <hip/hip_runtime.h>
#include <cstdio>
#include <cstdint>
#include <cstring>
namespace pg8 {
#define PG8_LAS __attribute__((address_space(3)))
typedef unsigned short bf16_t;
typedef short bf16x8 __attribute__((ext_vector_type(8)));
typedef float f32x4 __attribute__((ext_vector_type(4)));
typedef unsigned u32x4 __attribute__((ext_vector_type(4)));
constexpr int BM = 256, BK = 64, HALF = 128, HTB = HALF * BK * 2  , STAGE_BYTES = 8 * HTB, NXCD = 8, WGM = 8;

__host__ __device__ __forceinline__ int lds_byte(int r, int c) { const int st = (r >> 4) * 2 + (c >> 5), rr = r & 15, cc = c & 31, ob = rr * 64 + cc * 2; return st * 1024 + (ob ^ (((ob >> 9) & 1) << 5)); }
__host__ __device__ __forceinline__ void stage_rc(int b, int& R, int& C) { const int st = b / 1024, sb = b % 1024, swz = sb ^ (((sb >> 9) & 1) << 5); R = (st >> 1) * 16 + swz / 64; C = (st & 1) * 32 + (swz % 64) / 2; }
__host__ __device__ __forceinline__ int perm32(int rho) { const int n = rho >> 4, i = rho & 15; return 8 * (i >> 2) + 4 * n + (i & 3); }

struct Unit { int pm, pn; };
struct Gemm { const bf16_t* A; const bf16_t* Bt; int M, N, K, pad; };

struct StaticOrder {
    int nM, nN, nwg, G, c;
    __host__ __device__ void init(int M, int N, int G_, int c_) { nM = M / BM; nN = N / BM; nwg = nM * nN; G = G_; c = c_; }
    __host__ __device__ bool next(int i, Unit& u) const {
        const long L = (long)i * G + c; if (L >= nwg) return false;
        int wgid = (int)L; { const int q = nwg / NXCD, r = nwg % NXCD, xcd = wgid % NXCD, off = wgid / NXCD; wgid = (xcd < r ? xcd * (q + 1) : r * (q + 1) + (xcd - r) * q) + off; }
        const int nig = WGM * nN, gid = wgid / nig, fm = gid * WGM, gsz = (nM - fm) < WGM ? (nM - fm) : WGM;
        u.pm = fm + ((wgid % nig) % gsz); u.pn = (wgid % nig) / gsz; return true;
    }
    __device__ __forceinline__ int brow(const Unit& u) const { return u.pn * BM; }
    __device__ __forceinline__ void a_ready(const Unit&) const {}
    __device__ __forceinline__ void done(const Unit&) const {}
};

__device__ __forceinline__ unsigned cvt_pk_bf16(float lo, float hi) { unsigned r; asm volatile("v_cvt_pk_bf16_f32 %0, %1, %2" : "=v"(r) : "v"(lo), "v"(hi)); return r; }
typedef float f32x2 __attribute__((ext_vector_type(2)));
template <class Epi, class Sched, bool ALIGN_EPI = false, bool SP2 = false>
__device__ __forceinline__ void gemm_phase(PG8_LAS unsigned char* lds, const Gemm g, const Sched& S, const Epi& E) {
    const int tid = threadIdx.x, wid = __builtin_amdgcn_readfirstlane(tid >> 6), lane = tid & 63, wr = wid >> 2, wc = wid & 3, fr = lane & 15, fq = lane >> 4;
    const int K = g.K, nt = K / BK;
    unsigned voffA[2], voffB[2];
#pragma unroll
    for (int i = 0; i < 2; ++i) { int R, C; stage_rc(tid * 16 + i * 8192, R, C); const int Rb = Epi::PERM ? ((R & ~31) + perm32(R & 31)) : R;
        voffA[i] = (unsigned)(R * K + C) * 2u; voffB[i] = (unsigned)(Rb * K + C) * 2u; }
    const size_t kstep = (size_t)(BK * 2);
    const size_t hstep = (size_t)HALF * K * 2;
    const size_t tstep = 2 * hstep;
    const unsigned ldsw = (unsigned)wid * 1024u;
    const int aoff = lds_byte(wr * 64 + fr, fq * 8), boff = lds_byte(wc * 32 + fr, fq * 8);
#define PG8_SA(b, h) (((b) * 2 + (h)) * HTB)
#define PG8_SB(b, h) ((4 + (b) * 2 + (h)) * HTB)
#define PG8_STAGE(bufoff, gbase, voff) do { _Pragma("unroll") for (int _i = 0; _i < 2; ++_i) \
        __builtin_amdgcn_global_load_lds((const unsigned*)((const char*)(gbase) + (voff)[_i]), (PG8_LAS unsigned*)(lds + (bufoff) + ldsw + _i * 8192), 16, 0, 0); } while (0)
#define PG8_LDA(dst, b, h) do { _Pragma("unroll") for (int m = 0; m < 4; ++m) _Pragma("unroll") for (int k = 0; k < 2; ++k) dst[m][k] = *(const PG8_LAS bf16x8*)(lds + PG8_SA(b, h) + aoff + m * 2048 + k * 1024); } while (0)
#define PG8_LDB(dst, b, h) do { _Pragma("unroll") for (int n = 0; n < 2; ++n) _Pragma("unroll") for (int k = 0; k < 2; ++k) dst[n][k] = *(const PG8_LAS bf16x8*)(lds + PG8_SB(b, h) + boff + n * 2048 + k * 1024); } while (0)
#define PG8_MMA(ai, bj, At, Bt) do { __builtin_amdgcn_s_setprio(1); _Pragma("unroll") for (int m = 0; m < 4; ++m) _Pragma("unroll") for (int n = 0; n < 2; ++n) _Pragma("unroll") for (int k = 0; k < 2; ++k) \
        acc[ai][bj][m][n] = __builtin_amdgcn_mfma_f32_16x16x32_bf16(Bt[n][k], At[m][k], acc[ai][bj][m][n], 0, 0, 0); __builtin_amdgcn_s_setprio(0); } while (0)
#define PG8_WAIT_V(n) asm volatile("s_waitcnt vmcnt(" #n ")" ::: "memory")
#define PG8_WAIT_L(n) asm volatile("s_waitcnt lgkmcnt(" #n ")" ::: "memory")
#define PG8_BAR __builtin_amdgcn_s_barrier()
#define PG8_SCHED __builtin_amdgcn_sched_barrier(0)
    Unit cur, nxt; int ui = 0;
    if (!S.next(0, cur)) return;
    f32x4 acc[2][2][4][2];
#pragma unroll
    for (int a = 0; a < 2; ++a)
#pragma unroll
        for (int b = 0; b < 2; ++b)
#pragma unroll
            for (int m = 0; m < 4; ++m)
#pragma unroll
                for (int n = 0; n < 2; ++n) acc[a][b][m][n] = (f32x4){0.f, 0.f, 0.f, 0.f};
    bf16x8 At[4][2], B0[2][2], B1[2][2];
    const char* cA = (const char*)g.A + (size_t)cur.pm * tstep; const char* cB = (const char*)g.Bt + (size_t)S.brow(cur) * (size_t)K * 2;
    S.a_ready(cur);
    if constexpr (SP2) {
        PG8_STAGE(PG8_SB(0, 0), cB, voffB); PG8_STAGE(PG8_SB(0, 1), cB + hstep, voffB); PG8_STAGE(PG8_SA(0, 0), cA, voffA); PG8_STAGE(PG8_SA(0, 1), cA + hstep, voffA);
        if (wr == 1) PG8_BAR;
        PG8_WAIT_V(2); PG8_BAR;
        PG8_STAGE(PG8_SB(1, 0), cB + kstep, voffB); PG8_STAGE(PG8_SA(1, 0), cA + kstep, voffA); PG8_STAGE(PG8_SB(1, 1), cB + hstep + kstep, voffB);
        PG8_WAIT_V(6); PG8_BAR;
    } else {
        PG8_STAGE(PG8_SB(0, 0), cB, voffB); PG8_STAGE(PG8_SA(0, 0), cA, voffA); PG8_STAGE(PG8_SB(0, 1), cB + hstep, voffB); PG8_STAGE(PG8_SA(0, 1), cA + hstep, voffA);
        if (wr == 1) PG8_BAR;
        PG8_WAIT_V(4); PG8_BAR;
        PG8_STAGE(PG8_SB(1, 0), cB + kstep, voffB); PG8_STAGE(PG8_SA(1, 0), cA + kstep, voffA); PG8_STAGE(PG8_SB(1, 1), cB + hstep + kstep, voffB);
        PG8_WAIT_V(6); PG8_BAR;
    }
    for (;;) {
        const bool has_next = S.next(ui + 1, nxt);
        const char* nA = has_next ? (const char*)g.A + (size_t)nxt.pm * tstep : cA; const char* nB = has_next ? (const char*)g.Bt + (size_t)S.brow(nxt) * (size_t)K * 2 : cB;
        for (int t = 0; t < nt; t += 2) {
            const bool last = (t == nt - 2);
            const char* a1 = cA + (size_t)(t + 1) * kstep;
            const char* a2 = last ? nA : cA + (size_t)(t + 2) * kstep; const char* b2 = last ? nB : cB + (size_t)(t + 2) * kstep;
            const char* a3 = a2 + kstep; const char* b3 = b2 + kstep;
            if (last && has_next) S.a_ready(nxt);
            if constexpr (SP2) {
            PG8_LDB(B0, 0, 0); PG8_LDB(B1, 0, 1); PG8_SCHED; PG8_LDA(At, 0, 0); PG8_STAGE(PG8_SA(1, 1), a1 + hstep, voffA);
            PG8_WAIT_V(8); PG8_WAIT_L(0); PG8_BAR; PG8_MMA(0, 0, At, B0); PG8_MMA(0, 1, At, B1); PG8_BAR; PG8_SCHED;
            PG8_LDA(At, 0, 1); PG8_STAGE(PG8_SB(0, 0), b2, voffB); PG8_STAGE(PG8_SB(0, 1), b2 + hstep, voffB); PG8_STAGE(PG8_SA(0, 0), a2, voffA);
            PG8_WAIT_V(8); PG8_WAIT_L(0); PG8_BAR; PG8_MMA(1, 0, At, B0); PG8_MMA(1, 1, At, B1); PG8_BAR; PG8_SCHED;
            PG8_LDB(B0, 1, 0); PG8_LDB(B1, 1, 1); PG8_SCHED; PG8_LDA(At, 1, 0); PG8_STAGE(PG8_SA(0, 1), a2 + hstep, voffA);
            PG8_WAIT_V(8); PG8_WAIT_L(0); PG8_BAR; PG8_MMA(0, 0, At, B0); PG8_MMA(0, 1, At, B1); PG8_BAR; PG8_SCHED;
            PG8_LDA(At, 1, 1); PG8_STAGE(PG8_SB(1, 0), b3, voffB); PG8_STAGE(PG8_SB(1, 1), b3 + hstep, voffB); PG8_STAGE(PG8_SA(1, 0), a3, voffA);
            PG8_WAIT_V(8); PG8_WAIT_L(0); PG8_BAR; PG8_MMA(1, 0, At, B0); PG8_MMA(1, 1, At, B1); PG8_BAR; PG8_SCHED;
            } else {
            PG8_LDB(B0, 0, 0); PG8_SCHED; PG8_LDA(At, 0, 0); PG8_STAGE(PG8_SA(1, 1), a1 + hstep, voffA);
            PG8_WAIT_L(8); PG8_BAR; PG8_WAIT_L(0); PG8_MMA(0, 0, At, B0); PG8_BAR; PG8_SCHED;
            PG8_LDB(B1, 0, 1); PG8_STAGE(PG8_SB(0, 0), b2, voffB);
            PG8_BAR; PG8_WAIT_L(0); PG8_MMA(0, 1, At, B1); PG8_BAR;
            PG8_LDA(At, 0, 1); PG8_STAGE(PG8_SA(0, 0), a2, voffA);
            PG8_BAR; PG8_WAIT_L(0); PG8_MMA(1, 0, At, B0); PG8_BAR; PG8_SCHED;
            PG8_STAGE(PG8_SB(0, 1), b2 + hstep, voffB);
            PG8_WAIT_V(6); PG8_BAR; PG8_MMA(1, 1, At, B1); PG8_BAR;
            PG8_LDB(B0, 1, 0); PG8_SCHED; PG8_LDA(At, 1, 0); PG8_STAGE(PG8_SA(0, 1), a2 + hstep, voffA);
            PG8_WAIT_L(8); PG8_BAR; PG8_WAIT_L(0); PG8_MMA(0, 0, At, B0); PG8_BAR; PG8_SCHED;
            PG8_LDB(B1, 1, 1); PG8_STAGE(PG8_SB(1, 0), b3, voffB);
            PG8_BAR; PG8_WAIT_L(0); PG8_MMA(0, 1, At, B1); PG8_BAR;
            PG8_LDA(At, 1, 1); PG8_STAGE(PG8_SA(1, 0), a3, voffA);
            PG8_BAR; PG8_WAIT_L(0); PG8_MMA(1, 0, At, B0); PG8_BAR; PG8_SCHED;
            PG8_STAGE(PG8_SB(1, 1), b3 + hstep, voffB);
            PG8_WAIT_V(6); PG8_BAR; PG8_MMA(1, 1, At, B1); PG8_BAR;
            }
        }
        if constexpr (ALIGN_EPI) { if (wr == 0) PG8_BAR; }
        if constexpr (!Epi::AFTER_DRAIN) { E(acc, cur, wr, wc, fr, fq); S.done(cur); }
        if (!has_next) break;
#pragma unroll
        for (int a = 0; a < 2; ++a)
#pragma unroll
            for (int b = 0; b < 2; ++b)
#pragma unroll
                for (int m = 0; m < 4; ++m)
#pragma unroll
                    for (int n = 0; n < 2; ++n) acc[a][b][m][n] = (f32x4){0.f, 0.f, 0.f, 0.f};
        cur = nxt; cA = nA; cB = nB; ++ui;
        if constexpr (ALIGN_EPI) { if (wr == 1) PG8_BAR; }
    }
    PG8_WAIT_V(0);
    if constexpr (!ALIGN_EPI) { if (wr == 0) PG8_BAR; }
    PG8_BAR;
    if constexpr (Epi::AFTER_DRAIN) { E.fused(acc, cur, wr, wc, fr, fq, lds, wid, lane); S.done(cur); }
#undef PG8_SA
#undef PG8_SB
#undef PG8_STAGE
#undef PG8_LDA
#undef PG8_LDB
#undef PG8_MMA
#undef PG8_WAIT_V
#undef PG8_WAIT_L
#undef PG8_BAR
#undef PG8_SCHED
}
}


constexpr int NB = 16, SEQ = 4096, DM = 1024, CTXL = 256, DEPTH = 2, INW = 2560, NEXP = 32, TOPK = 4;
constexpr int TL = NB * SEQ, TC = NB * CTXL, TT = TL + TC;
constexpr int NH = 8, NKEY = SEQ + CTXL;
constexpr int MAXBLK = 1120;
constexpr int NMOD = 6;
constexpr float EPS = 1e-6f;
constexpr float SM_SCALE = 0.17677669529663687f;

typedef unsigned short bf16;
typedef float f32x4 __attribute__((ext_vector_type(4)));
typedef unsigned u32x4 __attribute__((ext_vector_type(4)));
typedef unsigned u32x2 __attribute__((ext_vector_type(2)));

constexpr size_t MiB = 1u << 20;
constexpr size_t WS_CTL = 0, WS_MOD = 1 * MiB, WS_ROPE = 2 * MiB, WS_SCAL = 3 * MiB, WS_WIN = 4 * MiB, WS_WOUT = 14 * MiB, WS_WGU = 18 * MiB, WS_WDN = 274 * MiB;
constexpr size_t WS_H = 402 * MiB, WS_X1 = 538 * MiB, WS_X2C = 810 * MiB, WS_TOK = 826 * MiB, WS_RA = 858 * MiB, WS_RB = 1418 * MiB, WS_END = 1978 * MiB;
constexpr size_t TOK_TE = 0, TOK_TW = 2 * MiB, TOK_SLOTOF = 4 * MiB, TOK_ROWTOK = 6 * MiB, TOK_ROWW = 8 * MiB, TOK_LOGITS = 10 * MiB;
constexpr size_t RA_P = 0, RA_MIX = 340 * MiB;
constexpr size_t RB_Q = 0, RB_QC = 128 * MiB, RB_K = 136 * MiB, RB_V = 272 * MiB, RB_D = 408 * MiB;
constexpr int CTL_LSTRIDE = 4096, CTL_CNT = 0, CTL_CUR = 32, CTL_PADSTART = 64, CTL_NBLK = 96, CTL_BLKE = 128;

__device__ __forceinline__ unsigned f2bf(float f) { unsigned u = __builtin_bit_cast(unsigned, f); return (u + 0x7fffu + ((u >> 16) & 1u)) >> 16; }
__device__ __forceinline__ float bf2f(unsigned short b) { return __builtin_bit_cast(float, ((unsigned)b) << 16); }
__device__ __forceinline__ float wave_sum(float v) {
#pragma unroll
    for (int o = 1; o < 64; o <<= 1) v += __shfl_xor(v, o);
    return v;
}

struct GroupedOrder {
    const int* ctl; int nN, Nper, G, c, nblk, pad;
    __device__ __forceinline__ void begin(int G_, int c_) { G = G_; c = c_; nblk = ctl[CTL_NBLK]; }
    __device__ __forceinline__ bool next(int i, pg8::Unit& u) const {
        const int xcd = c & 7, j = c >> 3, per = G / nN;
        u.pn = j % nN; u.pm = i * per + (j / nN) * 8 + xcd; return u.pm < nblk;
    }
    __device__ __forceinline__ int brow(const pg8::Unit& u) const { return ctl[CTL_BLKE + u.pm] * Nper + u.pn * 256; }
    __device__ __forceinline__ void a_ready(const pg8::Unit&) const {}
    __device__ __forceinline__ void done(const pg8::Unit&) const {}
};
struct PlainOrder : pg8::StaticOrder {
    int M, N;
    __device__ __forceinline__ void begin(int G_, int c_) { init(M, N, G_, c_); }
};


struct EpiPlainBf16 {
    static constexpr bool PERM = true, AFTER_DRAIN = false;
    bf16* O; long ldc;
    __device__ __forceinline__ void operator()(const f32x4 (&acc)[2][2][4][2], const pg8::Unit& u, int wr, int wc, int fr, int fq) const {
        const int row0 = u.pm * 256 + wr * 64 + fr, col0 = u.pn * 256 + wc * 32 + 8 * fq;
#pragma unroll
        for (int ai = 0; ai < 2; ++ai)
#pragma unroll
            for (int m = 0; m < 4; ++m) { bf16* rowp = O + (size_t)(row0 + ai * 128 + m * 16) * ldc + col0;
#pragma unroll
                for (int bj = 0; bj < 2; ++bj) { const f32x4 v0 = acc[ai][bj][m][0], v1 = acc[ai][bj][m][1];
                    u32x4 w; w.x = pg8::cvt_pk_bf16(v0[0], v0[1]); w.y = pg8::cvt_pk_bf16(v0[2], v0[3]); w.z = pg8::cvt_pk_bf16(v1[0], v1[1]); w.w = pg8::cvt_pk_bf16(v1[2], v1[3]);
                    *(u32x4*)(rowp + bj * 128) = w; } }
    }
};
struct EpiResid {
    static constexpr bool PERM = false, AFTER_DRAIN = false;
    const float* xl; const float* xc; const float* gate  ; float* out;
    __device__ __forceinline__ void operator()(const f32x4 (&acc)[2][2][4][2], const pg8::Unit& u, int wr, int wc, int fr, int fq) const {
        const int row0 = u.pm * 256 + wr * 64 + fr, col0 = u.pn * 256 + wc * 32 + 4 * fq;
#pragma unroll
        for (int ai = 0; ai < 2; ++ai)
#pragma unroll
            for (int m = 0; m < 4; ++m) {
                const int row = row0 + ai * 128 + m * 16;
                const int b = row < TL ? (row >> 12) : 16;
                const float* bp = (row < TL ? xl + (size_t)row * DM : xc + (size_t)(row - TL) * DM) + col0;
                const float* gp = gate + (size_t)b * (NMOD * DM) + col0;
                float* op = out + (size_t)row * DM + col0;
#pragma unroll
                for (int bj = 0; bj < 2; ++bj)
#pragma unroll
                    for (int n = 0; n < 2; ++n) {
                        const f32x4 bs = *(const f32x4*)(bp + bj * 128 + n * 16), gv = *(const f32x4*)(gp + bj * 128 + n * 16);
                        *(f32x4*)(op + bj * 128 + n * 16) = bs + gv * acc[ai][bj][m][n];
                    }
            }
    }
};
struct EpiSwiglu {
    static constexpr bool PERM = true, AFTER_DRAIN = false;
    const int* ctl; const float* bias  ; bf16* act;
    __device__ __forceinline__ void operator()(const f32x4 (&acc)[2][2][4][2], const pg8::Unit& u, int wr, int wc, int fr, int fq) const {
        const int e = ctl[CTL_BLKE + u.pm];
        const int row0 = u.pm * 256 + wr * 64 + fr, cl = u.pn * 128 + wc * 32 + 8 * fq;
        const float* bg = bias + (size_t)e * 2048 + cl;
        f32x4 bgl[2], bli[2];
#pragma unroll
        for (int n = 0; n < 2; ++n) { bgl[n] = *(const f32x4*)(bg + 4 * n); bli[n] = *(const f32x4*)(bg + 1024 + 4 * n); }
#pragma unroll
        for (int ai = 0; ai < 2; ++ai)
#pragma unroll
            for (int m = 0; m < 4; ++m) {
                const int row = row0 + ai * 128 + m * 16;
                float r[8];
#pragma unroll
                for (int n = 0; n < 2; ++n)
#pragma unroll
                    for (int j = 0; j < 4; ++j) {
                        float g = acc[ai][0][m][n][j] + bgl[n][j], li = acc[ai][1][m][n][j] + bli[n][j];
                        g = fminf(g, 7.0f); li = fminf(fmaxf(li, -7.0f), 7.0f);
                        const float sg = 1.0f / (1.0f + __expf(-1.702f * g));
                        r[4 * n + j] = g * sg * (li + 1.0f);
                    }
                u32x4 w; w.x = pg8::cvt_pk_bf16(r[0], r[1]); w.y = pg8::cvt_pk_bf16(r[2], r[3]); w.z = pg8::cvt_pk_bf16(r[4], r[5]); w.w = pg8::cvt_pk_bf16(r[6], r[7]);
                *(u32x4*)(act + (size_t)row * 1024 + cl) = w;
            }
    }
};
struct EpiDown {
    static constexpr bool PERM = true, AFTER_DRAIN = false;
    const int* ctl; const float* bias  ; const float* row_w; bf16* Y;
    __device__ __forceinline__ void operator()(const f32x4 (&acc)[2][2][4][2], const pg8::Unit& u, int wr, int wc, int fr, int fq) const {
        const int e = ctl[CTL_BLKE + u.pm];
        const int row0 = u.pm * 256 + wr * 64 + fr, col0 = u.pn * 256 + wc * 32 + 8 * fq;
        const float* bp = bias + (size_t)e * 1024 + col0;
        f32x4 bv[2][2];
#pragma unroll
        for (int bj = 0; bj < 2; ++bj)
#pragma unroll
            for (int n = 0; n < 2; ++n) bv[bj][n] = *(const f32x4*)(bp + bj * 128 + 4 * n);
#pragma unroll
        for (int ai = 0; ai < 2; ++ai)
#pragma unroll
            for (int m = 0; m < 4; ++m) {
                const int row = row0 + ai * 128 + m * 16; const float w = row_w[row];
#pragma unroll
                for (int bj = 0; bj < 2; ++bj) {
                    const f32x4 v0 = (acc[ai][bj][m][0] + bv[bj][0]) * w, v1 = (acc[ai][bj][m][1] + bv[bj][1]) * w;
                    u32x4 o; o.x = pg8::cvt_pk_bf16(v0[0], v0[1]); o.y = pg8::cvt_pk_bf16(v0[2], v0[3]); o.z = pg8::cvt_pk_bf16(v1[0], v1[1]); o.w = pg8::cvt_pk_bf16(v1[2], v1[3]);
                    *(u32x4*)(Y + (size_t)row * 1024 + col0 + bj * 128) = o;
                }
            }
    }
};

template <class Epi, class Sched>
__global__ void __launch_bounds__(512, 2) k_gemm(pg8::Gemm g, Sched S0, Epi E) {
    extern __shared__ __attribute__((aligned(16))) unsigned char lds[];
    Sched S = S0; S.begin((int)gridDim.x, (int)blockIdx.x);
    pg8::gemm_phase<Epi, Sched, true, true>((PG8_LAS unsigned char*)lds, g, S, E);
}

__global__ void __launch_bounds__(512) k_mod(const float* __restrict__ c, const float* __restrict__ c_ctx, const float* __restrict__ w_mod, const float* __restrict__ b_mod, float* __restrict__ mod) {
    __shared__ float red[8][17][64];
    const int l = blockIdx.x / 96, nb = blockIdx.x % 96, lane = threadIdx.x & 63, w = threadIdx.x >> 6, n = nb * 64 + lane;
    float acc[17];
#pragma unroll
    for (int r = 0; r < 17; ++r) acc[r] = 0.f;
    const float* W = w_mod + (size_t)l * DM * (NMOD * DM);
    for (int k = w * 128; k < w * 128 + 128; ++k) {
        const float wv = W[(size_t)k * (NMOD * DM) + n];
#pragma unroll
        for (int r = 0; r < 17; ++r) { const float cv = r < 16 ? c[r * DM + k] : c_ctx[k]; acc[r] += (cv / (1.0f + expf(-cv))) * wv; }
    }
#pragma unroll
    for (int r = 0; r < 17; ++r) red[w][r][lane] = acc[r];
    __syncthreads();
    for (int idx = threadIdx.x; idx < 17 * 64; idx += 512) {
        const int r = idx >> 6, ln = idx & 63; float s = 0.f;
#pragma unroll
        for (int ww = 0; ww < 8; ++ww) s += red[ww][r][ln];
        mod[((size_t)l * 17 + r) * (NMOD * DM) + nb * 64 + ln] = s + b_mod[l * (NMOD * DM) + nb * 64 + ln];
    }
}
__global__ void k_misc(float2* __restrict__ rope, float* __restrict__ scal, const float* lq1, const float* lk1, const float* lq2, const float* lk2) {
    const int i = blockIdx.x * blockDim.x + threadIdx.x;
    if (i < SEQ * 16) {
        const int l = i >> 4, axis = (i >> 3) & 1, pair = i & 7;
        const float pos = axis == 0 ? (float)(l / 64) : (float)(l % 64);
        const float inv = powf(10000.0f, -(float)pair / 8.0f);
        const float ang = pos * inv;
        rope[i] = make_float2(cosf(ang), sinf(ang));
    }
    if (i < DEPTH) {
        float s1 = 0.f, s2 = 0.f;
        for (int d = 0; d < 32; ++d) { s1 += lq1[i * 32 + d] * lk1[i * 32 + d]; s2 += lq2[i * 32 + d] * lk2[i * 32 + d]; }
        const float lam_init = 0.8f - 0.6f * expf(-0.3f * (float)i);
        scal[i * 2 + 0] = expf(s1) - expf(s2) + lam_init;
        scal[i * 2 + 1] = lam_init;
    }
}
__global__ void __launch_bounds__(256) k_transpose(const float* __restrict__ src, bf16* __restrict__ dst, int K, int N, int mode, size_t mstride) {
    __shared__ float t[64][65];
    src += (size_t)blockIdx.z * mstride; dst += (size_t)blockIdx.z * mstride;
    const int k0 = blockIdx.y * 64, n0 = blockIdx.x * 64, tx = threadIdx.x & 63, ty = threadIdx.x >> 6;
    for (int i = ty; i < 64; i += 4) t[i][tx] = src[(size_t)(k0 + i) * N + n0 + tx];
    __syncthreads();
    for (int i = ty; i < 64; i += 4) {
        const int n = n0 + i; int np = n;
        if (mode == 1) np = ((n & 1023) >> 7) * 256 + (n >> 10) * 128 + (n & 127);
        dst[(size_t)np * K + k0 + tx] = (bf16)f2bf(t[tx][i]);
    }
}
__global__ void __launch_bounds__(256) k_norm(const float* __restrict__ xl, const float* __restrict__ xc, const float* __restrict__ g, const float* __restrict__ modl, int ishift, int iscale,
                                              bf16* __restrict__ h, float* __restrict__ hf) {
    const int row = blockIdx.x * 4 + (threadIdx.x >> 6), lane = threadIdx.x & 63;
    const float* src = row < TL ? xl + (size_t)row * DM : xc + (size_t)(row - TL) * DM;
    const int b = row < TL ? (row >> 12) : 16;
    const float* sh = modl + (size_t)b * (NMOD * DM) + ishift * DM; const float* sc = modl + (size_t)b * (NMOD * DM) + iscale * DM;
    f32x4 v[4]; float ss = 0.f;
#pragma unroll
    for (int j = 0; j < 4; ++j) { v[j] = *(const f32x4*)(src + (lane + 64 * j) * 4); ss += (v[j].x * v[j].x + v[j].y * v[j].y) + (v[j].z * v[j].z + v[j].w * v[j].w); }
    const float rstd = 1.0f / sqrtf(wave_sum(ss) * (1.0f / DM) + EPS);
#pragma unroll
    for (int j = 0; j < 4; ++j) {
        const int col = (lane + 64 * j) * 4;
        const f32x4 gv = *(const f32x4*)(g + col), shv = *(const f32x4*)(sh + col), scv = *(const f32x4*)(sc + col);
        const f32x4 y = (v[j] * rstd) * gv * (scv + 1.0f) + shv;
        u32x2 o; o.x = f2bf(y.x) | (f2bf(y.y) << 16); o.y = f2bf(y.z) | (f2bf(y.w) << 16);
        *(u32x2*)(h + (size_t)row * DM + col) = o;
        if (hf) *(f32x4*)(hf + (size_t)row * DM + col) = y;
    }
}
__global__ void __launch_bounds__(256) k_qkv_post(const bf16* __restrict__ P, const float* __restrict__ qg, const float* __restrict__ kg, const float2* __restrict__ rope,
                                                  float* __restrict__ Qf, float* __restrict__ Qc, float* __restrict__ Kf, float* __restrict__ Vf) {
    const long idx = (long)blockIdx.x * 256 + threadIdx.x;
    if (idx >= (long)TT * NH * 5) return;
    const int comp = (int)(idx % 5), hh = (int)((idx / 5) % NH), row = (int)(idx / (5 * NH));
    const bool lat = row < TL; const int b = lat ? (row >> 12) : ((row - TL) >> 8), pos = lat ? (row & 4095) : ((row - TL) & 255);
    const int key = lat ? CTXL + pos : pos;
    const bf16* prow = P + (size_t)row * INW;
    if (comp == 4) {
        float* dst = Vf + ((size_t)(b * NH + hh) * NKEY + key) * 64;
        for (int d = 0; d < 64; ++d) dst[d] = bf2f(prow[1024 + hh * 64 + d]);
        return;
    }
    const int col0 = (comp < 2 ? 0 : 512) + hh * 64 + (comp & 1) * 32;
    const float* g = comp < 2 ? qg : kg;
    float v[32]; float ss = 0.f;
#pragma unroll
    for (int d = 0; d < 32; ++d) { v[d] = bf2f(prow[col0 + d]); ss += v[d] * v[d]; }
    const float r = 1.0f / sqrtf(ss * (1.0f / 32.0f) + EPS);
#pragma unroll
    for (int d = 0; d < 32; ++d) v[d] = v[d] * r * g[d];
    if (lat) {
#pragma unroll
        for (int axis = 0; axis < 2; ++axis)
#pragma unroll
            for (int pr = 0; pr < 8; ++pr) {
                const float2 cs = rope[pos * 16 + axis * 8 + pr];
                const float a = v[axis * 16 + pr], bb = v[axis * 16 + 8 + pr];
                v[axis * 16 + pr] = a * cs.x - bb * cs.y; v[axis * 16 + 8 + pr] = bb * cs.x + a * cs.y;
            }
    }
    float* dst;
    if (comp < 2) dst = lat ? Qf + ((size_t)(b * NH + hh) * SEQ + pos) * 64 + (comp & 1) * 32 : Qc + ((size_t)(b * NH + hh) * CTXL + pos) * 64 + (comp & 1) * 32;
    else dst = Kf + ((size_t)(b * NH + hh) * NKEY + key) * 64 + (comp & 1) * 32;
#pragma unroll
    for (int d = 0; d < 32; ++d) dst[d] = v[d];
}
__global__ void __launch_bounds__(256) k_attn_naive(const float* __restrict__ Q, const float* __restrict__ K, const float* __restrict__ V, int nq, int nk, const float* __restrict__ scal,
                                                    const float* __restrict__ subg, bf16* __restrict__ mix, int row_base, int rows_per_b) {
    __shared__ float Kt[32][64]; __shared__ float Vt[32][64];
    const int bh = blockIdx.y, b = bh / NH, hh = bh % NH, qi = blockIdx.x * 256 + threadIdx.x;
    const float lam = scal[0], lam_init = scal[1];
    float q[64], a1[64], a2[64]; float l1 = 0.f, l2 = 0.f;
    const float* qp = Q + ((size_t)bh * nq + qi) * 64;
#pragma unroll
    for (int d = 0; d < 64; ++d) { q[d] = qp[d] * SM_SCALE; a1[d] = 0.f; a2[d] = 0.f; }
    const float* Kb = K + (size_t)bh * NKEY * 64; const float* Vb = V + (size_t)bh * NKEY * 64;
    for (int k0 = 0; k0 < nk; k0 += 32) {
        __syncthreads();
        for (int i = threadIdx.x; i < 512; i += 256) { ((f32x4*)&Kt[0][0])[i] = ((const f32x4*)(Kb + (size_t)k0 * 64))[i]; ((f32x4*)&Vt[0][0])[i] = ((const f32x4*)(Vb + (size_t)k0 * 64))[i]; }
        __syncthreads();
        for (int kk = 0; kk < 32; ++kk) {
            float s1 = 0.f, s2 = 0.f;
#pragma unroll
            for (int d = 0; d < 32; ++d) { s1 += q[d] * Kt[kk][d]; s2 += q[32 + d] * Kt[kk][32 + d]; }
            const float p1 = expf(s1 - 8.0f), p2 = expf(s2 - 8.0f);
            l1 += p1; l2 += p2;
#pragma unroll
            for (int d = 0; d < 64; ++d) { const float vv = Vt[kk][d]; a1[d] += p1 * vv; a2[d] += p2 * vv; }
        }
    }
    const float i1 = 1.0f / l1, i2 = lam / l2; float ss = 0.f;
#pragma unroll
    for (int d = 0; d < 64; ++d) { a1[d] = a1[d] * i1 - a2[d] * i2; ss += a1[d] * a1[d]; }
    const float r = (1.0f / sqrtf(ss * (1.0f / 64.0f) + EPS)) * (1.0f - lam_init);
    bf16* op = mix + (size_t)(row_base + b * rows_per_b + qi) * DM + hh * 64;
#pragma unroll
    for (int d = 0; d < 64; ++d) op[d] = (bf16)f2bf(a1[d] * r * subg[d]);
}
__global__ void __launch_bounds__(256) k_convpool(const bf16* __restrict__ P, const float* __restrict__ convw, bf16* __restrict__ mix, float* __restrict__ dbuf) {
    const long idx = (long)blockIdx.x * 256 + threadIdx.x;
    const int ch = (int)(idx & 511), row = (int)(idx >> 9);
    if (row >= TT) return;
    const bool lat = row < TL; const int pos = lat ? (row & 4095) : ((row - TL) & 255), len = lat ? SEQ : CTXL;
    const bf16* prow = P + (size_t)row * INW;
    if (ch < 256) {
        const float zc = bf2f(prow[1792 + ch]) * bf2f(prow[2048 + ch]);
        const float zm = pos > 0 ? bf2f(prow[-INW + 1792 + ch]) * bf2f(prow[-INW + 2048 + ch]) : 0.f;
        const float zp = pos < len - 1 ? bf2f(prow[INW + 1792 + ch]) * bf2f(prow[INW + 2048 + ch]) : 0.f;
        const float cv = convw[ch] * zm + convw[256 + ch] * zc + convw[512 + ch] * zp;
        mix[(size_t)row * DM + 512 + ch] = (bf16)f2bf(bf2f(prow[1536 + ch]) * cv);
    } else {
        const int pc = ch - 256, gi = pc >> 6, half = 1 << gi;
        const int lo = max(pos - half, 0), hi = min(pos + half, len);
        float s = 0.f;
        for (int j = lo; j < hi; ++j) s += bf2f(prow[(long)(j - pos) * INW + 2304 + pc]);
        dbuf[(size_t)row * 256 + pc] = s / (float)(hi - lo) - bf2f(prow[2304 + pc]);
    }
}
__global__ void __launch_bounds__(256) k_pool_mix(const float* __restrict__ dbuf, const float* __restrict__ wpool, const float* __restrict__ pscale, bf16* __restrict__ mix) {
    const int row = blockIdx.x, o = threadIdx.x, gi = o >> 6, dd = o & 63;
    const float* dp = dbuf + (size_t)row * 256 + gi * 64; const float* wp = wpool + (size_t)gi * 4096 + dd;
    float s = 0.f;
    for (int c = 0; c < 64; ++c) s += dp[c] * wp[c * 64];
    mix[(size_t)row * DM + 768 + o] = (bf16)f2bf(s * pscale[o]);
}
__global__ void __launch_bounds__(256) k_router(const float* __restrict__ hf, const float* __restrict__ wr, const float* __restrict__ br, float* __restrict__ logits, int row0) {
    const int tok = row0 + blockIdx.x * 8 + (threadIdx.x >> 5), e = threadIdx.x & 31;
    const float* hp = hf + (size_t)tok * DM; float s = 0.f;
    for (int k = 0; k < DM; ++k) s += hp[k] * wr[k * NEXP + e];
    logits[(size_t)tok * NEXP + e] = s + br[e];
}
__global__ void __launch_bounds__(256) k_topk(const float* __restrict__ logits, int row0, int nrows, int* __restrict__ te, float* __restrict__ tw, int* __restrict__ ctl) {
    const int i = blockIdx.x * 256 + threadIdx.x; if (i >= nrows) return; const int tok = row0 + i;
    float v[32];
#pragma unroll
    for (int e = 0; e < 32; ++e) v[e] = logits[(size_t)tok * NEXP + e];
    int be[4]; float bv[4];
#pragma unroll
    for (int k = 0; k < 4; ++k) {
        float m = -3.0e38f; int mi = 0;
#pragma unroll
        for (int e = 0; e < 32; ++e) { if (v[e] > m) { m = v[e]; mi = e; } }
        be[k] = mi; bv[k] = m;
#pragma unroll
        for (int e = 0; e < 32; ++e) if (e == mi) v[e] = -3.0e38f;
    }
    float s = 0.f, p[4];
#pragma unroll
    for (int k = 0; k < 4; ++k) { p[k] = expf(bv[k] - bv[0]); s += p[k]; }
#pragma unroll
    for (int k = 0; k < 4; ++k) { te[(size_t)tok * 4 + k] = be[k]; tw[(size_t)tok * 4 + k] = p[k] / s; atomicAdd(&ctl[CTL_CNT + be[k]], 1); }
}
__global__ void k_offsets(int* __restrict__ ctl) {
    if (threadIdx.x != 0 || blockIdx.x != 0) return;
    int blk = 0;
    for (int e = 0; e < NEXP; ++e) {
        const int n = ctl[CTL_CNT + e], nb = (n + 255) / 256;
        ctl[CTL_PADSTART + e] = blk * 256;
        for (int j = 0; j < nb; ++j) ctl[CTL_BLKE + blk + j] = e;
        blk += nb;
    }
    ctl[CTL_NBLK] = blk;
}
__global__ void __launch_bounds__(256) k_assign(const int* __restrict__ te, const float* __restrict__ tw, int row0, int nrows, int* __restrict__ ctl, int* __restrict__ row_tok, float* __restrict__ row_w, int* __restrict__ slot_of) {
    const int i = blockIdx.x * 256 + threadIdx.x; if (i >= nrows * 4) return;
    const int tok = row0 + (i >> 2), k = i & 3; const int e = te[(size_t)tok * 4 + k];
    const int pos = atomicAdd(&ctl[CTL_CUR + e], 1), slot = ctl[CTL_PADSTART + e] + pos;
    row_tok[slot] = tok; row_w[slot] = tw[(size_t)tok * 4 + k]; slot_of[(size_t)tok * 4 + k] = slot;
}
__global__ void __launch_bounds__(256) k_gather(const bf16* __restrict__ h2, const int* __restrict__ row_tok, const int* __restrict__ ctl, bf16* __restrict__ xs) {
    const int slot = blockIdx.x * 4 + (threadIdx.x >> 6), lane = threadIdx.x & 63;
    if (slot >= ctl[CTL_NBLK] * 256) return;
    const u32x4* s = (const u32x4*)(h2 + (size_t)row_tok[slot] * DM); u32x4* d = (u32x4*)(xs + (size_t)slot * DM);
    d[lane] = s[lane]; d[lane + 64] = s[lane + 64];
}
__global__ void __launch_bounds__(256) k_combine(const float* __restrict__ x1, const bf16* __restrict__ Y, const int* __restrict__ slot_of, const float* __restrict__ modl, int row0, float* __restrict__ outl, float* __restrict__ outc) {
    const int row = row0 + blockIdx.x * 4 + (threadIdx.x >> 6), lane = threadIdx.x & 63;
    const int b = row < TL ? (row >> 12) : 16;
    const float* gp = modl + (size_t)b * (NMOD * DM) + 5 * DM;
    float* op = row < TL ? outl + (size_t)row * DM : outc + (size_t)(row - TL) * DM;
    int s[4];
#pragma unroll
    for (int k = 0; k < 4; ++k) s[k] = slot_of[(size_t)row * 4 + k];
#pragma unroll
    for (int j = 0; j < 4; ++j) {
        const int col = (lane + 64 * j) * 4;
        f32x4 acc = (f32x4){0.f, 0.f, 0.f, 0.f};
#pragma unroll
        for (int k = 0; k < 4; ++k) { const u32x2 y = *(const u32x2*)(Y + (size_t)s[k] * DM + col);
            acc += (f32x4){__builtin_bit_cast(float, y.x << 16), __builtin_bit_cast(float, y.x & 0xffff0000u), __builtin_bit_cast(float, y.y << 16), __builtin_bit_cast(float, y.y & 0xffff0000u)}; }
        const f32x4 xv = *(const f32x4*)(x1 + (size_t)row * DM + col), gv = *(const f32x4*)(gp + col);
        *(f32x4*)(op + col) = xv + gv * acc;
    }
}

template <class Epi, class Sched> static void launch_gemm(const pg8::Gemm& g, const Sched& S, const Epi& E, int grid, hipStream_t stream) {
    static bool attr_done = false;
    if (!attr_done) { (void)hipFuncSetAttribute((const void*)k_gemm<Epi, Sched>, hipFuncAttributeMaxDynamicSharedMemorySize, pg8::STAGE_BYTES); attr_done = true; }
    hipLaunchKernelGGL((k_gemm<Epi, Sched>), dim3(grid), dim3(512), pg8::STAGE_BYTES, stream, g, S, E);
}

extern "C" void kernel_launch(void* const* d_in, const int* in_sizes, int n_in, void* d_out, int out_size, void* d_ws, size_t ws_size, hipStream_t stream) {
    if (n_in != 26 || ws_size < WS_END) { fprintf(stderr, "kernel_launch: need 26 inputs and %zu bytes of workspace (got %d, %zu)\n", (size_t)WS_END, n_in, ws_size); return; }
    const float* x = (const float*)d_in[0]; const float* c = (const float*)d_in[1]; const float* ctx = (const float*)d_in[2]; const float* c_ctx = (const float*)d_in[3];
    const float* w_mod = (const float*)d_in[4]; const float* b_mod = (const float*)d_in[5]; const float* norm1_g = (const float*)d_in[6]; const float* norm2_g = (const float*)d_in[7];
    const float* w_in = (const float*)d_in[8]; const float* q_norm_g = (const float*)d_in[9]; const float* k_norm_g = (const float*)d_in[10];
    const float* lq1 = (const float*)d_in[11]; const float* lk1 = (const float*)d_in[12]; const float* lq2 = (const float*)d_in[13]; const float* lk2 = (const float*)d_in[14];
    const float* subln_g = (const float*)d_in[15]; const float* conv_w = (const float*)d_in[16]; const float* pool_w = (const float*)d_in[17]; const float* pool_scale = (const float*)d_in[18];
    const float* w_out = (const float*)d_in[19]; const float* router_w = (const float*)d_in[20]; const float* router_b = (const float*)d_in[21];
    const float* w_gu = (const float*)d_in[22]; const float* b_gu = (const float*)d_in[23]; const float* w_dn = (const float*)d_in[24]; const float* b_dn = (const float*)d_in[25];
    float* out = (float*)d_out; unsigned char* ws = (unsigned char*)d_ws;
    static int grid = 0;
    if (!grid) { int dev = 0, cus = 0; (void)hipGetDevice(&dev); (void)hipDeviceGetAttribute(&cus, hipDeviceAttributeMultiprocessorCount, dev); grid = cus > 0 ? cus : 256; }

    int* ctl = (int*)(ws + WS_CTL); float* mod = (float*)(ws + WS_MOD); float2* rope = (float2*)(ws + WS_ROPE); float* scal = (float*)(ws + WS_SCAL);
    bf16* Win = (bf16*)(ws + WS_WIN); bf16* Wout = (bf16*)(ws + WS_WOUT); bf16* Wgu = (bf16*)(ws + WS_WGU); bf16* Wdn = (bf16*)(ws + WS_WDN);
    bf16* H = (bf16*)(ws + WS_H); float* X1 = (float*)(ws + WS_X1); float* X2C = (float*)(ws + WS_X2C);
    int* TE = (int*)(ws + WS_TOK + TOK_TE); float* TW = (float*)(ws + WS_TOK + TOK_TW); int* SLOTOF = (int*)(ws + WS_TOK + TOK_SLOTOF);
    int* ROWTOK = (int*)(ws + WS_TOK + TOK_ROWTOK); float* ROWW = (float*)(ws + WS_TOK + TOK_ROWW); float* LOGITS = (float*)(ws + WS_TOK + TOK_LOGITS);
    bf16* P = (bf16*)(ws + WS_RA + RA_P); bf16* MIX = (bf16*)(ws + WS_RA + RA_MIX); bf16* XS = (bf16*)(ws + WS_RA); bf16* Y = (bf16*)(ws + WS_RA);
    float* Qf = (float*)(ws + WS_RB + RB_Q); float* Qc = (float*)(ws + WS_RB + RB_QC); float* Kf = (float*)(ws + WS_RB + RB_K); float* Vf = (float*)(ws + WS_RB + RB_V); float* DBUF = (float*)(ws + WS_RB + RB_D);
    float* H2F = (float*)(ws + WS_RB); bf16* ACT = (bf16*)(ws + WS_RB);

    (void)hipMemsetAsync(ws + WS_CTL, 0, 1 * MiB, stream);
    (void)hipMemsetAsync(ws + WS_TOK + TOK_ROWTOK, 0, 4 * MiB, stream);

    hipLaunchKernelGGL(k_mod, dim3(192), dim3(512), 0, stream, c, c_ctx, w_mod, b_mod, mod);
    hipLaunchKernelGGL(k_misc, dim3(SEQ * 16 / 256), dim3(256), 0, stream, rope, scal, lq1, lk1, lq2, lk2);
    hipLaunchKernelGGL(k_transpose, dim3(INW / 64, DM / 64, DEPTH), dim3(256), 0, stream, w_in, Win, DM, INW, 0, (size_t)DM * INW);
    hipLaunchKernelGGL(k_transpose, dim3(DM / 64, DM / 64, DEPTH), dim3(256), 0, stream, w_out, Wout, DM, DM, 0, (size_t)DM * DM);
    hipLaunchKernelGGL(k_transpose, dim3(2048 / 64, DM / 64, DEPTH * NEXP), dim3(256), 0, stream, w_gu, Wgu, DM, 2048, 1, (size_t)DM * 2048);
    hipLaunchKernelGGL(k_transpose, dim3(DM / 64, DM / 64, DEPTH * NEXP), dim3(256), 0, stream, w_dn, Wdn, DM, DM, 0, (size_t)DM * DM);

    for (int l = 0; l < DEPTH; ++l) {
        const bool has_next = l + 1 < DEPTH;
        const float* xl = l == 0 ? x : out; const float* xc = l == 0 ? ctx : X2C;
        const float* modl = mod + (size_t)l * 17 * NMOD * DM; int* ctll = ctl + l * CTL_LSTRIDE;
        hipLaunchKernelGGL(k_norm, dim3(TT / 4), dim3(256), 0, stream, xl, xc, norm1_g + l * DM, modl, 0, 1, H, (float*)nullptr);
        { pg8::Gemm g{H, Win + (size_t)l * INW * DM, TT, INW, DM, 0}; PlainOrder S{}; S.M = TT; S.N = INW;
          EpiPlainBf16 E{P, (long)INW}; launch_gemm(g, S, E, grid, stream); }
        hipLaunchKernelGGL(k_qkv_post, dim3((unsigned)(((long)TT * NH * 5 + 255) / 256)), dim3(256), 0, stream, P, q_norm_g + l * 32, k_norm_g + l * 32, rope, Qf, Qc, Kf, Vf);
        hipLaunchKernelGGL(k_attn_naive, dim3(SEQ / 256, NB * NH), dim3(256), 0, stream, Qf, Kf, Vf, SEQ, NKEY, scal + 2 * l, subln_g + l * 64, MIX, 0, SEQ);
        if (has_next) hipLaunchKernelGGL(k_attn_naive, dim3(CTXL / 256, NB * NH), dim3(256), 0, stream, Qc, Kf, Vf, CTXL, CTXL, scal + 2 * l, subln_g + l * 64, MIX, TL, CTXL);
        hipLaunchKernelGGL(k_convpool, dim3(TT * 2), dim3(256), 0, stream, P, conv_w + l * 768, MIX, DBUF);
        hipLaunchKernelGGL(k_pool_mix, dim3(TT), dim3(256), 0, stream, DBUF, pool_w + l * 16384, pool_scale + l * 256, MIX);
        { pg8::Gemm g{MIX, Wout + (size_t)l * DM * DM, TT, DM, DM, 0}; PlainOrder S{}; S.M = TT; S.N = DM;
          EpiResid E{xl, xc, modl + 2 * DM, X1}; launch_gemm(g, S, E, grid, stream); }
        const int row0 = 0, nrows = has_next ? TT : TL;
        hipLaunchKernelGGL(k_norm, dim3(TT / 4), dim3(256), 0, stream, X1, X1 + (size_t)TL * DM, norm2_g + l * DM, modl, 3, 4, H, H2F);
        hipLaunchKernelGGL(k_router, dim3(nrows / 8), dim3(256), 0, stream, H2F, router_w + l * DM * NEXP, router_b + l * NEXP, LOGITS, row0);
        hipLaunchKernelGGL(k_topk, dim3((nrows + 255) / 256), dim3(256), 0, stream, LOGITS, row0, nrows, TE, TW, ctll);
        hipLaunchKernelGGL(k_offsets, dim3(1), dim3(64), 0, stream, ctll);
        hipLaunchKernelGGL(k_assign, dim3((nrows * 4 + 255) / 256), dim3(256), 0, stream, TE, TW, row0, nrows, ctll, ROWTOK, ROWW, SLOTOF);
        hipLaunchKernelGGL(k_gather, dim3(MAXBLK * 256 / 4), dim3(256), 0, stream, H, ROWTOK, ctll, XS);
        { pg8::Gemm g{XS, Wgu + (size_t)l * NEXP * 2048 * DM, 0, 2048, DM, 0}; GroupedOrder S{}; S.ctl = ctll; S.nN = 8; S.Nper = 2048;
          EpiSwiglu E{ctll, b_gu + (size_t)l * NEXP * 2048, ACT}; launch_gemm(g, S, E, grid, stream); }
        { pg8::Gemm g{ACT, Wdn + (size_t)l * NEXP * DM * DM, 0, DM, DM, 0}; GroupedOrder S{}; S.ctl = ctll; S.nN = 4; S.Nper = 1024;
          EpiDown E{ctll, b_dn + (size_t)l * NEXP * DM, ROWW, Y}; launch_gemm(g, S, E, grid, stream); }
        hipLaunchKernelGGL(k_combine, dim3(nrows / 4), dim3(256), 0, stream, X1, Y, SLOTOF, modl, row0, out, X2C);
    }
}
```

```cpp
#include <hip/hip_runtime.h>
#include <cstdio>
#include <cstdint>
#include <cstring>
namespace pg8 {
#define PG8_LAS __attribute__((address_space(3)))
typedef unsigned short bf16_t;
typedef short bf16x8 __attribute__((ext_vector_type(8)));
typedef float f32x4 __attribute__((ext_vector_type(4)));
typedef unsigned u32x4 __attribute__((ext_vector_type(4)));
typedef int pg8_v4i __attribute__((ext_vector_type(4)));
typedef int pg8_v8i __attribute__((ext_vector_type(8)));
constexpr int BM = 256, BK = 64, HALF = 128, HTB = HALF * BK * 2  , STAGE_BYTES = 8 * HTB, NXCD = 8, WGM = 8;

__host__ __device__ __forceinline__ int lds_byte(int r, int c) { const int st = (r >> 4) * 2 + (c >> 5), rr = r & 15, cc = c & 31, ob = rr * 64 + cc * 2; return st * 1024 + (ob ^ (((ob >> 9) & 1) << 5)); }
__host__ __device__ __forceinline__ void stage_rc(int b, int& R, int& C) { const int st = b / 1024, sb = b % 1024, swz = sb ^ (((sb >> 9) & 1) << 5); R = (st >> 1) * 16 + swz / 64; C = (st & 1) * 32 + (swz % 64) / 2; }
__host__ __device__ __forceinline__ int perm32(int rho) { const int n = rho >> 4, i = rho & 15; return 8 * (i >> 2) + 4 * n + (i & 3); }

struct Unit { int pm, pn; };
struct Gemm { const bf16_t* A; const bf16_t* Bt; int M, N, K, pad; };

struct StaticOrder {
    int nM, nN, nwg, G, c;
    __host__ __device__ void init(int M, int N, int G_, int c_) { nM = M / BM; nN = N / BM; nwg = nM * nN; G = G_; c = c_; }
    __host__ __device__ bool next(int i, Unit& u) const {
        const long L = (long)i * G + c; if (L >= nwg) return false;
        int wgid = (int)L; { const int q = nwg / NXCD, r = nwg % NXCD, xcd = wgid % NXCD, off = wgid / NXCD; wgid = (xcd < r ? xcd * (q + 1) : r * (q + 1) + (xcd - r) * q) + off; }
        const int nig = WGM * nN, gid = wgid / nig, fm = gid * WGM, gsz = (nM - fm) < WGM ? (nM - fm) : WGM;
        u.pm = fm + ((wgid % nig) % gsz); u.pn = (wgid % nig) / gsz; return true;
    }
    __device__ __forceinline__ int brow(const Unit& u) const { return u.pn * BM; }
    static constexpr const int* rowtok = nullptr;
    __device__ __forceinline__ void a_ready(const Unit&) const {}
    __device__ __forceinline__ void done(const Unit&) const {}
};

__device__ __forceinline__ unsigned cvt_pk_bf16(float lo, float hi) { unsigned r; asm volatile("v_cvt_pk_bf16_f32 %0, %1, %2" : "=v"(r) : "v"(lo), "v"(hi)); return r; }
typedef float f32x2 __attribute__((ext_vector_type(2)));
template <class Epi, class Sched, bool ALIGN_EPI = false, bool SP2 = false, bool FP8 = false, bool GATHER = false>
__device__ __forceinline__ void gemm_phase(PG8_LAS unsigned char* lds, const Gemm g, const Sched& S, const Epi& E) {
    int tid_l = threadIdx.x; asm volatile("" : "+v"(tid_l));
    const int tid = tid_l, wid = __builtin_amdgcn_readfirstlane(tid >> 6), lane = tid & 63, wr = wid >> 2, wc = wid & 3, fr = lane & 15, fq = lane >> 4;
    const int K = g.K, nt = K / BK;
    unsigned voffA[2], voffB[2]; int gR[2]; unsigned gC[2];
#pragma unroll
    for (int i = 0; i < 2; ++i) { int R, C; stage_rc(tid * 16 + i * 8192, R, C); const int Rb = Epi::PERM ? ((R & ~31) + perm32(R & 31)) : R;
        voffA[i] = (unsigned)(R * K + C) * 2u; voffB[i] = (unsigned)(Rb * K + C) * 2u; gR[i] = R; gC[i] = (unsigned)C * 2u; }
    static_assert(!GATHER || SP2, "GATHER is written for the SP2 loop");
    unsigned gcur[2][2] = {{0u, 0u}, {0u, 0u}}, gnxt[2][2] = {{0u, 0u}, {0u, 0u}}, graw[2][2] = {{0u, 0u}, {0u, 0u}};
#define PG8_GLOAD(gv, u) do { _Pragma("unroll") for (int h_ = 0; h_ < 2; ++h_) _Pragma("unroll") for (int i_ = 0; i_ < 2; ++i_) gv[h_][i_] = (unsigned)S.rowtok[(u).pm * BM + h_ * HALF + gR[i_]] * (unsigned)(K * 2) + gC[i_]; } while (0)
    const size_t kstep = (size_t)(BK * 2);
    const size_t hstep = (size_t)HALF * K * 2;
    const size_t tstep = 2 * hstep;
    const unsigned ldsw = (unsigned)wid * 1024u;
    const int aoff = lds_byte(wr * 64 + fr, fq * 8), boff = lds_byte(wc * 32 + fr, fq * 8);
#define PG8_CAT8(x, y) __builtin_shufflevector(__builtin_bit_cast(pg8_v4i, (x)), __builtin_bit_cast(pg8_v4i, (y)), 0, 1, 2, 3, 4, 5, 6, 7)
#define PG8_SA(b, h) (((b) * 2 + (h)) * HTB)
#define PG8_SB(b, h) ((4 + (b) * 2 + (h)) * HTB)
#define PG8_STAGE(bufoff, gbase, voff) do { _Pragma("unroll") for (int _i = 0; _i < 2; ++_i) \
        __builtin_amdgcn_global_load_lds((const unsigned*)((const char*)(gbase) + (voff)[_i]), (PG8_LAS unsigned*)(lds + (bufoff) + ldsw + _i * 8192), 16, 0, 0); } while (0)
#define PG8_STAGE_A(bufoff, kbase, h, gv) do { if constexpr (GATHER) { PG8_STAGE(bufoff, kbase, (gv)[h]); } else { PG8_STAGE(bufoff, (kbase) + (h) * hstep, voffA); } } while (0)
#define PG8_LDA(dst, b, h) do { _Pragma("unroll") for (int m = 0; m < 4; ++m) { if constexpr (FP8) dst##8[m] = PG8_CAT8(*(const PG8_LAS bf16x8*)(lds + PG8_SA(b, h) + aoff + m * 2048), *(const PG8_LAS bf16x8*)(lds + PG8_SA(b, h) + aoff + m * 2048 + 1024)); \
        else { _Pragma("unroll") for (int k = 0; k < 2; ++k) dst[m][k] = *(const PG8_LAS bf16x8*)(lds + PG8_SA(b, h) + aoff + m * 2048 + k * 1024); } } } while (0)
#define PG8_LDB(dst, b, h) do { _Pragma("unroll") for (int n = 0; n < 2; ++n) { if constexpr (FP8) dst##8[n] = PG8_CAT8(*(const PG8_LAS bf16x8*)(lds + PG8_SB(b, h) + boff + n * 2048), *(const PG8_LAS bf16x8*)(lds + PG8_SB(b, h) + boff + n * 2048 + 1024)); \
        else { _Pragma("unroll") for (int k = 0; k < 2; ++k) dst[n][k] = *(const PG8_LAS bf16x8*)(lds + PG8_SB(b, h) + boff + n * 2048 + k * 1024); } } } while (0)
#define PG8_MMA(ai, bj, At, Bt) do { __builtin_amdgcn_s_setprio(1); _Pragma("unroll") for (int m = 0; m < 4; ++m) _Pragma("unroll") for (int n = 0; n < 2; ++n) { \
        if constexpr (FP8) asm volatile("v_mfma_f32_16x16x128_f8f6f4 %0, %1, %2, %0" : "+v"(acc[ai][bj][m][n]) : "v"(Bt##8[n]), "v"(At##8[m]));     \
        else { _Pragma("unroll") for (int k = 0; k < 2; ++k) acc[ai][bj][m][n] = __builtin_amdgcn_mfma_f32_16x16x32_bf16(Bt[n][k], At[m][k], acc[ai][bj][m][n], 0, 0, 0); } } __builtin_amdgcn_s_setprio(0); } while (0)
#define PG8_WAIT_V(n) asm volatile("s_waitcnt vmcnt(" #n ")" ::: "memory")
#define PG8_WAIT_L(n) asm volatile("s_waitcnt lgkmcnt(" #n ")" ::: "memory")
#define PG8_BAR __builtin_amdgcn_s_barrier()
#define PG8_SCHED __builtin_amdgcn_sched_barrier(0)
    Unit cur, nxt; int ui = 0;
    if (!S.next(0, cur)) return;
    f32x4 acc[2][2][4][2];
#pragma unroll
    for (int a = 0; a < 2; ++a)
#pragma unroll
        for (int b = 0; b < 2; ++b)
#pragma unroll
            for (int m = 0; m < 4; ++m)
#pragma unroll
                for (int n = 0; n < 2; ++n) acc[a][b][m][n] = (f32x4){0.f, 0.f, 0.f, 0.f};
    bf16x8 At[4][2], B0[2][2], B1[2][2]; pg8_v8i At8[4], B08[2], B18[2];
    const char* cA = (const char*)g.A + (GATHER ? (size_t)0 : (size_t)cur.pm * tstep); if constexpr (GATHER) PG8_GLOAD(gcur, cur);
    const char* cB = (const char*)g.Bt + (size_t)S.brow(cur) * (size_t)K * 2;
    S.a_ready(cur);
    if constexpr (SP2) {
        PG8_STAGE(PG8_SB(0, 0), cB, voffB); PG8_STAGE(PG8_SB(0, 1), cB + hstep, voffB); PG8_STAGE_A(PG8_SA(0, 0), cA, 0, gcur); PG8_STAGE_A(PG8_SA(0, 1), cA, 1, gcur);
        if (wr == 1) PG8_BAR;
        PG8_WAIT_V(2); PG8_BAR;
        PG8_STAGE(PG8_SB(1, 0), cB + kstep, voffB); PG8_STAGE_A(PG8_SA(1, 0), cA + kstep, 0, gcur); PG8_STAGE(PG8_SB(1, 1), cB + hstep + kstep, voffB);
        PG8_WAIT_V(6); PG8_BAR;
    } else {
        PG8_STAGE(PG8_SB(0, 0), cB, voffB); PG8_STAGE(PG8_SA(0, 0), cA, voffA); PG8_STAGE(PG8_SB(0, 1), cB + hstep, voffB); PG8_STAGE(PG8_SA(0, 1), cA + hstep, voffA);
        if (wr == 1) PG8_BAR;
        PG8_WAIT_V(4); PG8_BAR;
        PG8_STAGE(PG8_SB(1, 0), cB + kstep, voffB); PG8_STAGE(PG8_SA(1, 0), cA + kstep, voffA); PG8_STAGE(PG8_SB(1, 1), cB + hstep + kstep, voffB);
        PG8_WAIT_V(6); PG8_BAR;
    }
    for (;;) {
        const bool has_next = S.next(ui + 1, nxt);
        const char* nA = (has_next && !GATHER) ? (const char*)g.A + (size_t)nxt.pm * tstep : cA; const char* nB = has_next ? (const char*)g.Bt + (size_t)S.brow(nxt) * (size_t)K * 2 : cB;
#pragma nounroll
        for (int t = 0; t < nt; t += 2) {
            const bool last = (t == nt - 2);
            const char* a1 = cA + (size_t)(t + 1) * kstep;
            const char* a2 = last ? nA : cA + (size_t)(t + 2) * kstep; const char* b2 = last ? nB : cB + (size_t)(t + 2) * kstep;
            const char* a3 = a2 + kstep; const char* b3 = b2 + kstep;
            if (last && has_next) S.a_ready(nxt);
            if (last) E.pre(cur, wid, lane);
            if constexpr (GATHER) { if (t == nt - 4 && has_next) { _Pragma("unroll") for (int h_ = 0; h_ < 2; ++h_) _Pragma("unroll") for (int i_ = 0; i_ < 2; ++i_)
                asm volatile("global_load_dword %0, %1, off" : "+v"(graw[h_][i_]) : "v"(S.rowtok + (nxt.pm * BM + h_ * HALF + gR[i_])) : "memory"); } }
            unsigned gsel[2][2];
            if constexpr (GATHER) { _Pragma("unroll") for (int h_ = 0; h_ < 2; ++h_) _Pragma("unroll") for (int i_ = 0; i_ < 2; ++i_) { if (last && has_next) gnxt[h_][i_] = graw[h_][i_] * (unsigned)(K * 2) + gC[i_]; gsel[h_][i_] = (last && has_next) ? gnxt[h_][i_] : gcur[h_][i_]; } }
            if constexpr (SP2) {
            PG8_LDB(B0, 0, 0); PG8_LDB(B1, 0, 1); PG8_SCHED; PG8_LDA(At, 0, 0); PG8_STAGE_A(PG8_SA(1, 1), a1, 1, gcur);
            PG8_WAIT_V(8); PG8_WAIT_L(0); PG8_BAR; PG8_MMA(0, 0, At, B0); PG8_MMA(0, 1, At, B1); PG8_BAR; PG8_SCHED;
            PG8_LDA(At, 0, 1); PG8_STAGE(PG8_SB(0, 0), b2, voffB); PG8_STAGE(PG8_SB(0, 1), b2 + hstep, voffB); PG8_STAGE_A(PG8_SA(0, 0), a2, 0, gsel);
            PG8_WAIT_V(8); PG8_WAIT_L(0); PG8_BAR; PG8_MMA(1, 0, At, B0); PG8_MMA(1, 1, At, B1); PG8_BAR; PG8_SCHED;
            PG8_LDB(B0, 1, 0); PG8_LDB(B1, 1, 1); PG8_SCHED; PG8_LDA(At, 1, 0); PG8_STAGE_A(PG8_SA(0, 1), a2, 1, gsel);
            PG8_WAIT_V(8); PG8_WAIT_L(0); PG8_BAR; PG8_MMA(0, 0, At, B0); PG8_MMA(0, 1, At, B1); PG8_BAR; PG8_SCHED;
            PG8_LDA(At, 1, 1); PG8_STAGE(PG8_SB(1, 0), b3, voffB); PG8_STAGE(PG8_SB(1, 1), b3 + hstep, voffB); PG8_STAGE_A(PG8_SA(1, 0), a3, 0, gsel);
            PG8_WAIT_V(8); PG8_WAIT_L(0); PG8_BAR; PG8_MMA(1, 0, At, B0); PG8_MMA(1, 1, At, B1); PG8_BAR; PG8_SCHED;
            } else {
            PG8_LDB(B0, 0, 0); PG8_SCHED; PG8_LDA(At, 0, 0); PG8_STAGE(PG8_SA(1, 1), a1 + hstep, voffA);
            PG8_WAIT_L(8); PG8_BAR; PG8_WAIT_L(0); PG8_MMA(0, 0, At, B0); PG8_BAR; PG8_SCHED;
            PG8_LDB(B1, 0, 1); PG8_STAGE(PG8_SB(0, 0), b2, voffB);
            PG8_BAR; PG8_WAIT_L(0); PG8_MMA(0, 1, At, B1); PG8_BAR;
            PG8_LDA(At, 0, 1); PG8_STAGE(PG8_SA(0, 0), a2, voffA);
            PG8_BAR; PG8_WAIT_L(0); PG8_MMA(1, 0, At, B0); PG8_BAR; PG8_SCHED;
            PG8_STAGE(PG8_SB(0, 1), b2 + hstep, voffB);
            PG8_WAIT_V(6); PG8_BAR; PG8_MMA(1, 1, At, B1); PG8_BAR;
            PG8_LDB(B0, 1, 0); PG8_SCHED; PG8_LDA(At, 1, 0); PG8_STAGE(PG8_SA(0, 1), a2 + hstep, voffA);
            PG8_WAIT_L(8); PG8_BAR; PG8_WAIT_L(0); PG8_MMA(0, 0, At, B0); PG8_BAR; PG8_SCHED;
            PG8_LDB(B1, 1, 1); PG8_STAGE(PG8_SB(1, 0), b3, voffB);
            PG8_BAR; PG8_WAIT_L(0); PG8_MMA(0, 1, At, B1); PG8_BAR;
            PG8_LDA(At, 1, 1); PG8_STAGE(PG8_SA(1, 0), a3, voffA);
            PG8_BAR; PG8_WAIT_L(0); PG8_MMA(1, 0, At, B0); PG8_BAR; PG8_SCHED;
            PG8_STAGE(PG8_SB(1, 1), b3 + hstep, voffB);
            PG8_WAIT_V(6); PG8_BAR; PG8_MMA(1, 1, At, B1); PG8_BAR;
            }
        }
        if constexpr (FP8) asm volatile("s_nop 15\n\ts_nop 15" ::: "memory");
        if constexpr (ALIGN_EPI) { if (wr == 0) PG8_BAR; }
        if constexpr (!Epi::AFTER_DRAIN) { E(acc, cur, wr, wc, fr, fq); S.done(cur); }
        if (!has_next) break;
#pragma unroll
        for (int a = 0; a < 2; ++a)
#pragma unroll
            for (int b = 0; b < 2; ++b)
#pragma unroll
                for (int m = 0; m < 4; ++m)
#pragma unroll
                    for (int n = 0; n < 2; ++n) acc[a][b][m][n] = (f32x4){0.f, 0.f, 0.f, 0.f};
        cur = nxt; cA = nA; cB = nB; ++ui;
        if constexpr (GATHER) { _Pragma("unroll") for (int h_ = 0; h_ < 2; ++h_) _Pragma("unroll") for (int i_ = 0; i_ < 2; ++i_) gcur[h_][i_] = gnxt[h_][i_]; }
        if constexpr (ALIGN_EPI) { if (wr == 1) PG8_BAR; }
    }
    PG8_WAIT_V(0);
    if constexpr (!ALIGN_EPI) { if (wr == 0) PG8_BAR; }
    PG8_BAR;
    if constexpr (Epi::AFTER_DRAIN) { E.fused(acc, cur, wr, wc, fr, fq, lds, wid, lane); S.done(cur); }
#undef PG8_SA
#undef PG8_SB
#undef PG8_STAGE
#undef PG8_STAGE_A
#undef PG8_GLOAD
#undef PG8_LDA
#undef PG8_LDB
#undef PG8_MMA
#undef PG8_CAT8
#undef PG8_WAIT_V
#undef PG8_WAIT_L
#undef PG8_BAR
#undef PG8_SCHED
}
}


constexpr int NB = 16, SEQ = 4096, DM = 1024, CTXL = 256, DEPTH = 2, INW = 2560, NEXP = 32, TOPK = 4;
constexpr int TL = NB * SEQ, TC = NB * CTXL, TT = TL + TC;
constexpr int NH = 8, NKEY = SEQ + CTXL;
constexpr int MAXBLK = 1120;
constexpr int NMOD = 6;
constexpr float EPS = 1e-6f;
constexpr float QSCALE = 0.17677669529663687f * 1.4426950408889634f;
constexpr float SMAX2 = 12.0f;

typedef unsigned short bf16;
typedef float f32x4 __attribute__((ext_vector_type(4)));
typedef unsigned u32x4 __attribute__((ext_vector_type(4)));
typedef unsigned u32x2 __attribute__((ext_vector_type(2)));

constexpr size_t MiB = 1u << 20;
constexpr size_t WS_CTL = 0, WS_MOD = 1 * MiB, WS_ROPE = 2 * MiB, WS_SCAL = 3 * MiB, WS_WIN = 4 * MiB, WS_WOUT = 14 * MiB, WS_WGU = 18 * MiB, WS_WDN = 274 * MiB;
constexpr size_t WS_H = 402 * MiB, WS_X1 = 538 * MiB, WS_X2C = 810 * MiB, WS_TOK = 826 * MiB, WS_RA = 858 * MiB, WS_RB = 1418 * MiB, WS_END = 1978 * MiB;
constexpr size_t TOK_AE = 0, TOK_AW = 2 * MiB, TOK_SLOTOF = 4 * MiB, TOK_ROWTOK = 6 * MiB, TOK_ROWW = 8 * MiB;
constexpr size_t RA_Q = 0, RA_QC = 64 * MiB, RA_K = 68 * MiB, RA_V = 136 * MiB, RA_CPU = 204 * MiB, RA_MIX = 306 * MiB;
constexpr int CTL_LSTRIDE = 4096, CTL_NBLK = 96, CTL_BLKE = 128;
constexpr int CTL_WGCNT = 8192, CTL_WGCNT_L = 8192;
constexpr int CTL_BAR = 32768, CTL_BAR_STRIDE = 4096;

constexpr int NWAVES = 8, NTHR = 512;
constexpr int LDS_SCR = 131072, LDS_CTL = 143360, LDS_BARW = LDS_CTL + 512, LDS_BYTES = 147456;
constexpr size_t WS_WRT = WS_SCAL + 65536;
constexpr int NPHASE = 1 + 9 * DEPTH;

typedef int i32x4 __attribute__((ext_vector_type(4)));
__device__ __forceinline__ unsigned f2bf(float f) { unsigned u = __builtin_bit_cast(unsigned, f); return (u + 0x7fffu + ((u >> 16) & 1u)) >> 16; }
__device__ __forceinline__ float bf2f(unsigned short b) { return __builtin_bit_cast(float, ((unsigned)b) << 16); }
__device__ __forceinline__ float bflo(unsigned w) { return __builtin_bit_cast(float, w << 16); }
__device__ __forceinline__ float bfhi(unsigned w) { return __builtin_bit_cast(float, w & 0xffff0000u); }
template <int CTRL> __device__ __forceinline__ float dpp_mov(float v) { return __builtin_bit_cast(float, __builtin_amdgcn_update_dpp(0, __builtin_bit_cast(int, v), CTRL, 0xf, 0xf, true)); }
__device__ __forceinline__ float rlane(float v, int l) { return __builtin_bit_cast(float, __builtin_amdgcn_readlane(__builtin_bit_cast(int, v), l)); }
__device__ __forceinline__ float xor16_sum(float v) { const unsigned a = __builtin_bit_cast(unsigned, v); const auto r = __builtin_amdgcn_permlane16_swap(a, a, false, false); const unsigned r0 = r[0], r1 = r[1]; return __builtin_bit_cast(float, r0) + __builtin_bit_cast(float, r1); }
__device__ __forceinline__ float xor32_sum(float v) { const unsigned a = __builtin_bit_cast(unsigned, v); const auto r = __builtin_amdgcn_permlane32_swap(a, a, false, false); const unsigned r0 = r[0], r1 = r[1]; return __builtin_bit_cast(float, r0) + __builtin_bit_cast(float, r1); }
__device__ __forceinline__ float wave_sum(float v) {
    v += dpp_mov<0xB1>(v); v += dpp_mov<0x4E>(v); v += dpp_mov<0x141>(v); v += dpp_mov<0x140>(v);
    return (rlane(v, 0) + rlane(v, 16)) + (rlane(v, 32) + rlane(v, 48));
}
typedef float f32x2v __attribute__((ext_vector_type(2)));
template <int CTRL> __device__ __forceinline__ int dpp_movi(int v) { return __builtin_amdgcn_update_dpp(0, v, CTRL, 0xf, 0xf, true); }
template <int CTRL> __device__ __forceinline__ float dpp_movf(float v) { return __builtin_bit_cast(float, __builtin_amdgcn_update_dpp(0, __builtin_bit_cast(int, v), CTRL, 0xf, 0xf, true)); }
__device__ __forceinline__ unsigned pk4_fp8(float a, float b, float c, float d) { int w = __builtin_amdgcn_cvt_pk_fp8_f32(a, b, 0, false); w = __builtin_amdgcn_cvt_pk_fp8_f32(c, d, w, true); return (unsigned)w; }
constexpr float Y8_SCALE = 8.0f, Y8_INV = 1.0f / 8.0f;
constexpr float W8_SCALE = 32.0f, W8_INV = 1.0f / 32.0f;
__device__ __forceinline__ u32x4 pack8(const f32x4 a, const f32x4 b) { u32x4 w; w.x = pg8::cvt_pk_bf16(a[0], a[1]); w.y = pg8::cvt_pk_bf16(a[2], a[3]); w.z = pg8::cvt_pk_bf16(b[0], b[1]); w.w = pg8::cvt_pk_bf16(b[2], b[3]); return w; }

__device__ __forceinline__ void lds_dma16(const void* gsrc, unsigned lds_dst) { unsigned keep;
    asm volatile("s_mov_b32 %0, m0\n\ts_mov_b32 m0, %2\n\ts_nop 0\n\tglobal_load_lds_dwordx4 %1, off\n\ts_mov_b32 m0, %0" : "=&s"(keep) : "v"(gsrc), "s"(lds_dst) : "memory"); }
constexpr int LDS_NBLK = LDS_CTL + 640, LDS_BTE = LDS_CTL + 1280;
constexpr int LDS_EPI = 131072;
struct PlainOrder : pg8::StaticOrder { };
struct InprojOrder {
    pg8::StaticOrder lat; int ncolc, G, c; static constexpr const int* rowtok = nullptr;
    __device__ __forceinline__ void init(int ncolc_, int G_, int c_) { lat.init(TL, INW, G_, c_); ncolc = ncolc_; G = G_; c = c_; }
    __device__ __forceinline__ bool next(int i, pg8::Unit& u) const {
        const int L = i * G + c;
        if (L < lat.nwg) return lat.next(i, u);
        const int idx = L - lat.nwg; if (idx >= 16 * ncolc) return false;
        u.pm = 256 + idx / ncolc; u.pn = (ncolc == 10) ? idx % 10 : 2 + idx % 4; return true;
    }
    __device__ __forceinline__ int brow(const pg8::Unit& u) const { return u.pn * 256; }
    __device__ __forceinline__ void a_ready(const pg8::Unit&) const {}
    __device__ __forceinline__ void done(const pg8::Unit&) const {}
};
struct GroupedOrder {
    const PG8_LAS unsigned char* bte; const int* rowtok; int nN, Nper, G, c, nblk;
    __device__ __forceinline__ void init(const PG8_LAS unsigned char* lds_, int nN_, int Nper_, int G_, int c_, const int* rowtok_ = nullptr) { bte = lds_ + LDS_BTE; rowtok = rowtok_; nN = nN_; Nper = Nper_; G = G_; c = c_; nblk = *(const PG8_LAS int*)(lds_ + LDS_NBLK); }
    __device__ __forceinline__ bool next(int i, pg8::Unit& u) const {
        const int xcd = c & 7, j = c >> 3, per = G / nN;
        u.pm = i * per + (j / nN) * 8 + xcd; u.pn = (j % nN) | ((int)bte[u.pm] << 8); return u.pm < nblk;
    }
    __device__ __forceinline__ int brow(const pg8::Unit& u) const { return (u.pn >> 8) * Nper + (u.pn & 255) * 256; }
    __device__ __forceinline__ void a_ready(const pg8::Unit&) const {}
    __device__ __forceinline__ void done(const pg8::Unit&) const {}
};

struct EpiInproj {
    static constexpr bool PERM = true, AFTER_DRAIN = false;
    __device__ __forceinline__ void pre(const pg8::Unit&, int, int) const {}
    bf16 *Q, *Qc, *K, *V, *CPU; const PG8_LAS float* tab;
    __device__ __forceinline__ void operator()(const f32x4 (&acc)[2][2][4][2], const pg8::Unit& u, int wr, int wc, int fr_in, int fq_in) const {
        int fr = fr_in, fq = fq_in; asm volatile("" : "+v"(fr), "+v"(fq));
        const int pn = u.pn; const bool lat = u.pm < 256; const int b = lat ? (u.pm >> 4) : (u.pm - 256);
        const int pbase = (lat ? (u.pm & 15) * 256 : 0) + wr * 64 + fr;
        const int rbase = u.pm * 256 + wr * 64 + fr;
        if (pn < 4) {
            const bool isq = pn < 2; const PG8_LAS float* g = tab + 1024 + (isq ? 0 : 32);
            const f32x4 g0 = *(const PG8_LAS f32x4*)(g + 8 * fq), g1 = *(const PG8_LAS f32x4*)(g + 8 * fq + 4);
            const float sgn = (fq & 1) ? 1.0f : -1.0f;
#pragma unroll
            for (int bj = 0; bj < 2; ++bj) {
                const int grp = bj * 4 + wc, head = (pn & 1) * 4 + (grp >> 1), comp = grp & 1, bh = b * NH + head;
#pragma unroll
                for (int ai = 0; ai < 2; ++ai)
#pragma unroll
                    for (int m = 0; m < 4; ++m) {
                        const int pos = pbase + ai * 128 + m * 16;
                        f32x4 v0 = acc[ai][bj][m][0], v1 = acc[ai][bj][m][1];
                        float ss = (v0[0] * v0[0] + v0[1] * v0[1]) + (v0[2] * v0[2] + v0[3] * v0[3]) + (v1[0] * v1[0] + v1[1] * v1[1]) + (v1[2] * v1[2] + v1[3] * v1[3]);
                        ss = xor32_sum(xor16_sum(ss));
                        const float r = __builtin_amdgcn_rsqf(ss * (1.0f / 32.0f) + EPS);
                        v0 = v0 * r * g0; v1 = v1 * r * g1;
                        if (lat) {
                            const int p = (fq >> 1) == 0 ? (pos >> 6) : (pos & 63);
                            const f32x4 c0 = *(const PG8_LAS f32x4*)(tab + p * 8), c1 = *(const PG8_LAS f32x4*)(tab + p * 8 + 4), s0 = *(const PG8_LAS f32x4*)(tab + 512 + p * 8), s1 = *(const PG8_LAS f32x4*)(tab + 512 + p * 8 + 4);
                            f32x4 o0, o1;
#pragma unroll
                            for (int j = 0; j < 4; ++j) { o0[j] = __shfl_xor(v0[j], 16); o1[j] = __shfl_xor(v1[j], 16); }
                            v0 = v0 * c0 + (o0 * s0) * sgn; v1 = v1 * c1 + (o1 * s1) * sgn;
                        }
                        if (isq) { v0 = v0 * QSCALE; v1 = v1 * QSCALE; }
                        bf16* dst;
                        if (isq) dst = lat ? Q + ((size_t)bh * SEQ + pos) * 64 : Qc + ((size_t)bh * CTXL + pos) * 64;
                        else dst = K + ((size_t)bh * NKEY + (lat ? CTXL + pos : pos)) * 64;
                        *(u32x4*)(dst + comp * 32 + 8 * fq) = pack8(v0, v1);
                    }
            }
        } else if (pn < 6) {
#pragma unroll
            for (int bj = 0; bj < 2; ++bj) {
                const int grp = bj * 4 + wc, head = (pn - 4) * 4 + (grp >> 1), bh = b * NH + head;
#pragma unroll
                for (int ai = 0; ai < 2; ++ai)
#pragma unroll
                    for (int m = 0; m < 4; ++m) {
                        const int pos = pbase + ai * 128 + m * 16;
                        bf16* dst = V + ((size_t)bh * NKEY + (lat ? CTXL + pos : pos)) * 64 + (grp & 1) * 32 + 8 * fq;
                        *(u32x4*)dst = pack8(acc[ai][bj][m][0], acc[ai][bj][m][1]);
                    }
            }
        } else if (pn == 7 || pn == 8) {
#pragma unroll
            for (int ai = 0; ai < 2; ++ai)
#pragma unroll
                for (int m = 0; m < 4; ++m) {
                    bf16* dst = CPU + (size_t)(rbase + ai * 128 + m * 16) * 768 + 256 + (pn - 7) * 128 + wc * 32 + 8 * fq;
                    *(u32x4*)dst = pack8(acc[ai][0][m][0] * acc[ai][1][m][0], acc[ai][0][m][1] * acc[ai][1][m][1]);
                }
        } else {
            const int cb = pn == 6 ? 0 : 512;
#pragma unroll
            for (int ai = 0; ai < 2; ++ai)
#pragma unroll
                for (int m = 0; m < 4; ++m)
#pragma unroll
                    for (int bj = 0; bj < 2; ++bj) {
                        bf16* dst = CPU + (size_t)(rbase + ai * 128 + m * 16) * 768 + cb + bj * 128 + wc * 32 + 8 * fq;
                        *(u32x4*)dst = pack8(acc[ai][bj][m][0], acc[ai][bj][m][1]);
                    }
        }
    }
};
struct EpiResid {
    static constexpr bool PERM = true, AFTER_DRAIN = false;
    const bf16* xb  ; const float* gate  ; bf16* out; PG8_LAS unsigned char* lds;
    __device__ __forceinline__ void pre(const pg8::Unit& u, int wid, int lane) const {
        if (wid == 0) lds_dma16(gate + (size_t)(u.pm < 256 ? (u.pm >> 4) : 16) * (NMOD * DM) + u.pn * 256 + lane * 4, (unsigned)(uintptr_t)(lds + LDS_EPI)); }
    __device__ __forceinline__ void operator()(const f32x4 (&acc)[2][2][4][2], const pg8::Unit& u, int wr, int wc, int fr_in, int fq_in) const {
        int fr = fr_in, fq = fq_in; asm volatile("" : "+v"(fr), "+v"(fq));
        const int row0 = u.pm * 256 + wr * 64 + fr, col0 = u.pn * 256 + wc * 32 + 8 * fq;
        const bool lat = u.pm < 256; const int b = lat ? (u.pm >> 4) : 16;
        const PG8_LAS float* gp = (const PG8_LAS float*)(lds + LDS_EPI) + wc * 32 + 8 * fq; (void)b;
        f32x4 gv[2][2];
#pragma unroll
        for (int bj = 0; bj < 2; ++bj)
#pragma unroll
            for (int n = 0; n < 2; ++n) gv[bj][n] = *(const PG8_LAS f32x4*)(gp + bj * 128 + n * 4);
#pragma unroll
        for (int ai = 0; ai < 2; ++ai)
#pragma unroll
            for (int m = 0; m < 4; ++m) {
                const int row = row0 + ai * 128 + m * 16;
                const bf16* bp = xb + (size_t)row * DM + col0;
#pragma unroll
                for (int bj = 0; bj < 2; ++bj) {
                    const u32x4 bb = *(const u32x4*)(bp + bj * 128);
                    const f32x4 b0 = (f32x4){bflo(bb.x), bfhi(bb.x), bflo(bb.y), bfhi(bb.y)}, b1 = (f32x4){bflo(bb.z), bfhi(bb.z), bflo(bb.w), bfhi(bb.w)};
                    *(u32x4*)(out + (size_t)row * DM + col0 + bj * 128) = pack8(b0 + gv[bj][0] * acc[ai][bj][m][0], b1 + gv[bj][1] * acc[ai][bj][m][1]);
                }
            }
    }
};
struct EpiSwiglu {
    static constexpr bool PERM = true, AFTER_DRAIN = false;
    const int* ctl; const float* bias  ; unsigned char* act  ; PG8_LAS unsigned char* lds;
    __device__ __forceinline__ void pre(const pg8::Unit& u, int wid, int lane) const {
        if (wid == 0) lds_dma16(bias + (size_t)(u.pn >> 8) * 2048 + (lane >> 5) * 1024 + (u.pn & 255) * 128 + (lane & 31) * 4, (unsigned)(uintptr_t)(lds + LDS_EPI)); }
    __device__ __forceinline__ void operator()(const f32x4 (&acc)[2][2][4][2], const pg8::Unit& u, int wr, int wc, int fr_in, int fq_in) const {
        int fr = fr_in, fq = fq_in; asm volatile("" : "+v"(fr), "+v"(fq));
        const int row0 = u.pm * 256 + wr * 64 + fr + (fq & 1) * 16, cl = (u.pn & 255) * 128 + wc * 32 + (fq >> 1) * 16;
        const PG8_LAS float* bl_ = (const PG8_LAS float*)(lds + LDS_EPI) + wc * 32 + 8 * fq;
        f32x4 bgl[2], bli[2];
#pragma unroll
        for (int n = 0; n < 2; ++n) { bgl[n] = *(const PG8_LAS f32x4*)(bl_ + 4 * n); bli[n] = *(const PG8_LAS f32x4*)(bl_ + 128 + 4 * n); }
#pragma unroll
        for (int ai = 0; ai < 2; ++ai)
#pragma unroll
            for (int mp = 0; mp < 2; ++mp) {
                u32x2 w8[2];
#pragma unroll
                for (int mm = 0; mm < 2; ++mm) {
                    const int m = 2 * mp + mm;
                    f32x4 r[2];
#pragma unroll
                    for (int n = 0; n < 2; ++n) {
                        f32x4 g = acc[ai][0][m][n] * W8_INV + bgl[n], li = acc[ai][1][m][n] * W8_INV + bli[n];
                        g = __builtin_elementwise_min(g, (f32x4){7.0f, 7.0f, 7.0f, 7.0f});
                        li = __builtin_elementwise_min(__builtin_elementwise_max(li, (f32x4){-7.0f, -7.0f, -7.0f, -7.0f}), (f32x4){7.0f, 7.0f, 7.0f, 7.0f});
                        const f32x4 t = g * (-1.702f * 1.4426950408889634f);
                        f32x4 d; d.x = __builtin_amdgcn_exp2f(t.x); d.y = __builtin_amdgcn_exp2f(t.y); d.z = __builtin_amdgcn_exp2f(t.z); d.w = __builtin_amdgcn_exp2f(t.w);
                        d = d + 1.0f;
                        f32x4 sg; sg.x = __builtin_amdgcn_rcpf(d.x); sg.y = __builtin_amdgcn_rcpf(d.y); sg.z = __builtin_amdgcn_rcpf(d.z); sg.w = __builtin_amdgcn_rcpf(d.w);
                        const f32x4 u2 = g * sg;
                        r[n] = u2 * li + u2;
                    }
                    w8[mm].x = pk4_fp8(r[0][0], r[0][1], r[0][2], r[0][3]); w8[mm].y = pk4_fp8(r[1][0], r[1][1], r[1][2], r[1][3]);
                }
                { auto rx = __builtin_amdgcn_permlane16_swap(w8[0].x, w8[1].x, false, false); auto ry = __builtin_amdgcn_permlane16_swap(w8[0].y, w8[1].y, false, false);
                  *(u32x4*)(act + (size_t)(row0 + ai * 128 + mp * 32) * 1024 + cl) = (u32x4){rx[0], ry[0], rx[1], ry[1]}; }
            }
    }
};
struct EpiDown {
    static constexpr bool PERM = true, AFTER_DRAIN = false;
    const int* ctl; const float* bias  ; const float* row_w; unsigned char* Y  ; PG8_LAS unsigned char* lds;
    __device__ __forceinline__ void pre(const pg8::Unit& u, int wid, int lane) const {
        if (wid == 0) lds_dma16(bias + (size_t)(u.pn >> 8) * 1024 + (u.pn & 255) * 256 + lane * 4, (unsigned)(uintptr_t)(lds + LDS_EPI));
        if (wid == 1) lds_dma16(row_w + (size_t)u.pm * 256 + lane * 4, (unsigned)(uintptr_t)(lds + LDS_EPI + 1024)); }
    __device__ __forceinline__ void operator()(const f32x4 (&acc)[2][2][4][2], const pg8::Unit& u, int wr, int wc, int fr_in, int fq_in) const {
        int fr = fr_in, fq = fq_in; asm volatile("" : "+v"(fr), "+v"(fq));
        const int row0 = u.pm * 256 + wr * 64 + fr + (fq & 1) * 16, col0 = (u.pn & 255) * 256 + wc * 32 + (fq >> 1) * 16;
        const PG8_LAS float* bl_ = (const PG8_LAS float*)(lds + LDS_EPI) + wc * 32 + 8 * fq; const PG8_LAS float* wl_ = (const PG8_LAS float*)(lds + LDS_EPI + 1024) + wr * 64 + fr;
        f32x4 bv[2][2];
#pragma unroll
        for (int bj = 0; bj < 2; ++bj)
#pragma unroll
            for (int n = 0; n < 2; ++n) bv[bj][n] = *(const PG8_LAS f32x4*)(bl_ + bj * 128 + 4 * n);
#pragma unroll
        for (int ai = 0; ai < 2; ++ai)
#pragma unroll
            for (int mp = 0; mp < 2; ++mp) {
                const float w0 = wl_[ai * 128 + mp * 32] * Y8_SCALE, w1 = wl_[ai * 128 + mp * 32 + 16] * Y8_SCALE;
#pragma unroll
                for (int bj = 0; bj < 2; ++bj) {
                    u32x2 o[2];
#pragma unroll
                    for (int mm = 0; mm < 2; ++mm) { const int m = 2 * mp + mm; const float w = mm ? w1 : w0;
                        const f32x4 y0 = (acc[ai][bj][m][0] * W8_INV + bv[bj][0]) * w, y1 = (acc[ai][bj][m][1] * W8_INV + bv[bj][1]) * w;
                        o[mm].x = pk4_fp8(y0[0], y0[1], y0[2], y0[3]); o[mm].y = pk4_fp8(y1[0], y1[1], y1[2], y1[3]); }
                    auto rx = __builtin_amdgcn_permlane16_swap(o[0].x, o[1].x, false, false); auto ry = __builtin_amdgcn_permlane16_swap(o[0].y, o[1].y, false, false);
                    *(u32x4*)(Y + (size_t)(row0 + ai * 128 + mp * 32) * 1024 + col0 + bj * 128) = (u32x4){rx[0], ry[0], rx[1], ry[1]};
                }
            }
    }
};

#define XB_TMO      128
#define XB_XCNT(j)  (256  + 64 * (j))
#define XB_XSUB(j)  (1280 + 64 * (j))
#define XB_XGEN(j)  (2304 + 64 * (j))
#define XB_TOP      3328
#define XB_TOPGEN   3392
#define XCD_BAR_WORDS 3456
#define XB_SPIN_CAP (1u << 18)
#define LAS __attribute__((address_space(3)))

__device__ __forceinline__ unsigned xb_ld(unsigned* p)              { return __hip_atomic_load(p, __ATOMIC_RELAXED, __HIP_MEMORY_SCOPE_AGENT); }
__device__ __forceinline__ unsigned xb_add(unsigned* p, unsigned v) { return __hip_atomic_fetch_add(p, v, __ATOMIC_RELAXED, __HIP_MEMORY_SCOPE_AGENT); }
__device__ __forceinline__ unsigned xb_xcc_id() { return (unsigned)__builtin_amdgcn_s_getreg((3 << 11) | 20) & 0xFu; }
#define XB_SPIN(cond, bar) do { unsigned _sp = 0; while (cond) { __builtin_amdgcn_s_sleep(1); \
    if ((++_sp & 255u) == 0u) { if (xb_ld(&(bar)[XB_TMO])) break; if (_sp > XB_SPIN_CAP) { atomicAdd(&(bar)[XB_TMO], 1u); break; } } } } while (0)

struct XcdBarrier {
    unsigned* bar; unsigned x;
    volatile LAS unsigned* st;
};

__device__ __forceinline__ XcdBarrier xcd_barrier_post(unsigned* bar, volatile LAS unsigned* st) {
    XcdBarrier b; b.bar = bar; b.x = xb_xcc_id(); b.st = st;
    if (threadIdx.x == 0) (void)xb_add(&bar[XB_XCNT(b.x)], 1u);
    return b;
}
__device__ __forceinline__ void xcd_barrier_complete(unsigned* bar, unsigned x, unsigned& nloc, unsigned& nx) {
    const unsigned G = gridDim.x * gridDim.y * gridDim.z;
    unsigned sum, cnt, mine, sp = 0u;
    for (;;) {
        sum = 0u; cnt = 0u; mine = 0u;
#pragma unroll
        for (unsigned j = 0; j < 16; ++j) { const unsigned c = xb_ld(&bar[XB_XCNT(j)]); sum += c; cnt += (c > 0u) ? 1u : 0u; mine = (j == x) ? c : mine; }
        if (sum == G) break;
        __builtin_amdgcn_s_sleep(1);
        if ((++sp & 255u) == 0u) { if (xb_ld(&bar[XB_TMO])) break; if (sp > XB_SPIN_CAP) { atomicAdd(&bar[XB_TMO], 1u); break; } }
    }
    nloc = mine > 0u ? mine : 1u; nx = cnt > 0u ? cnt : 1u;
}

__device__ __forceinline__ void xcd_barrier(const XcdBarrier& b) {
    asm volatile("s_waitcnt vmcnt(0)" ::: "memory");
    __syncthreads();
    if (threadIdx.x == 0) {
        unsigned* bar = b.bar;
        __builtin_amdgcn_s_waitcnt(0);
        unsigned nloc = b.st[0], nx = b.st[1];
        if (nloc == 0u) { xcd_barrier_complete(bar, b.x, nloc, nx); b.st[0] = nloc; b.st[1] = nx; }
        const unsigned old = xb_add(&bar[XB_XSUB(b.x)], 1u);
        const unsigned gen = old / nloc;
        if (old + 1u == (gen + 1u) * nloc) {
            __builtin_amdgcn_fence(__ATOMIC_RELEASE, "agent");
            asm volatile("s_waitcnt vmcnt(0)" ::: "memory");
            const unsigned og = xb_add(&bar[XB_TOP], 1u);
            const unsigned tg = og / nx;
            if (og + 1u == (tg + 1u) * nx) xb_add(&bar[XB_TOPGEN], 1u);
            else XB_SPIN(xb_ld(&bar[XB_TOPGEN]) == tg, bar);
            __builtin_amdgcn_fence(__ATOMIC_ACQUIRE, "agent");
            xb_add(&bar[XB_XGEN(b.x)], 1u);
            asm volatile("s_waitcnt vmcnt(0)" ::: "memory");
        } else {
            XB_SPIN(xb_ld(&bar[XB_XGEN(b.x)]) == gen, bar);
            __builtin_amdgcn_fence(__ATOMIC_ACQUIRE, "agent");
            asm volatile("s_waitcnt vmcnt(0)" ::: "memory");
        }
    }
    __syncthreads();
}


namespace fa {
using bf16x8 = __attribute__((ext_vector_type(8))) short;
using s16x4 = __attribute__((ext_vector_type(4))) short;
using f32x16 = __attribute__((ext_vector_type(16))) float;
typedef short v4i16_t __attribute__((ext_vector_type(4)));
constexpr int SUBB = 16384, SLOTB = 2 * SUBB, NSLOT = 3, PFD = NSLOT - 1;
constexpr int FA_WS = 131072, FA_OST = 0, OST_PITCH = 68;
static_assert(NSLOT * SLOTB <= 131072 && 8 * 32 * OST_PITCH * 4 <= NSLOT * SLOTB && FA_WS + 8 * 256 <= 139264, "attention LDS map");
__device__ __forceinline__ void glds16(const void* gsrc, unsigned lds_dst) { unsigned keep;
    asm volatile("s_mov_b32 %0, m0\n\ts_mov_b32 m0, %2\n\ts_nop 0\n\tglobal_load_lds_dwordx4 %1, off\n\ts_mov_b32 m0, %0" : "=&s"(keep) : "v"(gsrc), "s"(lds_dst) : "memory"); }
__device__ __forceinline__ s16x4 vtr(const LAS unsigned char* p) { return __builtin_bit_cast(s16x4, __builtin_amdgcn_ds_read_tr16_b64_v4i16((LAS v4i16_t*)p)); }
typedef float f32x2_t __attribute__((ext_vector_type(2))); typedef __bf16 bf16x2_t __attribute__((ext_vector_type(2)));
__device__ __forceinline__ unsigned cvtpk(float lo, float hi) { f32x2_t v = {lo, hi}; bf16x2_t b = __builtin_convertvector(v, bf16x2_t); return __builtin_bit_cast(unsigned, b); }
#define FA_WAIT_BAR(N) asm volatile("s_waitcnt vmcnt(" #N ") lgkmcnt(0)\n\ts_barrier" ::: "memory")
#define FA_MFMA(a, b, c) __builtin_amdgcn_mfma_f32_32x32x16_bf16((a), (b), (c), 0, 0, 0)

__device__ __forceinline__ void map_tile(const LAS unsigned char* kp, int ko0, int ko1, const bf16x8 (&qf)[2], const s16x4 (&vlo)[8], const s16x4 (&vhi)[8], f32x16 (&o)[2], float& l) {
    const bf16x8 k00 = *(const LAS bf16x8*)(kp + ko0), k01 = *(const LAS bf16x8*)(kp + ko1), k10 = *(const LAS bf16x8*)(kp + ko0 + 4096), k11 = *(const LAS bf16x8*)(kp + ko1 + 4096);
    f32x16 z;
#pragma unroll
    for (int i = 0; i < 16; ++i) z[i] = 0.f;
    f32x16 s0 = FA_MFMA(k00, qf[0], z); s0 = FA_MFMA(k01, qf[1], s0);
    f32x16 s1 = FA_MFMA(k10, qf[0], z); s1 = FA_MFMA(k11, qf[1], s1);
#pragma unroll
    for (int i = 0; i < 16; ++i) { s0[i] = __builtin_amdgcn_exp2f(s0[i]); s1[i] = __builtin_amdgcn_exp2f(s1[i]); }
    float a = 0.f, b = 0.f;
#pragma unroll
    for (int i = 0; i < 16; ++i) { a += s0[i]; b += s1[i]; }
    l += a + b;
    u32x4 pw[4];
#pragma unroll
    for (int j = 0; j < 4; ++j) { pw[0][j] = cvtpk(s0[2 * j], s0[2 * j + 1]); pw[1][j] = cvtpk(s0[8 + 2 * j], s0[8 + 2 * j + 1]); pw[2][j] = cvtpk(s1[2 * j], s1[2 * j + 1]); pw[3][j] = cvtpk(s1[8 + 2 * j], s1[8 + 2 * j + 1]); }
#pragma unroll
    for (int ks = 0; ks < 4; ++ks)
#pragma unroll
        for (int d0 = 0; d0 < 2; ++d0) {
            const int i = d0 * 4 + ks;
            const bf16x8 vf = (bf16x8){vlo[i][0], vlo[i][1], vlo[i][2], vlo[i][3], vhi[i][0], vhi[i][1], vhi[i][2], vhi[i][3]};
            o[d0] = FA_MFMA(__builtin_bit_cast(bf16x8, pw[ks]), vf, o[d0]);
        }
}
template <class Mid> __device__ __forceinline__ void attn_unit(const Mid& mid, LAS unsigned char* lds, const bf16* __restrict__ Qu, const bf16* __restrict__ Kh, const bf16* __restrict__ Vh, int q0, int NT,
                                          float lam, float oscale, const float* __restrict__ subg, bf16* __restrict__ mixp, int tid) {
    int tid_u = tid; asm volatile("" : "+v"(tid_u));
    const int lane = tid_u & 63, r32 = lane & 31, hi = lane >> 5, wid = __builtin_amdgcn_readfirstlane(tid_u >> 6);
    const unsigned lds0 = (unsigned)(uintptr_t)lds;
    const bf16* ksrc = Kh + (size_t)(8 * wid + (lane >> 3)) * 64 + (((lane & 7) ^ ((4 * (wid & 1) + (lane >> 4)) & 7)) * 8);
    const bf16* vsrc = Vh + (size_t)(16 * (wid & 3) + (lane >> 2)) * 64 + (wid >> 2) * 32 + (lane & 3) * 8;
    const unsigned kdst = lds0 + wid * 1024, vdst = lds0 + 8192 + wid * 1024;
#define FA_DMA(t, slot) do { _Pragma("unroll") for (int sb_ = 0; sb_ < 2; ++sb_) { glds16(ksrc + (size_t)(2 * (t) + sb_) * 4096, (unsigned)__builtin_amdgcn_readfirstlane(kdst + (slot) + sb_ * SUBB)); glds16(vsrc + (size_t)(2 * (t) + sb_) * 4096, (unsigned)__builtin_amdgcn_readfirstlane(vdst + (slot) + sb_ * SUBB)); } } while (0)
    const int swr = (r32 >> 1) & 7;
    const LAS unsigned char* kp0 = lds + r32 * 128;
    const int ko10 = ((0 + hi) ^ swr) << 4, ko11 = ((2 + hi) ^ swr) << 4, ko20 = ((4 + hi) ^ swr) << 4, ko21 = ((6 + hi) ^ swr) << 4;
    const LAS unsigned char* vp0 = lds + 8192 + ((lane >> 4) & 1) * 32 + (lane & 3) * 8 + (4 * hi + ((lane & 15) >> 2)) * 64;
#pragma unroll
    for (int d = 0; d < PFD; ++d) FA_DMA((d < (NT >> 1) ? d : (NT >> 1) - 1), d * SLOTB);
    bf16x8 q1f[2], q2f[2];
    { const bf16* qrow = Qu + (size_t)(q0 + wid * 32 + r32) * 64 + hi * 8;
      q1f[0] = *(const bf16x8*)(qrow); q1f[1] = *(const bf16x8*)(qrow + 16); q2f[0] = *(const bf16x8*)(qrow + 32); q2f[1] = *(const bf16x8*)(qrow + 48); }
    asm volatile("" : "+v"(q1f[0]), "+v"(q1f[1]), "+v"(q2f[0]), "+v"(q2f[1]));
    f32x16 o1[2], o2[2]; float l1 = 0.f, l2 = 0.f;
#pragma unroll
    for (int i = 0; i < 16; ++i) { o1[0][i] = 0.f; o1[1][i] = 0.f; o2[0][i] = 0.f; o2[1][i] = 0.f; }
    const int NT2 = NT >> 1;
    int sl = 0;
    for (int t = 0; t < NT2; ++t) {
        FA_WAIT_BAR(4);
        { const int tn = (t + PFD < NT2) ? t + PFD : NT2 - 1; const int sn = (sl == 0) ? (NSLOT - 1) * SLOTB : sl - SLOTB; FA_DMA(tn, sn); }
#pragma unroll 1
        for (int sb = 0; sb < 2; ++sb) {
            const LAS unsigned char* kp = kp0 + sl + sb * SUBB; const LAS unsigned char* vp = vp0 + sl + sb * SUBB;
            s16x4 vlo[8], vhi[8];
#pragma unroll
            for (int i = 0; i < 8; ++i) { vlo[i] = vtr(vp + (i >> 2) * 4096 + (i & 3) * 1024); vhi[i] = vtr(vp + (i >> 2) * 4096 + (i & 3) * 1024 + 512); }
            map_tile(kp, ko10, ko11, q1f, vlo, vhi, o1, l1);
            map_tile(kp, ko20, ko21, q2f, vlo, vhi, o2, l2);
            __builtin_amdgcn_sched_barrier(0);
        }
        sl += SLOTB; if (sl >= NSLOT * SLOTB) sl = 0;
    }
#undef FA_DMA
    asm volatile("s_waitcnt vmcnt(0) lgkmcnt(0)\n\ts_barrier" ::: "memory");
    f32x4 xv[32]; mid.load(xv);
    l1 = xor32_sum(l1); l2 = xor32_sum(l2);
    int lane_e = lane; asm volatile("" : "+v"(lane_e));
    const int r32e = lane_e & 31, hie = lane_e >> 5;
    LAS float* wsf = (LAS float*)(lds + FA_WS) + wid * 64;
    if (hie == 0) { wsf[r32e] = 1.0f / l1; wsf[32 + r32e] = lam / l2; }
    const LAS float* wq = wsf + 4 * hie;
    LAS float* sb = (LAS float*)(lds + FA_OST) + wid * (32 * OST_PITCH) + (4 * hie) * OST_PITCH + r32e;
#pragma unroll
    for (int i = 0; i < 16; ++i) {
        const int qc = (i & 3) + 8 * (i >> 2); const float a = wq[qc], b = wq[32 + qc];
        sb[qc * OST_PITCH] = o1[0][i] * a - o2[0][i] * b; sb[qc * OST_PITCH + 32] = o1[1][i] * a - o2[1][i] * b;
    }
    const int ch = lane_e & 7;
    const f32x4 g0 = *(const f32x4*)(subg + ch * 8), g1 = *(const f32x4*)(subg + ch * 8 + 4);
    const LAS float* rb = (const LAS float*)(lds + FA_OST) + wid * (32 * OST_PITCH) + (lane_e >> 3) * OST_PITCH + ch * 8;
    bf16* mrow = mixp + (size_t)(wid * 32 + (lane_e >> 3)) * DM + ch * 8;
#pragma unroll
    for (int ps = 0; ps < 4; ++ps) {
        const f32x4 x0 = *(const LAS f32x4*)(rb + ps * 8 * OST_PITCH), x1 = *(const LAS f32x4*)(rb + ps * 8 * OST_PITCH + 4);
        float ss = (x0[0] * x0[0] + x0[1] * x0[1]) + (x0[2] * x0[2] + x0[3] * x0[3]) + (x1[0] * x1[0] + x1[1] * x1[1]) + (x1[2] * x1[2] + x1[3] * x1[3]);
        ss += dpp_mov<0xB1>(ss); ss += dpp_mov<0x4E>(ss); ss += dpp_mov<0x141>(ss);
        const float r = oscale * __builtin_amdgcn_rsqf(ss * (1.0f / 64.0f) + EPS);
        *(u32x4*)(mrow + (size_t)ps * 8 * DM) = pack8(x0 * r * g0, x1 * r * g1);
    }
    mid.store(xv);
    asm volatile("s_waitcnt vmcnt(0) lgkmcnt(0)\n\ts_barrier" ::: "memory");
}
#undef FA_MFMA
}
struct Args { const float* in[26]; float* out; unsigned char* ws; int ph_lo, ph_hi, bar_region, pad; };

__device__ __forceinline__ int perm_row(int n, int mode) {
    if (mode == 1) return ((n & 1023) >> 7) * 256 + (n >> 10) * 128 + (n & 127);
    if (mode == 2) { if (n >= 1792 && n < 2304) { const int u = n >= 2048, j = n - (u ? 2048 : 1792); return 1792 + (j >> 7) * 256 + u * 128 + (j & 127); } return n; }
    return n;
}
__device__ __forceinline__ void transpose_item(const float* __restrict__ src, int N, int nb, int kq, bf16* __restrict__ dst, int mode, int lane) {
    const int n = nb * 64 + lane, np = perm_row(n, mode);
#pragma unroll 1
    for (int it = 0; it < 2; ++it) {
        const int k0 = kq * 64 + it * 32; float v[32];
#pragma unroll
        for (int i = 0; i < 32; ++i) v[i] = src[(size_t)(k0 + i) * N + n];
        u32x4* d = (u32x4*)(dst + (size_t)np * DM + k0);
#pragma unroll
        for (int q = 0; q < 4; ++q) { u32x4 a; a.x = pg8::cvt_pk_bf16(v[8 * q], v[8 * q + 1]); a.y = pg8::cvt_pk_bf16(v[8 * q + 2], v[8 * q + 3]); a.z = pg8::cvt_pk_bf16(v[8 * q + 4], v[8 * q + 5]); a.w = pg8::cvt_pk_bf16(v[8 * q + 6], v[8 * q + 7]); d[q] = a; }
    }
}
__device__ __forceinline__ void transpose_item8(const float* __restrict__ src, int N, int nb, int kq, unsigned char* __restrict__ dst, int mode, int lane) {
    const int n = nb * 64 + lane, np = perm_row(n, mode);
#pragma unroll 1
    for (int it = 0; it < 2; ++it) {
        const int k0 = kq * 64 + it * 32; float v[32];
#pragma unroll
        for (int i = 0; i < 32; ++i) v[i] = src[(size_t)(k0 + i) * N + n] * W8_SCALE;
        u32x4* d = (u32x4*)(dst + (size_t)np * DM + k0);
#pragma unroll
        for (int q = 0; q < 2; ++q) { u32x4 a; a.x = pk4_fp8(v[16 * q], v[16 * q + 1], v[16 * q + 2], v[16 * q + 3]); a.y = pk4_fp8(v[16 * q + 4], v[16 * q + 5], v[16 * q + 6], v[16 * q + 7]);
            a.z = pk4_fp8(v[16 * q + 8], v[16 * q + 9], v[16 * q + 10], v[16 * q + 11]); a.w = pk4_fp8(v[16 * q + 12], v[16 * q + 13], v[16 * q + 14], v[16 * q + 15]); d[q] = a; }
    }
}

__device__ __forceinline__ void transpose_batch8w(const float* __restrict__ src, int N, int nb, int k0, unsigned char* __restrict__ dst, int mode, int lane) {
    const int n0 = nb * 256 + lane * 4; f32x4 v[32];
#pragma unroll
    for (int i = 0; i < 32; ++i) v[i] = *(const f32x4*)(src + (size_t)(k0 + i) * N + n0);
#pragma unroll
    for (int c = 0; c < 4; ++c) {
        const int np = perm_row(n0 + c, mode); u32x4* d = (u32x4*)(dst + (size_t)np * DM + k0);
#pragma unroll
        for (int q = 0; q < 2; ++q) { u32x4 a;
            a.x = pk4_fp8(v[16 * q][c] * W8_SCALE, v[16 * q + 1][c] * W8_SCALE, v[16 * q + 2][c] * W8_SCALE, v[16 * q + 3][c] * W8_SCALE);
            a.y = pk4_fp8(v[16 * q + 4][c] * W8_SCALE, v[16 * q + 5][c] * W8_SCALE, v[16 * q + 6][c] * W8_SCALE, v[16 * q + 7][c] * W8_SCALE);
            a.z = pk4_fp8(v[16 * q + 8][c] * W8_SCALE, v[16 * q + 9][c] * W8_SCALE, v[16 * q + 10][c] * W8_SCALE, v[16 * q + 11][c] * W8_SCALE);
            a.w = pk4_fp8(v[16 * q + 12][c] * W8_SCALE, v[16 * q + 13][c] * W8_SCALE, v[16 * q + 14][c] * W8_SCALE, v[16 * q + 15][c] * W8_SCALE);
            d[q] = a; }
    }
}
__device__ __forceinline__ void transpose_batch16w(const float* __restrict__ src, int N, int nb, int k0, bf16* __restrict__ dst, int mode, int lane) {
    const int n0 = nb * 256 + lane * 4; f32x4 v[32];
#pragma unroll
    for (int i = 0; i < 32; ++i) v[i] = *(const f32x4*)(src + (size_t)(k0 + i) * N + n0);
#pragma unroll
    for (int c = 0; c < 4; ++c) {
        const int np = perm_row(n0 + c, mode); u32x4* d = (u32x4*)(dst + (size_t)np * DM + k0);
#pragma unroll
        for (int q = 0; q < 4; ++q) { u32x4 a; a.x = pg8::cvt_pk_bf16(v[8 * q][c], v[8 * q + 1][c]); a.y = pg8::cvt_pk_bf16(v[8 * q + 2][c], v[8 * q + 3][c]); a.z = pg8::cvt_pk_bf16(v[8 * q + 4][c], v[8 * q + 5][c]); a.w = pg8::cvt_pk_bf16(v[8 * q + 6][c], v[8 * q + 7][c]); d[q] = a; }
    }
}
constexpr int XW_BATCHES = 2 * (NEXP * 8 * 16 + NEXP * 4 * 16);
__device__ __forceinline__ void expert_weight_batch(int l, int bi, const float* __restrict__ w_gu, const float* __restrict__ w_dn, unsigned char* __restrict__ Wgu8, unsigned char* __restrict__ Wdn8, int lane) {
    const int item = bi >> 1, k32 = (bi & 1) * 32;
    if (item < NEXP * 8 * 16) { const int kq = item & 15, nb = (item >> 4) & 7, m = l * NEXP + (item >> 7);
        transpose_batch8w(w_gu + (size_t)m * DM * 2048, 2048, nb, kq * 64 + k32, Wgu8 + (size_t)m * 2048 * DM, 1, lane); }
    else { const int it2 = item - NEXP * 8 * 16, kq = it2 & 15, nb = (it2 >> 4) & 3, m = l * NEXP + (it2 >> 6);
        transpose_batch8w(w_dn + (size_t)m * DM * DM, DM, nb, kq * 64 + k32, Wdn8 + (size_t)m * DM * DM, 0, lane); }
}

struct XwMid {
    const float* src; unsigned char* dst; int N, n0, k0, mode; bool on;
    __device__ __forceinline__ void setup(int l, int bi, const float* w_gu, const float* w_dn, unsigned char* Wgu8, unsigned char* Wdn8, int lane) {
        on = bi < XW_BATCHES; const int item = bi >> 1, k32 = (bi & 1) * 32;
        if (item < NEXP * 8 * 16) { const int kq = item & 15, nb = (item >> 4) & 7, m = l * NEXP + (item >> 7); src = w_gu + (size_t)m * DM * 2048; dst = Wgu8 + (size_t)m * 2048 * DM; N = 2048; n0 = nb * 256 + lane * 4; k0 = kq * 64 + k32; mode = 1; }
        else { const int it2 = item - NEXP * 8 * 16, kq = it2 & 15, nb = (it2 >> 4) & 3, m = l * NEXP + (it2 >> 6); src = w_dn + (size_t)m * DM * DM; dst = Wdn8 + (size_t)m * DM * DM; N = DM; n0 = nb * 256 + lane * 4; k0 = kq * 64 + k32; mode = 0; }
    }
    __device__ __forceinline__ void load(f32x4 (&v)[32]) const { if (on) {
#pragma unroll
        for (int i = 0; i < 32; ++i) v[i] = *(const f32x4*)(src + (size_t)(k0 + i) * N + n0); } }
    __device__ __forceinline__ void store(const f32x4 (&v)[32]) const { if (on) {
#pragma unroll
        for (int c = 0; c < 4; ++c) {
            const int np = perm_row(n0 + c, mode); u32x4* d = (u32x4*)(dst + (size_t)np * DM + k0);
#pragma unroll
            for (int q = 0; q < 2; ++q) { u32x4 a;
                a.x = pk4_fp8(v[16 * q][c] * W8_SCALE, v[16 * q + 1][c] * W8_SCALE, v[16 * q + 2][c] * W8_SCALE, v[16 * q + 3][c] * W8_SCALE);
                a.y = pk4_fp8(v[16 * q + 4][c] * W8_SCALE, v[16 * q + 5][c] * W8_SCALE, v[16 * q + 6][c] * W8_SCALE, v[16 * q + 7][c] * W8_SCALE);
                a.z = pk4_fp8(v[16 * q + 8][c] * W8_SCALE, v[16 * q + 9][c] * W8_SCALE, v[16 * q + 10][c] * W8_SCALE, v[16 * q + 11][c] * W8_SCALE);
                a.w = pk4_fp8(v[16 * q + 12][c] * W8_SCALE, v[16 * q + 13][c] * W8_SCALE, v[16 * q + 14][c] * W8_SCALE, v[16 * q + 15][c] * W8_SCALE);
                d[q] = a; }
        } } }
};

__global__ void __launch_bounds__(NTHR, 2) mk_fwd(Args args) {
    extern __shared__ __attribute__((aligned(16))) unsigned char lds_raw[];
    LAS unsigned char* lds = (LAS unsigned char*)lds_raw;
    const int G = gridDim.x, bx = blockIdx.x, NGW = G * NWAVES;
#define PH_IDS() int tid = threadIdx.x; asm volatile("" : "+v"(tid)); const int lane = tid & 63, wave = __builtin_amdgcn_readfirstlane(tid >> 6), gw = bx * NWAVES + wave; (void)lane; (void)gw
    const int vcu = (G % 8 == 0) ? (bx % 8) * (G / 8) + bx / 8 : bx;
    typedef const __attribute__((address_space(4))) Args* KArgs;
    const KArgs ka0 = (KArgs)__builtin_amdgcn_kernarg_segment_ptr();
#define KA() ({ KArgs p_ = ka0; asm volatile("" : "+s"(p_)); p_; })
#define WSP(T, off) ((T*)(A->ws + (off)))
#define DEF_WS() KArgs A = KA(); int* ctl = WSP(int, WS_CTL); float* mod = WSP(float, WS_MOD); float* ropeC = WSP(float, WS_ROPE); float* ropeS = ropeC + 512; float* scal = WSP(float, WS_SCAL); \
    bf16* Win = WSP(bf16, WS_WIN); bf16* Wout = WSP(bf16, WS_WOUT); bf16* Wgu = WSP(bf16, WS_WGU); bf16* Wdn = WSP(bf16, WS_WDN); \
    bf16* H = WSP(bf16, WS_H); bf16* X1 = WSP(bf16, WS_X1); float* X2C = WSP(float, WS_X2C); \
    int* ASGE = WSP(int, WS_TOK + TOK_AE); float* ASGW = WSP(float, WS_TOK + TOK_AW); int* SLOTOF = WSP(int, WS_TOK + TOK_SLOTOF); int* ROWTOK = WSP(int, WS_TOK + TOK_ROWTOK); float* ROWW = WSP(float, WS_TOK + TOK_ROWW); \
    bf16* Qb = WSP(bf16, WS_RA + RA_Q); bf16* Qcb = WSP(bf16, WS_RA + RA_QC); bf16* Kb = WSP(bf16, WS_RA + RA_K); bf16* Vb = WSP(bf16, WS_RA + RA_V); \
    bf16* CPU = WSP(bf16, WS_RA + RA_CPU); bf16* MIX = WSP(bf16, WS_RA + RA_MIX); bf16* XS = WSP(bf16, WS_RA); bf16* Y = WSP(bf16, WS_RA); bf16* ACT = WSP(bf16, WS_RB); \
    float* out = A->out; const float* xl = l == 0 ? A->in[0] : out; const float* xc = l == 0 ? A->in[2] : X2C; \
    const float* modl = mod + (size_t)l * 17 * NMOD * DM; int* ctll = ctl + l * CTL_LSTRIDE; int* wgcnt = ctl + CTL_WGCNT + l * CTL_WGCNT_L; \
    (void)ctl; (void)mod; (void)ropeC; (void)ropeS; (void)scal; (void)Win; (void)Wout; (void)Wgu; (void)Wdn; (void)H; (void)X1; (void)X2C; (void)ASGE; (void)ASGW; (void)SLOTOF; (void)ROWTOK; (void)ROWW; \
    (void)Qb; (void)Qcb; (void)Kb; (void)Vb; (void)CPU; (void)MIX; (void)XS; (void)Y; (void)ACT; (void)out; (void)xl; (void)xc; (void)modl; (void)ctll; (void)wgcnt
    LAS int* lctl = (LAS int*)(lds + LDS_CTL);
    for (int u = threadIdx.x; u < (LDS_BYTES - LDS_CTL) / 4; u += NTHR) ((LAS unsigned*)(lds + LDS_CTL))[u] = 0u;
    __syncthreads();
    XcdBarrier bar = xcd_barrier_post((unsigned*)(ka0->ws + WS_CTL) + CTL_BAR + ka0->bar_region * CTL_BAR_STRIDE, (volatile LAS unsigned*)(lds + LDS_BARW));
    const int lo = ka0->ph_lo, hi = ka0->ph_hi;
#define IN(k) (lo <= (k) && (k) < hi)
#define SEAM(k) do { if (IN(k) && IN((k) + 1)) xcd_barrier(bar); } while (0)

    if (IN(0)) {
        const int l = 0; PH_IDS(); DEF_WS();
        const float* cvec = A->in[1]; const float* c_ctx = A->in[3]; const float* w_mod = A->in[4]; const float* b_mod = A->in[5];
        const float* w_in = A->in[8]; const float* pool_w = A->in[17]; const float* pool_scale = A->in[18]; const float* w_out = A->in[19]; const float* w_gu = A->in[22]; const float* w_dn = A->in[24];
        if (bx < 192) {
            LAS float* sl = (LAS float*)lds + 8704;
            for (int i = tid; i < 17 * DM; i += NTHR) { const float cv = i < 16 * DM ? cvec[i] : c_ctx[i - 16 * DM]; sl[i] = cv / (1.0f + expf(-cv)); }
            __syncthreads();
        }
        for (int t = bx; t < 192; t += G) {
            LAS float* red = (LAS float*)lds;
            const LAS float* sl = (const LAS float*)lds + 8704;
            const int l = t / 96, nb = t % 96, n = nb * 64 + lane;
            float acc[17];
#pragma unroll
            for (int r = 0; r < 17; ++r) acc[r] = 0.f;
            const float* W = w_mod + (size_t)l * DM * (NMOD * DM) + n;
#pragma unroll 1
            for (int k0 = wave * 128; k0 < wave * 128 + 128; k0 += 16) {
                float wv[16];
#pragma unroll
                for (int i = 0; i < 16; ++i) wv[i] = W[(size_t)(k0 + i) * (NMOD * DM)];
#pragma unroll
                for (int i = 0; i < 16; ++i)
#pragma unroll
                    for (int r = 0; r < 17; ++r) acc[r] += sl[r * DM + k0 + i] * wv[i];
            }
#pragma unroll
            for (int r = 0; r < 17; ++r) red[(wave * 17 + r) * 64 + lane] = acc[r];
            __syncthreads();
            for (int idx = tid; idx < 17 * 64; idx += NTHR) {
                const int r = idx >> 6, ln = idx & 63; float sm = 0.f;
#pragma unroll
                for (int ww = 0; ww < 8; ++ww) sm += red[(ww * 17 + r) * 64 + ln];
                mod[((size_t)l * 17 + r) * (NMOD * DM) + nb * 64 + ln] = sm + b_mod[l * (NMOD * DM) + nb * 64 + ln];
            }
            __syncthreads();
        }
        if (bx == G - 1) {
            { const int pos = tid >> 3, pair = tid & 7; const float inv = powf(10000.0f, -(float)pair / 8.0f), ang = (float)pos * inv; ropeC[tid] = cosf(ang); ropeS[tid] = sinf(ang); }
            if (tid < DEPTH) {
                const float *lq1 = A->in[11] + tid * 32, *lk1 = A->in[12] + tid * 32, *lq2 = A->in[13] + tid * 32, *lk2 = A->in[14] + tid * 32;
                float s1 = 0.f, s2 = 0.f;
                for (int d = 0; d < 32; ++d) { s1 += lq1[d] * lk1[d]; s2 += lq2[d] * lk2[d]; }
                const float lam_init = 0.8f - 0.6f * expf(-0.3f * (float)tid);
                scal[tid * 2 + 0] = expf(s1) - expf(s2) + lam_init; scal[tid * 2 + 1] = lam_init;
            }
        }
        {
            const float* router_w = A->in[20]; bf16* wrt = WSP(bf16, WS_WRT);
            for (int i = bx * NTHR + tid; i < DEPTH * NEXP * DM; i += G * NTHR) {
                const int ll = i >> 15, e = (i >> 10) & 31, k = i & 1023; const float w = router_w[((size_t)ll * DM + k) * NEXP + e];
                const unsigned hb = f2bf(w); const float hf = __builtin_bit_cast(float, hb << 16);
                wrt[(size_t)ll * 65536 + e * DM + k] = (bf16)hb; wrt[(size_t)ll * 65536 + 32768 + e * DM + k] = (bf16)f2bf(w - hf);
            }
        }
        constexpr int I_OUTT = DEPTH * 4 * 24, I_FOLD = DEPTH * 16 * 4 * 4, I_OUT = I_OUTT + I_FOLD, I_IN = DEPTH * 10 * 32, I_GU = 0, I_DN = 0;
        for (int step = 0; ; ++step) {
            int it;
            if (G == 256) { if (bx >= 192) { if (step > 0) break; it = gw - 192 * NWAVES; if (it >= I_FOLD) break; } else { it = I_FOLD + gw + step * 192 * NWAVES; if (it >= I_OUT + I_IN + I_GU + I_DN) break; } }
            else { it = gw + step * NGW; if (it >= I_OUT + I_IN + I_GU + I_DN) break; }
            int r = it;
            if (r < I_FOLD) {
                const int i4 = r & 3, gi = (r >> 2) & 3, nb = (r >> 4) & 15, l = r >> 8, n = nb * 64 + lane;
                const float* wo = w_out + (size_t)l * DM * DM + (size_t)(768 + gi * 64) * DM + n;
                const float* __restrict__ wp = pool_w + (size_t)l * 16384 + gi * 4096; const float* __restrict__ ps = pool_scale + l * 256 + gi * 64;
                float v[16];
#pragma unroll
                for (int i = 0; i < 16; ++i) v[i] = 0.f;
                for (int cp = 0; cp < 64; ++cp) { const float w = wo[(size_t)cp * DM] * ps[cp];
#pragma unroll
                    for (int i = 0; i < 16; ++i) v[i] += wp[(i4 * 16 + i) * 64 + cp] * w; }
                u32x4 a, b2;
                a.x = f2bf(v[0]) | (f2bf(v[1]) << 16); a.y = f2bf(v[2]) | (f2bf(v[3]) << 16); a.z = f2bf(v[4]) | (f2bf(v[5]) << 16); a.w = f2bf(v[6]) | (f2bf(v[7]) << 16);
                b2.x = f2bf(v[8]) | (f2bf(v[9]) << 16); b2.y = f2bf(v[10]) | (f2bf(v[11]) << 16); b2.z = f2bf(v[12]) | (f2bf(v[13]) << 16); b2.w = f2bf(v[14]) | (f2bf(v[15]) << 16);
                u32x4* d = (u32x4*)(Wout + (size_t)l * DM * DM + (size_t)n * DM + 768 + gi * 64 + i4 * 16); d[0] = a; d[1] = b2;
                continue;
            }
            if (r < I_OUT) { const int q = r - I_FOLD, kb = q % 24, nb = (q / 24) & 3, l = q / 96; transpose_batch16w(w_out + (size_t)l * DM * DM, DM, nb, kb * 32, Wout + (size_t)l * DM * DM, 0, lane); continue; }
            r -= I_OUT;
            if (r < I_IN) { const int kb = r & 31, nb = (r >> 5) % 10, l = (r >> 5) / 10; transpose_batch16w(w_in + (size_t)l * DM * INW, INW, nb, kb * 32, Win + (size_t)l * INW * DM, 2, lane); continue; }
        }
    }
    SEAM(0);

    { constexpr int l = 0;
        const int pb = 1 + 9 * l; const bool has_next = l + 1 < DEPTH;
        const int nmoe = has_next ? TT : TL;

        if (IN(pb + 0) && l == 0) {
            PH_IDS(); DEF_WS(); const float* g = A->in[6] + l * DM;
            f32x4 vn[2][4];
            if (gw * 2 < TT) {
#pragma unroll
                for (int r = 0; r < 2; ++r) { const int row = gw * 2 + r; const float* src = row < TL ? xl + (size_t)row * DM : xc + (size_t)(row - TL) * DM;
#pragma unroll
                    for (int jj = 0; jj < 2; ++jj) { const int col = (lane + 64 * jj) * 8; vn[r][2 * jj] = *(const f32x4*)(src + col); vn[r][2 * jj + 1] = *(const f32x4*)(src + col + 4); } }
            }
            for (int row0 = gw * 2; row0 < TT; row0 += NGW * 2) {
                f32x4 v[2][4]; float ss[2];
#pragma unroll
                for (int r = 0; r < 2; ++r)
#pragma unroll
                    for (int j = 0; j < 4; ++j) v[r][j] = vn[r][j];
                if (row0 + NGW * 2 < TT) {
#pragma unroll
                    for (int r = 0; r < 2; ++r) { const int row = row0 + NGW * 2 + r; const float* src = row < TL ? xl + (size_t)row * DM : xc + (size_t)(row - TL) * DM;
#pragma unroll
                        for (int jj = 0; jj < 2; ++jj) { const int col = (lane + 64 * jj) * 8; vn[r][2 * jj] = *(const f32x4*)(src + col); vn[r][2 * jj + 1] = *(const f32x4*)(src + col + 4); } }
                }
#pragma unroll
                for (int r = 0; r < 2; ++r) {
                    const int row = row0 + r; ss[r] = 0.f;
#pragma unroll
                    for (int jj = 0; jj < 2; ++jj) { const int col = (lane + 64 * jj) * 8;
                        *(u32x4*)((bf16*)ACT + (size_t)row * DM + col) = pack8(v[r][2 * jj], v[r][2 * jj + 1]); }
                }
#pragma unroll
                for (int r = 0; r < 2; ++r) {
                    const int row = row0 + r; const int b = row < TL ? (row >> 12) : 16;
                    const float* sh = modl + (size_t)b * (NMOD * DM); const float* sc = sh + DM;
#pragma unroll
                    for (int j = 0; j < 4; ++j) ss[r] += (v[r][j].x * v[r][j].x + v[r][j].y * v[r][j].y) + (v[r][j].z * v[r][j].z + v[r][j].w * v[r][j].w);
                    const float rstd = __builtin_amdgcn_rsqf(wave_sum(ss[r]) * (1.0f / DM) + EPS);
#pragma unroll
                    for (int jj = 0; jj < 2; ++jj) {
                        const int col = (lane + 64 * jj) * 8; f32x4 y[2];
#pragma unroll
                        for (int h = 0; h < 2; ++h) y[h] = (v[r][2 * jj + h] * rstd) * *(const f32x4*)(g + col + 4 * h) * (*(const f32x4*)(sc + col + 4 * h) + 1.0f) + *(const f32x4*)(sh + col + 4 * h);
                        *(u32x4*)(H + (size_t)row * DM + col) = pack8(y[0], y[1]);
                    }
                }
            }
        }
        if (l == 0)
        SEAM(pb + 0);
        if (IN(pb + 1)) {
            PH_IDS(); DEF_WS(); const float* q_norm_g = A->in[9]; const float* k_norm_g = A->in[10];
            pg8::Gemm g{H, Win + (size_t)l * INW * DM, TT, INW, DM, 0}; InprojOrder S; S.init(has_next ? 10 : 4, G, bx);
            { PG8_LAS float* tb = (PG8_LAS float*)(lds + LDS_EPI);
              for (int i = tid; i < 1088; i += NTHR) tb[i] = i < 512 ? ropeC[i] : (i < 1024 ? ropeS[i - 512] : (i < 1056 ? q_norm_g[l * 32 + i - 1024] : k_norm_g[l * 32 + i - 1056]));
              __syncthreads(); }
            EpiInproj E{Qb, Qcb, Kb, Vb, CPU, (const PG8_LAS float*)(lds + LDS_EPI)};
            pg8::gemm_phase<EpiInproj, InprojOrder, true, true>(lds, g, S, E);
        }
        SEAM(pb + 1);
        if (IN(pb + 2)) {
            PH_IDS(); DEF_WS(); const float* subln_g = A->in[15]; const float* conv_w = A->in[16];
            {
                const float lam = scal[2 * l], oscale = 1.0f - scal[2 * l + 1]; const float* sg = subln_g + l * 64;
                const int vcu = (G % 8 == 0) ? (bx % 8) * (G / 8) + bx / 8 : bx;
                const int nunits = 2048 + (has_next ? 128 : 0);
                int xwb = gw;
                for (int u = vcu; u < nunits; u += G) {
                    const bool latq = u < 2048; const int i = u >> 8, v = u & 255;
                    const int bh = latq ? (v >> 5) * 16 + i * 2 + ((v & 31) >> 4) : u - 2048, qb = latq ? (v & 15) : 0;
                    const bf16* Qu = latq ? Qb + (size_t)bh * SEQ * 64 : Qcb + (size_t)bh * CTXL * 64;
                    bf16* mp = MIX + (latq ? ((size_t)(bh >> 3) * SEQ + qb * 256) : ((size_t)TL + (bh >> 3) * CTXL)) * DM + (bh & 7) * 64;
                    XwMid mid; mid.setup(l, xwb, A->in[22], A->in[24], (unsigned char*)Wgu, (unsigned char*)Wdn, lane);
                    fa::attn_unit(mid, lds, Qu, Kb + (size_t)bh * NKEY * 64, Vb + (size_t)bh * NKEY * 64, qb * 256, latq ? NKEY / 64 : CTXL / 64, lam, oscale, sg, mp, tid);
                    if (xwb < XW_BATCHES) xwb += NGW;
                }
                for (; xwb < XW_BATCHES; xwb += NGW) expert_weight_batch(l, xwb, A->in[22], A->in[24], (unsigned char*)Wgu, (unsigned char*)Wdn, lane);
            }
            {
                const int nrows = has_next ? TT : TL; const float* cw = conv_w + l * 768;
                for (int row0 = gw * 4; row0 < nrows; row0 += NGW * 4) {
                    const bool lat = row0 < TL; const int pos0 = lat ? (row0 & 4095) : ((row0 - TL) & 255), len = lat ? SEQ : CTXL;
                    const bf16* prow = CPU + (size_t)row0 * 768;
                    const bool cv = lane < 32; const int ch = (lane & 31) * 8, half = cv ? 1 : 1 << ((lane - 32) >> 3);
                    const int off0 = half, nk = cv ? 6 : 2 * half + 3, colA = cv ? ch : 512 + ch, colB = cv ? 256 + ch : 512 + ch;
                    u32x4 v[23];
#pragma unroll
                    for (int r = 0; r < 4; ++r) v[r] = *(const u32x4*)(prow + (size_t)r * 768 + colA);
#pragma unroll
                    for (int k = 0; k < 19; ++k) { const int ro = k - off0, p = pos0 + ro; v[4 + k] = (u32x4){0u, 0u, 0u, 0u}; if (k < nk && p >= 0 && p < len) v[4 + k] = *(const u32x4*)(prow + (long)ro * 768 + colB); }
                    if (cv) {
                        f32x4 w0[2], w1[2], w2[2];
#pragma unroll
                        for (int hh = 0; hh < 2; ++hh) { w0[hh] = *(const f32x4*)(cw + ch + 4 * hh); w1[hh] = *(const f32x4*)(cw + 256 + ch + 4 * hh); w2[hh] = *(const f32x4*)(cw + 512 + ch + 4 * hh); }
#pragma unroll
                        for (int r = 0; r < 4; ++r) {
                            f32x4 o[2];
#pragma unroll
                            for (int hh = 0; hh < 2; ++hh) {
                                const f32x4 m = (f32x4){bflo(v[4 + r][2 * hh]), bfhi(v[4 + r][2 * hh]), bflo(v[4 + r][2 * hh + 1]), bfhi(v[4 + r][2 * hh + 1])};
                                const f32x4 c = (f32x4){bflo(v[5 + r][2 * hh]), bfhi(v[5 + r][2 * hh]), bflo(v[5 + r][2 * hh + 1]), bfhi(v[5 + r][2 * hh + 1])};
                                const f32x4 p = (f32x4){bflo(v[6 + r][2 * hh]), bfhi(v[6 + r][2 * hh]), bflo(v[6 + r][2 * hh + 1]), bfhi(v[6 + r][2 * hh + 1])};
                                const f32x4 b = (f32x4){bflo(v[r][2 * hh]), bfhi(v[r][2 * hh]), bflo(v[r][2 * hh + 1]), bfhi(v[r][2 * hh + 1])};
                                o[hh] = b * (w0[hh] * m + w1[hh] * c + w2[hh] * p);
                            }
                            *(u32x4*)(MIX + (size_t)(row0 + r) * DM + 512 + ch) = pack8(o[0], o[1]);
                        }
                    } else {
                        f32x4 s0[4], s1[4];
#pragma unroll
                        for (int r = 0; r < 4; ++r) { s0[r] = (f32x4){0.f, 0.f, 0.f, 0.f}; s1[r] = (f32x4){0.f, 0.f, 0.f, 0.f}; }
#pragma unroll
                        for (int u = 0; u < 19; ++u) {
                            const u32x4 x = v[4 + u];
                            const f32x4 a0 = (f32x4){bflo(x.x), bfhi(x.x), bflo(x.y), bfhi(x.y)}, a1 = (f32x4){bflo(x.z), bfhi(x.z), bflo(x.w), bfhi(x.w)};
#pragma unroll
                            for (int r = 0; r < 4; ++r) { const bool in = (u >= r) && (u < r + 2 * half); const float m = in ? 1.0f : 0.0f; s0[r] += a0 * m; s1[r] += a1 * m; }
                        }
#pragma unroll
                        for (int r = 0; r < 4; ++r) {
                            const int pos = pos0 + r; const int cnt = min(pos + half, len) - max(pos - half, 0);
                            const u32x4 uc = v[r]; const float inv = 1.0f / (float)cnt;
                            const f32x4 d0 = s0[r] * inv - (f32x4){bflo(uc.x), bfhi(uc.x), bflo(uc.y), bfhi(uc.y)}, d1 = s1[r] * inv - (f32x4){bflo(uc.z), bfhi(uc.z), bflo(uc.w), bfhi(uc.w)};
                            *(u32x4*)(MIX + (size_t)(row0 + r) * DM + 768 + ch) = pack8(d0, d1);
                        }
                    }
                }
            }
        }
        SEAM(pb + 2);
        if (IN(pb + 3)) {
            PH_IDS(); DEF_WS();
            const int M = has_next ? TT : TL;
            pg8::Gemm g{MIX, Wout + (size_t)l * DM * DM, M, DM, DM, 0}; PlainOrder S; S.init(M, DM, G, bx);
            EpiResid E{(const bf16*)ACT, modl + 2 * DM, X1, lds};
            pg8::gemm_phase<EpiResid, PlainOrder, true, true>(lds, g, S, E);
        }
        SEAM(pb + 3);
        if (IN(pb + 4)) {
            PH_IDS(); DEF_WS(); const float* router_b = A->in[21]; const float* norm2_g = A->in[7];
            const bf16* wrt_hi = WSP(bf16, WS_WRT) + (size_t)l * 65536; const bf16* wrt_lo = wrt_hi + 32768;
            const float* br = router_b + l * NEXP; const float* g = norm2_g + l * DM;
            constexpr int TP = 2064;
            LAS unsigned char* Thi = lds; LAS unsigned char* Tlo = lds + 32 * TP; LAS unsigned char* PART = lds + 64 * TP; LAS float* LOG = (LAS float*)(lds + 64 * TP + 4096);
            static_assert(64 * TP + 8192 <= LDS_CTL, "router LDS map");
            const int eh = wave & 1, rh = (wave >> 1) & 1, kh = wave >> 2, n16 = lane & 15, q4 = lane >> 4;
            fa::bf16x8 ah[16];
#pragma unroll
            for (int st = 0; st < 16; ++st) { const int k = kh * 512 + 32 * st + 8 * q4;
                ah[st] = *(const fa::bf16x8*)(wrt_hi + (eh * 16 + n16) * DM + k); }
            const bf16* alp = wrt_lo + (eh * 16 + n16) * DM + kh * 512 + 8 * q4;
            const f32x4 brv = *(const f32x4*)(br + eh * 16 + 4 * q4);
            if (tid < 32) lctl[tid] = 0;
            __syncthreads();
            u32x4 xq[4][2];
            if (bx < nmoe / 32) {
#pragma unroll
                for (int rr = 0; rr < 4; ++rr)
#pragma unroll
                    for (int j = 0; j < 2; ++j) xq[rr][j] = *(const u32x4*)(X1 + (size_t)(bx * 32 + wave * 4 + rr) * DM + lane * 16 + 8 * j);
            }
            for (int grp = bx; grp < nmoe / 32; grp += G) {
                const int row0 = grp * 32; const int b = row0 < TL ? (row0 >> 12) : 16;
                const float* sh = modl + (size_t)b * (NMOD * DM) + 3 * DM; const float* sc = sh + DM;
                const int col = lane * 16;
                f32x4 gm[4], sv[4];
#pragma unroll
                for (int j = 0; j < 4; ++j) { gm[j] = *(const f32x4*)(g + col + 4 * j) * (*(const f32x4*)(sc + col + 4 * j) + 1.0f); sv[j] = *(const f32x4*)(sh + col + 4 * j); }
#pragma unroll
                for (int rr = 0; rr < 4; ++rr) {
                    const int rl = wave * 4 + rr, row = row0 + rl; f32x4 v[4]; float ss = 0.f;
#pragma unroll
                    for (int j = 0; j < 2; ++j) { const u32x4 xb = xq[rr][j]; v[2 * j] = (f32x4){bflo(xb.x), bfhi(xb.x), bflo(xb.y), bfhi(xb.y)}; v[2 * j + 1] = (f32x4){bflo(xb.z), bfhi(xb.z), bflo(xb.w), bfhi(xb.w)}; }
#pragma unroll
                    for (int j = 0; j < 4; ++j) ss += (v[j].x * v[j].x + v[j].y * v[j].y) + (v[j].z * v[j].z + v[j].w * v[j].w);
                    const float rstd = __builtin_amdgcn_rsqf(wave_sum(ss) * (1.0f / DM) + EPS);
                    u32x4 h8, hiw[2], low[2];
#pragma unroll
                    for (int j = 0; j < 4; ++j) {
                        const f32x4 h = (v[j] * rstd) * gm[j] + sv[j];
                        h8[j] = pk4_fp8(h.x, h.y, h.z, h.w);
                        const unsigned h0 = pg8::cvt_pk_bf16(h.x, h.y), h1 = pg8::cvt_pk_bf16(h.z, h.w);
                        hiw[j >> 1][2 * (j & 1)] = h0; hiw[j >> 1][2 * (j & 1) + 1] = h1;
                        low[j >> 1][2 * (j & 1)] = pg8::cvt_pk_bf16(h.x - bflo(h0), h.y - bfhi(h0)); low[j >> 1][2 * (j & 1) + 1] = pg8::cvt_pk_bf16(h.z - bflo(h1), h.w - bfhi(h1));
                    }
                    *(u32x4*)((unsigned char*)H + (size_t)row * DM + col) = h8;
#pragma unroll
                    for (int j = 0; j < 2; ++j) { *(LAS u32x4*)(Thi + rl * TP + col * 2 + 16 * j) = hiw[j]; *(LAS u32x4*)(Tlo + rl * TP + col * 2 + 16 * j) = low[j]; }
                }
                __syncthreads();
                if (grp + G < nmoe / 32) {
#pragma unroll
                    for (int rr = 0; rr < 4; ++rr)
#pragma unroll
                        for (int j = 0; j < 2; ++j) xq[rr][j] = *(const u32x4*)(X1 + (size_t)((grp + G) * 32 + wave * 4 + rr) * DM + lane * 16 + 8 * j);
                }
                f32x4 acc = (f32x4){0.f, 0.f, 0.f, 0.f};
#pragma unroll
                for (int st = 0; st < 16; ++st) {
                    const int kb = (kh * 512 + 32 * st + 8 * q4) * 2;
                    const fa::bf16x8 bh = *(const LAS fa::bf16x8*)(Thi + (rh * 16 + n16) * TP + kb), bl = *(const LAS fa::bf16x8*)(Tlo + (rh * 16 + n16) * TP + kb);
                    acc = __builtin_amdgcn_mfma_f32_16x16x32_bf16(ah[st], bh, acc, 0, 0, 0);
                    acc = __builtin_amdgcn_mfma_f32_16x16x32_bf16(ah[st], bl, acc, 0, 0, 0);
                    acc = __builtin_amdgcn_mfma_f32_16x16x32_bf16(*(const fa::bf16x8*)(alp + 32 * st), bh, acc, 0, 0, 0);
                }
                if (kh == 1) *(LAS f32x4*)(PART + (wave & 3) * 1024 + lane * 16) = acc;
                __syncthreads();
                if (kh == 0) { acc += *(const LAS f32x4*)(PART + (wave & 3) * 1024 + lane * 16); acc += brv; *(LAS f32x4*)(LOG + (rh * 16 + n16) * 32 + eh * 16 + 4 * q4) = acc; }
                __syncthreads();
                {
                    const int rr = lane >> 4, j16 = lane & 15, rl = wave * 4 + rr, tok = row0 + rl;
                    const f32x2v xx = *(const LAS f32x2v*)(LOG + rl * 32 + 2 * j16);
                    float x0 = xx[0], x1 = xx[1];
                    float bv[4]; int be[4];
#pragma unroll
                    for (int k = 0; k < 4; ++k) {
                        float v = x0 >= x1 ? x0 : x1; int e = x0 >= x1 ? 2 * j16 : 2 * j16 + 1;
#define TOP_STEP(CTRL) { const float v2 = dpp_movf<CTRL>(v); const int e2 = dpp_movi<CTRL>(e); const bool tk = (v2 > v) || (v2 == v && e2 < e); v = tk ? v2 : v; e = tk ? e2 : e; }
                        TOP_STEP(0xB1) TOP_STEP(0x4E) TOP_STEP(0x141) TOP_STEP(0x140)
#undef TOP_STEP
                        bv[k] = v; be[k] = e;
                        if (e == 2 * j16) x0 = -3.0e38f;
                        if (e == 2 * j16 + 1) x1 = -3.0e38f;
                    }
                    float pe[4], sm = 0.f;
#pragma unroll
                    for (int k = 0; k < 4; ++k) { pe[k] = expf(bv[k] - bv[0]); sm += pe[k]; }
                    if (j16 < 4) {
                        const int ek = j16 == 0 ? be[0] : j16 == 1 ? be[1] : j16 == 2 ? be[2] : be[3]; const float pk = j16 == 0 ? pe[0] : j16 == 1 ? pe[1] : j16 == 2 ? pe[2] : pe[3];
                        const int rank = atomicAdd((int*)(lctl + ek), 1);
                        ASGE[(size_t)tok * 4 + j16] = ek | (rank << 8); ASGW[(size_t)tok * 4 + j16] = pk / sm;
                    }
                }
            }
            __syncthreads();
            if (tid < 32) wgcnt[bx * 32 + tid] = lctl[tid];
        }
        SEAM(pb + 4);
        if (IN(pb + 5)) {
            PH_IDS(); DEF_WS();
            {
                LAS int* sc = (LAS int*)lds; const int e = tid & 31, part = tid >> 5, per = (G + 15) >> 4;
                int tot = 0, off = 0;
                for (int j = 0; j < per; ++j) { const int w = part * per + j; if (w < G) { const int cc = wgcnt[w * 32 + e]; tot += cc; if (w < bx) off += cc; } }
                sc[part * 32 + e] = tot; sc[512 + part * 32 + e] = off;
                __syncthreads();
                if (tid < 32) { int t2 = 0, o2 = 0;
#pragma unroll
                    for (int p = 0; p < 16; ++p) { t2 += sc[p * 32 + tid]; o2 += sc[512 + p * 32 + tid]; }
                    lctl[96 + tid] = t2; lctl[64 + tid] = o2; }
            }
            __syncthreads();
            if (tid == 0) {
                int blk = 0;
                for (int e = 0; e < NEXP; ++e) { lctl[32 + e] = blk * 256; blk += (lctl[96 + e] + 255) >> 8; }
                *(LAS int*)(lds + LDS_NBLK) = blk;
                if (bx == 0) ctll[CTL_NBLK] = blk;
            }
            __syncthreads();
            if (tid < NEXP) { const int b0 = lctl[32 + tid] >> 8, nb = (lctl[96 + tid] + 255) >> 8; for (int j = 0; j < nb; ++j) (lds + LDS_BTE)[b0 + j] = (unsigned char)tid; }
            if (bx == 0 && tid < NEXP) { const int b0 = lctl[32 + tid] >> 8, nb = (lctl[96 + tid] + 255) >> 8; for (int j = 0; j < nb; ++j) ctll[CTL_BLKE + b0 + j] = tid; }
            for (int e = bx; e < NEXP; e += G) {
                const int beg = lctl[32 + e] + lctl[96 + e], end = lctl[32 + e] + (((lctl[96 + e] + 255) >> 8) << 8);
                for (int s = beg + tid; s < end; s += NTHR) { ROWTOK[s] = 0; ROWW[s] = 0.f; }
            }
            for (int grp = bx; grp < nmoe / 32; grp += G) {
                if (tid < 128) {
                    const int tok = grp * 32 + (tid >> 2), k = tid & 3; const int ev = ASGE[(size_t)tok * 4 + k], e = ev & 255, rank = ev >> 8;
                    const int slot = lctl[32 + e] + lctl[64 + e] + rank;
                    ROWTOK[slot] = tok; ROWW[slot] = ASGW[(size_t)tok * 4 + k]; SLOTOF[(size_t)tok * 4 + k] = slot;
                }
            }
        }
        SEAM(pb + 5);
        if (IN(pb + 6)) {
            PH_IDS(); DEF_WS(); const float* b_gu = A->in[23];
            pg8::Gemm g{H, (const bf16*)((const unsigned char*)Wgu + (size_t)l * NEXP * 2048 * DM), 0, 2048, DM / 2, 0}; GroupedOrder S; S.init(lds, 8, 2048, G, bx, ROWTOK);
            EpiSwiglu E{ctll, b_gu + (size_t)l * NEXP * 2048, (unsigned char*)ACT, lds};
            pg8::gemm_phase<EpiSwiglu, GroupedOrder, true, true, true, true>(lds, g, S, E);
        }
        SEAM(pb + 6);
        if (IN(pb + 7)) {
            PH_IDS(); DEF_WS(); const float* b_dn = A->in[25];
            pg8::Gemm g{ACT, (const bf16*)((const unsigned char*)Wdn + (size_t)l * NEXP * DM * DM), 0, DM, DM / 2, 0}; GroupedOrder S; S.init(lds, 4, 1024, G, bx);
            EpiDown E{ctll, b_dn + (size_t)l * NEXP * DM, ROWW, (unsigned char*)Y, lds};
            pg8::gemm_phase<EpiDown, GroupedOrder, true, true, true>(lds, g, S, E);
        }
        SEAM(pb + 7);
        if (IN(pb + 8)) {
            PH_IDS(); DEF_WS();
            const float* g1n = A->in[6] + (has_next ? (l + 1) * DM : 0); const float* modn = mod + (size_t)(has_next ? l + 1 : l) * 17 * NMOD * DM;
            i32x4 sl4n[4];
            if (gw * 4 < nmoe) {
#pragma unroll
                for (int r = 0; r < 4; ++r) sl4n[r] = *(const i32x4*)(SLOTOF + (size_t)(gw * 4 + r) * 4);
            }
            for (int row0 = gw * 4; row0 < nmoe; row0 += NGW * 4) {
                const int b = row0 < TL ? (row0 >> 12) : 16;
                const float* gp = modl + (size_t)b * (NMOD * DM) + 5 * DM;
                const int col = lane * 8;
                i32x4 sl4[4];
#pragma unroll
                for (int r = 0; r < 4; ++r) sl4[r] = sl4n[r];
                if (row0 + NGW * 4 < nmoe) {
#pragma unroll
                    for (int r = 0; r < 4; ++r) sl4n[r] = *(const i32x4*)(SLOTOF + (size_t)(row0 + NGW * 4 + r) * 4);
                }
                u32x4 xb[4][2];
#pragma unroll
                for (int r = 0; r < 4; ++r) { xb[r][0] = *(const u32x4*)(X1 + (size_t)(row0 + r) * DM + col); xb[r][1] = *(const u32x4*)(X1 + (size_t)(row0 + r) * DM + 512 + col); }
                f32x4 gt[4], gm[4], sv[4];
#pragma unroll
                for (int q = 0; q < 4; ++q) gt[q] = *(const f32x4*)(gp + (q >> 1) * 512 + col + 4 * (q & 1)) * Y8_INV;
                if (has_next) { const float* sh = modn + (size_t)b * (NMOD * DM); const float* sc = sh + DM;
#pragma unroll
                    for (int q = 0; q < 4; ++q) { const int cq = (q >> 1) * 512 + col + 4 * (q & 1); gm[q] = *(const f32x4*)(g1n + cq) * (*(const f32x4*)(sc + cq) + 1.0f); sv[q] = *(const f32x4*)(sh + cq); } }
                u32x2 yv[4][4][2];
#pragma unroll
                for (int r = 0; r < 4; ++r)
#pragma unroll
                    for (int k = 0; k < 4; ++k) { yv[r][k][0] = *(const u32x2*)((const unsigned char*)Y + (size_t)sl4[r][k] * DM + col); yv[r][k][1] = *(const u32x2*)((const unsigned char*)Y + (size_t)sl4[r][k] * DM + 512 + col); }
#pragma unroll
                for (int r = 0; r < 4; ++r) {
                    const int row = row0 + r;
                    float* op = row < TL ? out + (size_t)row * DM : X2C + (size_t)(row - TL) * DM;
                    f32x4 a[4];
#pragma unroll
                    for (int q = 0; q < 4; ++q) a[q] = (f32x4){0.f, 0.f, 0.f, 0.f};
#pragma unroll
                    for (int k = 0; k < 4; ++k)
#pragma unroll
                        for (int q = 0; q < 4; ++q) { const unsigned y = yv[r][k][q >> 1][q & 1]; const auto lo = __builtin_amdgcn_cvt_pk_f32_fp8((int)y, false), hi = __builtin_amdgcn_cvt_pk_f32_fp8((int)y, true); a[q] += (f32x4){lo[0], lo[1], hi[0], hi[1]}; }
                    f32x4 xo[4]; float ss = 0.f;
#pragma unroll
                    for (int q = 0; q < 4; ++q) {
                        xo[q] = (f32x4){bflo(xb[r][q >> 1][(q & 1) * 2]), bfhi(xb[r][q >> 1][(q & 1) * 2]), bflo(xb[r][q >> 1][(q & 1) * 2 + 1]), bfhi(xb[r][q >> 1][(q & 1) * 2 + 1])} + gt[q] * a[q];
                        if (!has_next) *(f32x4*)(op + (q >> 1) * 512 + col + 4 * (q & 1)) = xo[q];
                    }
                    if (has_next) { *(u32x4*)((bf16*)ACT + (size_t)row * DM + col) = pack8(xo[0], xo[1]); *(u32x4*)((bf16*)ACT + (size_t)row * DM + 512 + col) = pack8(xo[2], xo[3]); }
                    if (has_next) {
#pragma unroll
                        for (int q = 0; q < 4; ++q) ss += (xo[q].x * xo[q].x + xo[q].y * xo[q].y) + (xo[q].z * xo[q].z + xo[q].w * xo[q].w);
                        const float rstd = __builtin_amdgcn_rsqf(wave_sum(ss) * (1.0f / DM) + EPS);
                        f32x4 y[4];
#pragma unroll
                        for (int q = 0; q < 4; ++q) y[q] = (xo[q] * rstd) * gm[q] + sv[q];
                        *(u32x4*)(H + (size_t)row * DM + col) = pack8(y[0], y[1]); *(u32x4*)(H + (size_t)row * DM + 512 + col) = pack8(y[2], y[3]);
                    }
                }
            }
        }
        SEAM(pb + 8);
    }
    { constexpr int l = 1;
        const int pb = 1 + 9 * l; const bool has_next = l + 1 < DEPTH;
        const int nmoe = has_next ? TT : TL;

        if (IN(pb + 0) && l == 0) {
            PH_IDS(); DEF_WS(); const float* g = A->in[6] + l * DM;
            f32x4 vn[2][4];
            if (gw * 2 < TT) {
#pragma unroll
                for (int r = 0; r < 2; ++r) { const int row = gw * 2 + r; const float* src = row < TL ? xl + (size_t)row * DM : xc + (size_t)(row - TL) * DM;
#pragma unroll
                    for (int jj = 0; jj < 2; ++jj) { const int col = (lane + 64 * jj) * 8; vn[r][2 * jj] = *(const f32x4*)(src + col); vn[r][2 * jj + 1] = *(const f32x4*)(src + col + 4); } }
            }
            for (int row0 = gw * 2; row0 < TT; row0 += NGW * 2) {
                f32x4 v[2][4]; float ss[2];
#pragma unroll
                for (int r = 0; r < 2; ++r)
#pragma unroll
                    for (int j = 0; j < 4; ++j) v[r][j] = vn[r][j];
                if (row0 + NGW * 2 < TT) {
#pragma unroll
                    for (int r = 0; r < 2; ++r) { const int row = row0 + NGW * 2 + r; const float* src = row < TL ? xl + (size_t)row * DM : xc + (size_t)(row - TL) * DM;
#pragma unroll
                        for (int jj = 0; jj < 2; ++jj) { const int col = (lane + 64 * jj) * 8; vn[r][2 * jj] = *(const f32x4*)(src + col); vn[r][2 * jj + 1] = *(const f32x4*)(src + col + 4); } }
                }
#pragma unroll
                for (int r = 0; r < 2; ++r) {
                    const int row = row0 + r; ss[r] = 0.f;
#pragma unroll
                    for (int jj = 0; jj < 2; ++jj) { const int col = (lane + 64 * jj) * 8;
                        *(u32x4*)((bf16*)ACT + (size_t)row * DM + col) = pack8(v[r][2 * jj], v[r][2 * jj + 1]); }
                }
#pragma unroll
                for (int r = 0; r < 2; ++r) {
                    const int row = row0 + r; const int b = row < TL ? (row >> 12) : 16;
                    const float* sh = modl + (size_t)b * (NMOD * DM); const float* sc = sh + DM;
#pragma unroll
                    for (int j = 0; j < 4; ++j) ss[r] += (v[r][j].x * v[r][j].x + v[r][j].y * v[r][j].y) + (v[r][j].z * v[r][j].z + v[r][j].w * v[r][j].w);
                    const float rstd = __builtin_amdgcn_rsqf(wave_sum(ss[r]) * (1.0f / DM) + EPS);
#pragma unroll
                    for (int jj = 0; jj < 2; ++jj) {
                        const int col = (lane + 64 * jj) * 8; f32x4 y[2];
#pragma unroll
                        for (int h = 0; h < 2; ++h) y[h] = (v[r][2 * jj + h] * rstd) * *(const f32x4*)(g + col + 4 * h) * (*(const f32x4*)(sc + col + 4 * h) + 1.0f) + *(const f32x4*)(sh + col + 4 * h);
                        *(u32x4*)(H + (size_t)row * DM + col) = pack8(y[0], y[1]);
                    }
                }
            }
        }
        if (l == 0)
        SEAM(pb + 0);
        if (IN(pb + 1)) {
            PH_IDS(); DEF_WS(); const float* q_norm_g = A->in[9]; const float* k_norm_g = A->in[10];
            pg8::Gemm g{H, Win + (size_t)l * INW * DM, TT, INW, DM, 0}; InprojOrder S; S.init(has_next ? 10 : 4, G, bx);
            { PG8_LAS float* tb = (PG8_LAS float*)(lds + LDS_EPI);
              for (int i = tid; i < 1088; i += NTHR) tb[i] = i < 512 ? ropeC[i] : (i < 1024 ? ropeS[i - 512] : (i < 1056 ? q_norm_g[l * 32 + i - 1024] : k_norm_g[l * 32 + i - 1056]));
              __syncthreads(); }
            EpiInproj E{Qb, Qcb, Kb, Vb, CPU, (const PG8_LAS float*)(lds + LDS_EPI)};
            pg8::gemm_phase<EpiInproj, InprojOrder, true, true>(lds, g, S, E);
        }
        SEAM(pb + 1);
        if (IN(pb + 2)) {
            PH_IDS(); DEF_WS(); const float* subln_g = A->in[15]; const float* conv_w = A->in[16];
            {
                const float lam = scal[2 * l], oscale = 1.0f - scal[2 * l + 1]; const float* sg = subln_g + l * 64;
                const int vcu = (G % 8 == 0) ? (bx % 8) * (G / 8) + bx / 8 : bx;
                const int nunits = 2048 + (has_next ? 128 : 0);
                int xwb = gw;
                for (int u = vcu; u < nunits; u += G) {
                    const bool latq = u < 2048; const int i = u >> 8, v = u & 255;
                    const int bh = latq ? (v >> 5) * 16 + i * 2 + ((v & 31) >> 4) : u - 2048, qb = latq ? (v & 15) : 0;
                    const bf16* Qu = latq ? Qb + (size_t)bh * SEQ * 64 : Qcb + (size_t)bh * CTXL * 64;
                    bf16* mp = MIX + (latq ? ((size_t)(bh >> 3) * SEQ + qb * 256) : ((size_t)TL + (bh >> 3) * CTXL)) * DM + (bh & 7) * 64;
                    XwMid mid; mid.setup(l, xwb, A->in[22], A->in[24], (unsigned char*)Wgu, (unsigned char*)Wdn, lane);
                    fa::attn_unit(mid, lds, Qu, Kb + (size_t)bh * NKEY * 64, Vb + (size_t)bh * NKEY * 64, qb * 256, latq ? NKEY / 64 : CTXL / 64, lam, oscale, sg, mp, tid);
                    if (xwb < XW_BATCHES) xwb += NGW;
                }
                for (; xwb < XW_BATCHES; xwb += NGW) expert_weight_batch(l, xwb, A->in[22], A->in[24], (unsigned char*)Wgu, (unsigned char*)Wdn, lane);
            }
            {
                const int nrows = has_next ? TT : TL; const float* cw = conv_w + l * 768;
                for (int row0 = gw * 4; row0 < nrows; row0 += NGW * 4) {
                    const bool lat = row0 < TL; const int pos0 = lat ? (row0 & 4095) : ((row0 - TL) & 255), len = lat ? SEQ : CTXL;
                    const bf16* prow = CPU + (size_t)row0 * 768;
                    const bool cv = lane < 32; const int ch = (lane & 31) * 8, half = cv ? 1 : 1 << ((lane - 32) >> 3);
                    const int off0 = half, nk = cv ? 6 : 2 * half + 3, colA = cv ? ch : 512 + ch, colB = cv ? 256 + ch : 512 + ch;
                    u32x4 v[23];
#pragma unroll
                    for (int r = 0; r < 4; ++r) v[r] = *(const u32x4*)(prow + (size_t)r * 768 + colA);
#pragma unroll
                    for (int k = 0; k < 19; ++k) { const int ro = k - off0, p = pos0 + ro; v[4 + k] = (u32x4){0u, 0u, 0u, 0u}; if (k < nk && p >= 0 && p < len) v[4 + k] = *(const u32x4*)(prow + (long)ro * 768 + colB); }
                    if (cv) {
                        f32x4 w0[2], w1[2], w2[2];
#pragma unroll
                        for (int hh = 0; hh < 2; ++hh) { w0[hh] = *(const f32x4*)(cw + ch + 4 * hh); w1[hh] = *(const f32x4*)(cw + 256 + ch + 4 * hh); w2[hh] = *(const f32x4*)(cw + 512 + ch + 4 * hh); }
#pragma unroll
                        for (int r = 0; r < 4; ++r) {
                            f32x4 o[2];
#pragma unroll
                            for (int hh = 0; hh < 2; ++hh) {
                                const f32x4 m = (f32x4){bflo(v[4 + r][2 * hh]), bfhi(v[4 + r][2 * hh]), bflo(v[4 + r][2 * hh + 1]), bfhi(v[4 + r][2 * hh + 1])};
                                const f32x4 c = (f32x4){bflo(v[5 + r][2 * hh]), bfhi(v[5 + r][2 * hh]), bflo(v[5 + r][2 * hh + 1]), bfhi(v[5 + r][2 * hh + 1])};
                                const f32x4 p = (f32x4){bflo(v[6 + r][2 * hh]), bfhi(v[6 + r][2 * hh]), bflo(v[6 + r][2 * hh + 1]), bfhi(v[6 + r][2 * hh + 1])};
                                const f32x4 b = (f32x4){bflo(v[r][2 * hh]), bfhi(v[r][2 * hh]), bflo(v[r][2 * hh + 1]), bfhi(v[r][2 * hh + 1])};
                                o[hh] = b * (w0[hh] * m + w1[hh] * c + w2[hh] * p);
                            }
                            *(u32x4*)(MIX + (size_t)(row0 + r) * DM + 512 + ch) = pack8(o[0], o[1]);
                        }
                    } else {
                        f32x4 s0[4], s1[4];
#pragma unroll
                        for (int r = 0; r < 4; ++r) { s0[r] = (f32x4){0.f, 0.f, 0.f, 0.f}; s1[r] = (f32x4){0.f, 0.f, 0.f, 0.f}; }
#pragma unroll
                        for (int u = 0; u < 19; ++u) {
                            const u32x4 x = v[4 + u];
                            const f32x4 a0 = (f32x4){bflo(x.x), bfhi(x.x), bflo(x.y), bfhi(x.y)}, a1 = (f32x4){bflo(x.z), bfhi(x.z), bflo(x.w), bfhi(x.w)};
#pragma unroll
                            for (int r = 0; r < 4; ++r) { const bool in = (u >= r) && (u < r + 2 * half); const float m = in ? 1.0f : 0.0f; s0[r] += a0 * m; s1[r] += a1 * m; }
                        }
#pragma unroll
                        for (int r = 0; r < 4; ++r) {
                            const int pos = pos0 + r; const int cnt = min(pos + half, len) - max(pos - half, 0);
                            const u32x4 uc = v[r]; const float inv = 1.0f / (float)cnt;
                            const f32x4 d0 = s0[r] * inv - (f32x4){bflo(uc.x), bfhi(uc.x), bflo(uc.y), bfhi(uc.y)}, d1 = s1[r] * inv - (f32x4){bflo(uc.z), bfhi(uc.z), bflo(uc.w), bfhi(uc.w)};
                            *(u32x4*)(MIX + (size_t)(row0 + r) * DM + 768 + ch) = pack8(d0, d1);
                        }
                    }
                }
            }
        }
        SEAM(pb + 2);
        if (IN(pb + 3)) {
            PH_IDS(); DEF_WS();
            const int M = has_next ? TT : TL;
            pg8::Gemm g{MIX, Wout + (size_t)l * DM * DM, M, DM, DM, 0}; PlainOrder S; S.init(M, DM, G, bx);
            EpiResid E{(const bf16*)ACT, modl + 2 * DM, X1, lds};
            pg8::gemm_phase<EpiResid, PlainOrder, true, true>(lds, g, S, E);
        }
        SEAM(pb + 3);
        if (IN(pb + 4)) {
            PH_IDS(); DEF_WS(); const float* router_b = A->in[21]; const float* norm2_g = A->in[7];
            const bf16* wrt_hi = WSP(bf16, WS_WRT) + (size_t)l * 65536; const bf16* wrt_lo = wrt_hi + 32768;
            const float* br = router_b + l * NEXP; const float* g = norm2_g + l * DM;
            constexpr int TP = 2064;
            LAS unsigned char* Thi = lds; LAS unsigned char* Tlo = lds + 32 * TP; LAS unsigned char* PART = lds + 64 * TP; LAS float* LOG = (LAS float*)(lds + 64 * TP + 4096);
            static_assert(64 * TP + 8192 <= LDS_CTL, "router LDS map");
            const int eh = wave & 1, rh = (wave >> 1) & 1, kh = wave >> 2, n16 = lane & 15, q4 = lane >> 4;
            fa::bf16x8 ah[16];
#pragma unroll
            for (int st = 0; st < 16; ++st) { const int k = kh * 512 + 32 * st + 8 * q4;
                ah[st] = *(const fa::bf16x8*)(wrt_hi + (eh * 16 + n16) * DM + k); }
            const bf16* alp = wrt_lo + (eh * 16 + n16) * DM + kh * 512 + 8 * q4;
            const f32x4 brv = *(const f32x4*)(br + eh * 16 + 4 * q4);
            if (tid < 32) lctl[tid] = 0;
            __syncthreads();
            u32x4 xq[4][2];
            if (bx < nmoe / 32) {
#pragma unroll
                for (int rr = 0; rr < 4; ++rr)
#pragma unroll
                    for (int j = 0; j < 2; ++j) xq[rr][j] = *(const u32x4*)(X1 + (size_t)(bx * 32 + wave * 4 + rr) * DM + lane * 16 + 8 * j);
            }
            for (int grp = bx; grp < nmoe / 32; grp += G) {
                const int row0 = grp * 32; const int b = row0 < TL ? (row0 >> 12) : 16;
                const float* sh = modl + (size_t)b * (NMOD * DM) + 3 * DM; const float* sc = sh + DM;
                const int col = lane * 16;
                f32x4 gm[4], sv[4];
#pragma unroll
                for (int j = 0; j < 4; ++j) { gm[j] = *(const f32x4*)(g + col + 4 * j) * (*(const f32x4*)(sc + col + 4 * j) + 1.0f); sv[j] = *(const f32x4*)(sh + col + 4 * j); }
#pragma unroll
                for (int rr = 0; rr < 4; ++rr) {
                    const int rl = wave * 4 + rr, row = row0 + rl; f32x4 v[4]; float ss = 0.f;
#pragma unroll
                    for (int j = 0; j < 2; ++j) { const u32x4 xb = xq[rr][j]; v[2 * j] = (f32x4){bflo(xb.x), bfhi(xb.x), bflo(xb.y), bfhi(xb.y)}; v[2 * j + 1] = (f32x4){bflo(xb.z), bfhi(xb.z), bflo(xb.w), bfhi(xb.w)}; }
#pragma unroll
                    for (int j = 0; j < 4; ++j) ss += (v[j].x * v[j].x + v[j].y * v[j].y) + (v[j].z * v[j].z + v[j].w * v[j].w);
                    const float rstd = __builtin_amdgcn_rsqf(wave_sum(ss) * (1.0f / DM) + EPS);
                    u32x4 h8, hiw[2], low[2];
#pragma unroll
                    for (int j = 0; j < 4; ++j) {
                        const f32x4 h = (v[j] * rstd) * gm[j] + sv[j];
                        h8[j] = pk4_fp8(h.x, h.y, h.z, h.w);
                        const unsigned h0 = pg8::cvt_pk_bf16(h.x, h.y), h1 = pg8::cvt_pk_bf16(h.z, h.w);
                        hiw[j >> 1][2 * (j & 1)] = h0; hiw[j >> 1][2 * (j & 1) + 1] = h1;
                        low[j >> 1][2 * (j & 1)] = pg8::cvt_pk_bf16(h.x - bflo(h0), h.y - bfhi(h0)); low[j >> 1][2 * (j & 1) + 1] = pg8::cvt_pk_bf16(h.z - bflo(h1), h.w - bfhi(h1));
                    }
                    *(u32x4*)((unsigned char*)H + (size_t)row * DM + col) = h8;
#pragma unroll
                    for (int j = 0; j < 2; ++j) { *(LAS u32x4*)(Thi + rl * TP + col * 2 + 16 * j) = hiw[j]; *(LAS u32x4*)(Tlo + rl * TP + col * 2 + 16 * j) = low[j]; }
                }
                __syncthreads();
                if (grp + G < nmoe / 32) {
#pragma unroll
                    for (int rr = 0; rr < 4; ++rr)
#pragma unroll
                        for (int j = 0; j < 2; ++j) xq[rr][j] = *(const u32x4*)(X1 + (size_t)((grp + G) * 32 + wave * 4 + rr) * DM + lane * 16 + 8 * j);
                }
                f32x4 acc = (f32x4){0.f, 0.f, 0.f, 0.f};
#pragma unroll
                for (int st = 0; st < 16; ++st) {
                    const int kb = (kh * 512 + 32 * st + 8 * q4) * 2;
                    const fa::bf16x8 bh = *(const LAS fa::bf16x8*)(Thi + (rh * 16 + n16) * TP + kb), bl = *(const LAS fa::bf16x8*)(Tlo + (rh * 16 + n16) * TP + kb);
                    acc = __builtin_amdgcn_mfma_f32_16x16x32_bf16(ah[st], bh, acc, 0, 0, 0);
                    acc = __builtin_amdgcn_mfma_f32_16x16x32_bf16(ah[st], bl, acc, 0, 0, 0);
                    acc = __builtin_amdgcn_mfma_f32_16x16x32_bf16(*(const fa::bf16x8*)(alp + 32 * st), bh, acc, 0, 0, 0);
                }
                if (kh == 1) *(LAS f32x4*)(PART + (wave & 3) * 1024 + lane * 16) = acc;
                __syncthreads();
                if (kh == 0) { acc += *(const LAS f32x4*)(PART + (wave & 3) * 1024 + lane * 16); acc += brv; *(LAS f32x4*)(LOG + (rh * 16 + n16) * 32 + eh * 16 + 4 * q4) = acc; }
                __syncthreads();
                {
                    const int rr = lane >> 4, j16 = lane & 15, rl = wave * 4 + rr, tok = row0 + rl;
                    const f32x2v xx = *(const LAS f32x2v*)(LOG + rl * 32 + 2 * j16);
                    float x0 = xx[0], x1 = xx[1];
                    float bv[4]; int be[4];
#pragma unroll
                    for (int k = 0; k < 4; ++k) {
                        float v = x0 >= x1 ? x0 : x1; int e = x0 >= x1 ? 2 * j16 : 2 * j16 + 1;
#define TOP_STEP(CTRL) { const float v2 = dpp_movf<CTRL>(v); const int e2 = dpp_movi<CTRL>(e); const bool tk = (v2 > v) || (v2 == v && e2 < e); v = tk ? v2 : v; e = tk ? e2 : e; }
                        TOP_STEP(0xB1) TOP_STEP(0x4E) TOP_STEP(0x141) TOP_STEP(0x140)
#undef TOP_STEP
                        bv[k] = v; be[k] = e;
                        if (e == 2 * j16) x0 = -3.0e38f;
                        if (e == 2 * j16 + 1) x1 = -3.0e38f;
                    }
                    float pe[4], sm = 0.f;
#pragma unroll
                    for (int k = 0; k < 4; ++k) { pe[k] = expf(bv[k] - bv[0]); sm += pe[k]; }
                    if (j16 < 4) {
                        const int ek = j16 == 0 ? be[0] : j16 == 1 ? be[1] : j16 == 2 ? be[2] : be[3]; const float pk = j16 == 0 ? pe[0] : j16 == 1 ? pe[1] : j16 == 2 ? pe[2] : pe[3];
                        const int rank = atomicAdd((int*)(lctl + ek), 1);
                        ASGE[(size_t)tok * 4 + j16] = ek | (rank << 8); ASGW[(size_t)tok * 4 + j16] = pk / sm;
                    }
                }
            }
            __syncthreads();
            if (tid < 32) wgcnt[bx * 32 + tid] = lctl[tid];
        }
        SEAM(pb + 4);
        if (IN(pb + 5)) {
            PH_IDS(); DEF_WS();
            {
                LAS int* sc = (LAS int*)lds; const int e = tid & 31, part = tid >> 5, per = (G + 15) >> 4;
                int tot = 0, off = 0;
                for (int j = 0; j < per; ++j) { const int w = part * per + j; if (w < G) { const int cc = wgcnt[w * 32 + e]; tot += cc; if (w < bx) off += cc; } }
                sc[part * 32 + e] = tot; sc[512 + part * 32 + e] = off;
                __syncthreads();
                if (tid < 32) { int t2 = 0, o2 = 0;
#pragma unroll
                    for (int p = 0; p < 16; ++p) { t2 += sc[p * 32 + tid]; o2 += sc[512 + p * 32 + tid]; }
                    lctl[96 + tid] = t2; lctl[64 + tid] = o2; }
            }
            __syncthreads();
            if (tid == 0) {
                int blk = 0;
                for (int e = 0; e < NEXP; ++e) { lctl[32 + e] = blk * 256; blk += (lctl[96 + e] + 255) >> 8; }
                *(LAS int*)(lds + LDS_NBLK) = blk;
                if (bx == 0) ctll[CTL_NBLK] = blk;
            }
            __syncthreads();
            if (tid < NEXP) { const int b0 = lctl[32 + tid] >> 8, nb = (lctl[96 + tid] + 255) >> 8; for (int j = 0; j < nb; ++j) (lds + LDS_BTE)[b0 + j] = (unsigned char)tid; }
            if (bx == 0 && tid < NEXP) { const int b0 = lctl[32 + tid] >> 8, nb = (lctl[96 + tid] + 255) >> 8; for (int j = 0; j < nb; ++j) ctll[CTL_BLKE + b0 + j] = tid; }
            for (int e = bx; e < NEXP; e += G) {
                const int beg = lctl[32 + e] + lctl[96 + e], end = lctl[32 + e] + (((lctl[96 + e] + 255) >> 8) << 8);
                for (int s = beg + tid; s < end; s += NTHR) { ROWTOK[s] = 0; ROWW[s] = 0.f; }
            }
            for (int grp = bx; grp < nmoe / 32; grp += G) {
                if (tid < 128) {
                    const int tok = grp * 32 + (tid >> 2), k = tid & 3; const int ev = ASGE[(size_t)tok * 4 + k], e = ev & 255, rank = ev >> 8;
                    const int slot = lctl[32 + e] + lctl[64 + e] + rank;
                    ROWTOK[slot] = tok; ROWW[slot] = ASGW[(size_t)tok * 4 + k]; SLOTOF[(size_t)tok * 4 + k] = slot;
                }
            }
        }
        SEAM(pb + 5);
        if (IN(pb + 6)) {
            PH_IDS(); DEF_WS(); const float* b_gu = A->in[23];
            pg8::Gemm g{H, (const bf16*)((const unsigned char*)Wgu + (size_t)l * NEXP * 2048 * DM), 0, 2048, DM / 2, 0}; GroupedOrder S; S.init(lds, 8, 2048, G, bx, ROWTOK);
            EpiSwiglu E{ctll, b_gu + (size_t)l * NEXP * 2048, (unsigned char*)ACT, lds};
            pg8::gemm_phase<EpiSwiglu, GroupedOrder, true, true, true, true>(lds, g, S, E);
        }
        SEAM(pb + 6);
        if (IN(pb + 7)) {
            PH_IDS(); DEF_WS(); const float* b_dn = A->in[25];
            pg8::Gemm g{ACT, (const bf16*)((const unsigned char*)Wdn + (size_t)l * NEXP * DM * DM), 0, DM, DM / 2, 0}; GroupedOrder S; S.init(lds, 4, 1024, G, bx);
            EpiDown E{ctll, b_dn + (size_t)l * NEXP * DM, ROWW, (unsigned char*)Y, lds};
            pg8::gemm_phase<EpiDown, GroupedOrder, true, true, true>(lds, g, S, E);
        }
        SEAM(pb + 7);
        if (IN(pb + 8)) {
            PH_IDS(); DEF_WS();
            const float* g1n = A->in[6] + (has_next ? (l + 1) * DM : 0); const float* modn = mod + (size_t)(has_next ? l + 1 : l) * 17 * NMOD * DM;
            i32x4 sl4n[4];
            if (gw * 4 < nmoe) {
#pragma unroll
                for (int r = 0; r < 4; ++r) sl4n[r] = *(const i32x4*)(SLOTOF + (size_t)(gw * 4 + r) * 4);
            }
            for (int row0 = gw * 4; row0 < nmoe; row0 += NGW * 4) {
                const int b = row0 < TL ? (row0 >> 12) : 16;
                const float* gp = modl + (size_t)b * (NMOD * DM) + 5 * DM;
                const int col = lane * 8;
                i32x4 sl4[4];
#pragma unroll
                for (int r = 0; r < 4; ++r) sl4[r] = sl4n[r];
                if (row0 + NGW * 4 < nmoe) {
#pragma unroll
                    for (int r = 0; r < 4; ++r) sl4n[r] = *(const i32x4*)(SLOTOF + (size_t)(row0 + NGW * 4 + r) * 4);
                }
                u32x4 xb[4][2];
#pragma unroll
                for (int r = 0; r < 4; ++r) { xb[r][0] = *(const u32x4*)(X1 + (size_t)(row0 + r) * DM + col); xb[r][1] = *(const u32x4*)(X1 + (size_t)(row0 + r) * DM + 512 + col); }
                f32x4 gt[4], gm[4], sv[4];
#pragma unroll
                for (int q = 0; q < 4; ++q) gt[q] = *(const f32x4*)(gp + (q >> 1) * 512 + col + 4 * (q & 1)) * Y8_INV;
                if (has_next) { const float* sh = modn + (size_t)b * (NMOD * DM); const float* sc = sh + DM;
#pragma unroll
                    for (int q = 0; q < 4; ++q) { const int cq = (q >> 1) * 512 + col + 4 * (q & 1); gm[q] = *(const f32x4*)(g1n + cq) * (*(const f32x4*)(sc + cq) + 1.0f); sv[q] = *(const f32x4*)(sh + cq); } }
                u32x2 yv[4][4][2];
#pragma unroll
                for (int r = 0; r < 4; ++r)
#pragma unroll
                    for (int k = 0; k < 4; ++k) { yv[r][k][0] = *(const u32x2*)((const unsigned char*)Y + (size_t)sl4[r][k] * DM + col); yv[r][k][1] = *(const u32x2*)((const unsigned char*)Y + (size_t)sl4[r][k] * DM + 512 + col); }
#pragma unroll
                for (int r = 0; r < 4; ++r) {
                    const int row = row0 + r;
                    float* op = row < TL ? out + (size_t)row * DM : X2C + (size_t)(row - TL) * DM;
                    f32x4 a[4];
#pragma unroll
                    for (int q = 0; q < 4; ++q) a[q] = (f32x4){0.f, 0.f, 0.f, 0.f};
#pragma unroll
                    for (int k = 0; k < 4; ++k)
#pragma unroll
                        for (int q = 0; q < 4; ++q) { const unsigned y = yv[r][k][q >> 1][q & 1]; const auto lo = __builtin_amdgcn_cvt_pk_f32_fp8((int)y, false), hi = __builtin_amdgcn_cvt_pk_f32_fp8((int)y, true); a[q] += (f32x4){lo[0], lo[1], hi[0], hi[1]}; }
                    f32x4 xo[4]; float ss = 0.f;
#pragma unroll
                    for (int q = 0; q < 4; ++q) {
                        xo[q] = (f32x4){bflo(xb[r][q >> 1][(q & 1) * 2]), bfhi(xb[r][q >> 1][(q & 1) * 2]), bflo(xb[r][q >> 1][(q & 1) * 2 + 1]), bfhi(xb[r][q >> 1][(q & 1) * 2 + 1])} + gt[q] * a[q];
                        if (!has_next) *(f32x4*)(op + (q >> 1) * 512 + col + 4 * (q & 1)) = xo[q];
                    }
                    if (has_next) { *(u32x4*)((bf16*)ACT + (size_t)row * DM + col) = pack8(xo[0], xo[1]); *(u32x4*)((bf16*)ACT + (size_t)row * DM + 512 + col) = pack8(xo[2], xo[3]); }
                    if (has_next) {
#pragma unroll
                        for (int q = 0; q < 4; ++q) ss += (xo[q].x * xo[q].x + xo[q].y * xo[q].y) + (xo[q].z * xo[q].z + xo[q].w * xo[q].w);
                        const float rstd = __builtin_amdgcn_rsqf(wave_sum(ss) * (1.0f / DM) + EPS);
                        f32x4 y[4];
#pragma unroll
                        for (int q = 0; q < 4; ++q) y[q] = (xo[q] * rstd) * gm[q] + sv[q];
                        *(u32x4*)(H + (size_t)row * DM + col) = pack8(y[0], y[1]); *(u32x4*)(H + (size_t)row * DM + 512 + col) = pack8(y[2], y[3]);
                    }
                }
            }
        }
        SEAM(pb + 8);
    }
#undef IN
#undef SEAM
}

#ifndef MK_SPLIT
#define MK_SPLIT 0
#endif
extern "C" void kernel_launch(void* const* d_in, const int* in_sizes, int n_in, void* d_out, int out_size, void* d_ws, size_t ws_size, hipStream_t stream) {
    static int grid = 0;
    if (grid == 0) {
        if (n_in != 26 || ws_size < WS_END) { fprintf(stderr, "kernel_launch: need 26 inputs and %zu bytes of workspace (got %d, %zu)\n", (size_t)WS_END, n_in, ws_size); grid = -1; return; }
        int dev = 0, cus = 0, per_cu = 0;
        if (hipGetDevice(&dev) != hipSuccess || hipDeviceGetAttribute(&cus, hipDeviceAttributeMultiprocessorCount, dev) != hipSuccess) { grid = -1; return; }
        if (hipFuncSetAttribute((const void*)mk_fwd, hipFuncAttributeMaxDynamicSharedMemorySize, LDS_BYTES) != hipSuccess) { fprintf(stderr, "kernel_launch: hipFuncSetAttribute failed\n"); grid = -1; return; }
        if (hipOccupancyMaxActiveBlocksPerMultiprocessor(&per_cu, (const void*)mk_fwd, NTHR, LDS_BYTES) != hipSuccess || per_cu < 1) { fprintf(stderr, "kernel_launch: occupancy query says %d\n", per_cu); }
        (void)hipGetLastError();
        grid = cus;
    }
    if (grid < 0) return;
    (void)hipMemsetAsync((char*)d_ws + WS_CTL, 0, 1 * MiB, stream);
    Args a; memset(&a, 0, sizeof(a));
    for (int i = 0; i < 26; ++i) a.in[i] = (const float*)d_in[i];
    a.out = (float*)d_out; a.ws = (unsigned char*)d_ws;
#if MK_SPLIT
    for (int p = 0; p < NPHASE; ++p) { a.ph_lo = p; a.ph_hi = p + 1; a.bar_region = p; hipLaunchKernelGGL(mk_fwd, dim3(grid), dim3(NTHR), LDS_BYTES, stream, a); }
#else
    a.ph_lo = 0; a.ph_hi = NPHASE; a.bar_region = 0;
    hipLaunchKernelGGL(mk_fwd, dim3(grid), dim3(NTHR), LDS_BYTES, stream, a);
#endif
}
```

```cpp
#include <hip/hip_runtime.h>
#include <cstdio>
#include <cstdint>
#include <cstring>
namespace pg8 {
#define PG8_LAS __attribute__((address_space(3)))
typedef unsigned short bf16_t;
typedef short bf16x8 __attribute__((ext_vector_type(8)));
typedef float f32x4 __attribute__((ext_vector_type(4)));
typedef unsigned u32x4 __attribute__((ext_vector_type(4)));
typedef int pg8_v4i __attribute__((ext_vector_type(4)));
typedef int pg8_v8i __attribute__((ext_vector_type(8)));
constexpr int BM = 256, BK = 64, HALF = 128, HTB = HALF * BK * 2  , STAGE_BYTES = 8 * HTB, NXCD = 8, WGM = 8;

__host__ __device__ __forceinline__ int lds_byte(int r, int c) { const int st = (r >> 4) * 2 + (c >> 5), rr = r & 15, cc = c & 31, ob = rr * 64 + cc * 2; return st * 1024 + (ob ^ (((ob >> 9) & 1) << 5)); }
__host__ __device__ __forceinline__ void stage_rc(int b, int& R, int& C) { const int st = b / 1024, sb = b % 1024, swz = sb ^ (((sb >> 9) & 1) << 5); R = (st >> 1) * 16 + swz / 64; C = (st & 1) * 32 + (swz % 64) / 2; }
__host__ __device__ __forceinline__ int perm32(int rho) { const int n = rho >> 4, i = rho & 15; return 8 * (i >> 2) + 4 * n + (i & 3); }

struct Unit { int pm, pn; };
struct Gemm { const bf16_t* A; const bf16_t* Bt; int M, N, K, pad; };

struct StaticOrder {
    int nM, nN, nwg, G, c;
    __host__ __device__ void init(int M, int N, int G_, int c_) { nM = M / BM; nN = N / BM; nwg = nM * nN; G = G_; c = c_; }
    __host__ __device__ bool next(int i, Unit& u) const {
        const long L = (long)i * G + c; if (L >= nwg) return false;
        int wgid = (int)L; { const int q = nwg / NXCD, r = nwg % NXCD, xcd = wgid % NXCD, off = wgid / NXCD; wgid = (xcd < r ? xcd * (q + 1) : r * (q + 1) + (xcd - r) * q) + off; }
        const int nig = WGM * nN, gid = wgid / nig, fm = gid * WGM, gsz = (nM - fm) < WGM ? (nM - fm) : WGM;
        u.pm = fm + ((wgid % nig) % gsz); u.pn = (wgid % nig) / gsz; return true;
    }
    __device__ __forceinline__ int brow(const Unit& u) const { return u.pn * BM; }
    static constexpr const int* rowtok = nullptr;
    __device__ __forceinline__ void a_ready(const Unit&) const {}
    __device__ __forceinline__ void done(const Unit&) const {}
};

__device__ __forceinline__ unsigned cvt_pk_bf16(float lo, float hi) { unsigned r; asm volatile("v_cvt_pk_bf16_f32 %0, %1, %2" : "=v"(r) : "v"(lo), "v"(hi)); return r; }
typedef float f32x2 __attribute__((ext_vector_type(2)));
template <class Epi, class Sched, bool ALIGN_EPI = false, bool SP2 = false, bool FP8 = false, bool GATHER = false>
__device__ __forceinline__ void gemm_phase(PG8_LAS unsigned char* lds, const Gemm g, const Sched& S, const Epi& E) {
    int tid_l = threadIdx.x; asm volatile("" : "+v"(tid_l));
    const int tid = tid_l, wid = __builtin_amdgcn_readfirstlane(tid >> 6), lane = tid & 63, wr = wid >> 2, wc = wid & 3, fr = lane & 15, fq = lane >> 4;
    const int K = g.K, nt = K / BK;
    unsigned voffA[2], voffB[2]; int gR[2]; unsigned gC[2];
#pragma unroll
    for (int i = 0; i < 2; ++i) { int R, C; stage_rc(tid * 16 + i * 8192, R, C); const int Rb = Epi::PERM ? ((R & ~31) + perm32(R & 31)) : R;
        voffA[i] = (unsigned)(R * K + C) * 2u; voffB[i] = (unsigned)(Rb * K + C) * 2u; gR[i] = R; gC[i] = (unsigned)C * 2u; }
    static_assert(!GATHER || SP2, "GATHER is written for the SP2 loop");
    unsigned gcur[2][2] = {{0u, 0u}, {0u, 0u}}, gnxt[2][2] = {{0u, 0u}, {0u, 0u}}, graw[2][2] = {{0u, 0u}, {0u, 0u}};
#define PG8_GLOAD(gv, u) do { _Pragma("unroll") for (int h_ = 0; h_ < 2; ++h_) _Pragma("unroll") for (int i_ = 0; i_ < 2; ++i_) gv[h_][i_] = (unsigned)S.rowtok[(u).pm * BM + h_ * HALF + gR[i_]] * (unsigned)(K * 2) + gC[i_]; } while (0)
    const size_t kstep = (size_t)(BK * 2);
    const size_t hstep = (size_t)HALF * K * 2;
    const size_t tstep = 2 * hstep;
    const unsigned ldsw = (unsigned)wid * 1024u;
    const int aoff = lds_byte(wr * 64 + fr, fq * 8), boff = lds_byte(wc * 32 + fr, fq * 8);
#define PG8_CAT8(x, y) __builtin_shufflevector(__builtin_bit_cast(pg8_v4i, (x)), __builtin_bit_cast(pg8_v4i, (y)), 0, 1, 2, 3, 4, 5, 6, 7)
#define PG8_SA(b, h) (((b) * 2 + (h)) * HTB)
#define PG8_SB(b, h) ((4 + (b) * 2 + (h)) * HTB)
#define PG8_STAGE(bufoff, gbase, voff) do { _Pragma("unroll") for (int _i = 0; _i < 2; ++_i) \
        __builtin_amdgcn_global_load_lds((const unsigned*)((const char*)(gbase) + (voff)[_i]), (PG8_LAS unsigned*)(lds + (bufoff) + ldsw + _i * 8192), 16, 0, 0); } while (0)
#define PG8_STAGE_A(bufoff, kbase, h, gv) do { if constexpr (GATHER) { PG8_STAGE(bufoff, kbase, (gv)[h]); } else { PG8_STAGE(bufoff, (kbase) + (h) * hstep, voffA); } } while (0)
#define PG8_LDA(dst, b, h) do { _Pragma("unroll") for (int m = 0; m < 4; ++m) { if constexpr (FP8) dst##8[m] = PG8_CAT8(*(const PG8_LAS bf16x8*)(lds + PG8_SA(b, h) + aoff + m * 2048), *(const PG8_LAS bf16x8*)(lds + PG8_SA(b, h) + aoff + m * 2048 + 1024)); \
        else { _Pragma("unroll") for (int k = 0; k < 2; ++k) dst[m][k] = *(const PG8_LAS bf16x8*)(lds + PG8_SA(b, h) + aoff + m * 2048 + k * 1024); } } } while (0)
#define PG8_LDB(dst, b, h) do { _Pragma("unroll") for (int n = 0; n < 2; ++n) { if constexpr (FP8) dst##8[n] = PG8_CAT8(*(const PG8_LAS bf16x8*)(lds + PG8_SB(b, h) + boff + n * 2048), *(const PG8_LAS bf16x8*)(lds + PG8_SB(b, h) + boff + n * 2048 + 1024)); \
        else { _Pragma("unroll") for (int k = 0; k < 2; ++k) dst[n][k] = *(const PG8_LAS bf16x8*)(lds + PG8_SB(b, h) + boff + n * 2048 + k * 1024); } } } while (0)
#define PG8_MMA(ai, bj, At, Bt) do { __builtin_amdgcn_s_setprio(1); _Pragma("unroll") for (int m = 0; m < 4; ++m) _Pragma("unroll") for (int n = 0; n < 2; ++n) { \
        if constexpr (FP8) asm volatile("v_mfma_f32_16x16x128_f8f6f4 %0, %1, %2, %0" : "+v"(acc[ai][bj][m][n]) : "v"(Bt##8[n]), "v"(At##8[m]));     \
        else { _Pragma("unroll") for (int k = 0; k < 2; ++k) acc[ai][bj][m][n] = __builtin_amdgcn_mfma_f32_16x16x32_bf16(Bt[n][k], At[m][k], acc[ai][bj][m][n], 0, 0, 0); } } __builtin_amdgcn_s_setprio(0); } while (0)
#define PG8_WAIT_V(n) asm volatile("s_waitcnt vmcnt(" #n ")" ::: "memory")
#define PG8_WAIT_L(n) asm volatile("s_waitcnt lgkmcnt(" #n ")" ::: "memory")
#define PG8_BAR __builtin_amdgcn_s_barrier()
#define PG8_SCHED __builtin_amdgcn_sched_barrier(0)
    Unit cur, nxt; int ui = 0;
    if (!S.next(0, cur)) return;
    f32x4 acc[2][2][4][2];
#pragma unroll
    for (int a = 0; a < 2; ++a)
#pragma unroll
        for (int b = 0; b < 2; ++b)
#pragma unroll
            for (int m = 0; m < 4; ++m)
#pragma unroll
                for (int n = 0; n < 2; ++n) acc[a][b][m][n] = (f32x4){0.f, 0.f, 0.f, 0.f};
    bf16x8 At[4][2], B0[2][2], B1[2][2]; pg8_v8i At8[4], B08[2], B18[2];
    const char* cA = (const char*)g.A + (GATHER ? (size_t)0 : (size_t)cur.pm * tstep); if constexpr (GATHER) PG8_GLOAD(gcur, cur);
    const char* cB = (const char*)g.Bt + (size_t)S.brow(cur) * (size_t)K * 2;
    S.a_ready(cur);
    if constexpr (SP2) {
        PG8_STAGE(PG8_SB(0, 0), cB, voffB); PG8_STAGE(PG8_SB(0, 1), cB + hstep, voffB); PG8_STAGE_A(PG8_SA(0, 0), cA, 0, gcur); PG8_STAGE_A(PG8_SA(0, 1), cA, 1, gcur);
        if (wr == 1) PG8_BAR;
        PG8_WAIT_V(2); PG8_BAR;
        PG8_STAGE(PG8_SB(1, 0), cB + kstep, voffB); PG8_STAGE_A(PG8_SA(1, 0), cA + kstep, 0, gcur); PG8_STAGE(PG8_SB(1, 1), cB + hstep + kstep, voffB);
        PG8_WAIT_V(6); PG8_BAR;
    } else {
        PG8_STAGE(PG8_SB(0, 0), cB, voffB); PG8_STAGE(PG8_SA(0, 0), cA, voffA); PG8_STAGE(PG8_SB(0, 1), cB + hstep, voffB); PG8_STAGE(PG8_SA(0, 1), cA + hstep, voffA);
        if (wr == 1) PG8_BAR;
        PG8_WAIT_V(4); PG8_BAR;
        PG8_STAGE(PG8_SB(1, 0), cB + kstep, voffB); PG8_STAGE(PG8_SA(1, 0), cA + kstep, voffA); PG8_STAGE(PG8_SB(1, 1), cB + hstep + kstep, voffB);
        PG8_WAIT_V(6); PG8_BAR;
    }
    for (;;) {
        const bool has_next = S.next(ui + 1, nxt);
        const char* nA = (has_next && !GATHER) ? (const char*)g.A + (size_t)nxt.pm * tstep : cA; const char* nB = has_next ? (const char*)g.Bt + (size_t)S.brow(nxt) * (size_t)K * 2 : cB;
#pragma nounroll
        for (int t = 0; t < nt; t += 2) {
            const bool last = (t == nt - 2);
            const char* a1 = cA + (size_t)(t + 1) * kstep;
            const char* a2 = last ? nA : cA + (size_t)(t + 2) * kstep; const char* b2 = last ? nB : cB + (size_t)(t + 2) * kstep;
            const char* a3 = a2 + kstep; const char* b3 = b2 + kstep;
            if (last && has_next) S.a_ready(nxt);
            if (last) E.pre(cur, wid, lane);
            if constexpr (GATHER) { if (t == nt - 4 && has_next) { _Pragma("unroll") for (int h_ = 0; h_ < 2; ++h_) _Pragma("unroll") for (int i_ = 0; i_ < 2; ++i_)
                asm volatile("global_load_dword %0, %1, off" : "+v"(graw[h_][i_]) : "v"(S.rowtok + (nxt.pm * BM + h_ * HALF + gR[i_])) : "memory"); } }
            unsigned gsel[2][2];
            if constexpr (GATHER) { _Pragma("unroll") for (int h_ = 0; h_ < 2; ++h_) _Pragma("unroll") for (int i_ = 0; i_ < 2; ++i_) { if (last && has_next) gnxt[h_][i_] = graw[h_][i_] * (unsigned)(K * 2) + gC[i_]; gsel[h_][i_] = (last && has_next) ? gnxt[h_][i_] : gcur[h_][i_]; } }
            if constexpr (SP2) {
            PG8_LDB(B0, 0, 0); PG8_LDB(B1, 0, 1); PG8_SCHED; PG8_LDA(At, 0, 0); PG8_STAGE_A(PG8_SA(1, 1), a1, 1, gcur);
            PG8_WAIT_V(8); PG8_WAIT_L(0); PG8_BAR; PG8_MMA(0, 0, At, B0); PG8_MMA(0, 1, At, B1); PG8_BAR; PG8_SCHED;
            PG8_LDA(At, 0, 1); PG8_STAGE(PG8_SB(0, 0), b2, voffB); PG8_STAGE(PG8_SB(0, 1), b2 + hstep, voffB); PG8_STAGE_A(PG8_SA(0, 0), a2, 0, gsel);
            PG8_WAIT_V(8); PG8_WAIT_L(0); PG8_BAR; PG8_MMA(1, 0, At, B0); PG8_MMA(1, 1, At, B1); PG8_BAR; PG8_SCHED;
            PG8_LDB(B0, 1, 0); PG8_LDB(B1, 1, 1); PG8_SCHED; PG8_LDA(At, 1, 0); PG8_STAGE_A(PG8_SA(0, 1), a2, 1, gsel);
            PG8_WAIT_V(8); PG8_WAIT_L(0); PG8_BAR; PG8_MMA(0, 0, At, B0); PG8_MMA(0, 1, At, B1); PG8_BAR; PG8_SCHED;
            PG8_LDA(At, 1, 1); PG8_STAGE(PG8_SB(1, 0), b3, voffB); PG8_STAGE(PG8_SB(1, 1), b3 + hstep, voffB); PG8_STAGE_A(PG8_SA(1, 0), a3, 0, gsel);
            PG8_WAIT_V(8); PG8_WAIT_L(0); PG8_BAR; PG8_MMA(1, 0, At, B0); PG8_MMA(1, 1, At, B1); PG8_BAR; PG8_SCHED;
            } else {
            PG8_LDB(B0, 0, 0); PG8_SCHED; PG8_LDA(At, 0, 0); PG8_STAGE(PG8_SA(1, 1), a1 + hstep, voffA);
            PG8_WAIT_L(8); PG8_BAR; PG8_WAIT_L(0); PG8_MMA(0, 0, At, B0); PG8_BAR; PG8_SCHED;
            PG8_LDB(B1, 0, 1); PG8_STAGE(PG8_SB(0, 0), b2, voffB);
            PG8_BAR; PG8_WAIT_L(0); PG8_MMA(0, 1, At, B1); PG8_BAR;
            PG8_LDA(At, 0, 1); PG8_STAGE(PG8_SA(0, 0), a2, voffA);
            PG8_BAR; PG8_WAIT_L(0); PG8_MMA(1, 0, At, B0); PG8_BAR; PG8_SCHED;
            PG8_STAGE(PG8_SB(0, 1), b2 + hstep, voffB);
            PG8_WAIT_V(6); PG8_BAR; PG8_MMA(1, 1, At, B1); PG8_BAR;
            PG8_LDB(B0, 1, 0); PG8_SCHED; PG8_LDA(At, 1, 0); PG8_STAGE(PG8_SA(0, 1), a2 + hstep, voffA);
            PG8_WAIT_L(8); PG8_BAR; PG8_WAIT_L(0); PG8_MMA(0, 0, At, B0); PG8_BAR; PG8_SCHED;
            PG8_LDB(B1, 1, 1); PG8_STAGE(PG8_SB(1, 0), b3, voffB);
            PG8_BAR; PG8_WAIT_L(0); PG8_MMA(0, 1, At, B1); PG8_BAR;
            PG8_LDA(At, 1, 1); PG8_STAGE(PG8_SA(1, 0), a3, voffA);
            PG8_BAR; PG8_WAIT_L(0); PG8_MMA(1, 0, At, B0); PG8_BAR; PG8_SCHED;
            PG8_STAGE(PG8_SB(1, 1), b3 + hstep, voffB);
            PG8_WAIT_V(6); PG8_BAR; PG8_MMA(1, 1, At, B1); PG8_BAR;
            }
        }
        if constexpr (FP8) asm volatile("s_nop 15\n\ts_nop 15" ::: "memory");
        if constexpr (ALIGN_EPI) { if (wr == 0) PG8_BAR; }
        if constexpr (!Epi::AFTER_DRAIN) { E(acc, cur, wr, wc, fr, fq); S.done(cur); }
        if (!has_next) break;
#pragma unroll
        for (int a = 0; a < 2; ++a)
#pragma unroll
            for (int b = 0; b < 2; ++b)
#pragma unroll
                for (int m = 0; m < 4; ++m)
#pragma unroll
                    for (int n = 0; n < 2; ++n) acc[a][b][m][n] = (f32x4){0.f, 0.f, 0.f, 0.f};
        cur = nxt; cA = nA; cB = nB; ++ui;
        if constexpr (GATHER) { _Pragma("unroll") for (int h_ = 0; h_ < 2; ++h_) _Pragma("unroll") for (int i_ = 0; i_ < 2; ++i_) gcur[h_][i_] = gnxt[h_][i_]; }
        if constexpr (ALIGN_EPI) { if (wr == 1) PG8_BAR; }
    }
    PG8_WAIT_V(0);
    if constexpr (!ALIGN_EPI) { if (wr == 0) PG8_BAR; }
    PG8_BAR;
    if constexpr (Epi::AFTER_DRAIN) { E.fused(acc, cur, wr, wc, fr, fq, lds, wid, lane); S.done(cur); }
#undef PG8_SA
#undef PG8_SB
#undef PG8_STAGE
#undef PG8_STAGE_A
#undef PG8_GLOAD
#undef PG8_LDA
#undef PG8_LDB
#undef PG8_MMA
#undef PG8_CAT8
#undef PG8_WAIT_V
#undef PG8_WAIT_L
#undef PG8_BAR
#undef PG8_SCHED
}
}


constexpr int NB = 16, SEQ = 4096, DM = 1024, CTXL = 256, DEPTH = 2, INW = 2560, NEXP = 32, TOPK = 4;
constexpr int TL = NB * SEQ, TC = NB * CTXL, TT = TL + TC;
constexpr int NH = 8, NKEY = SEQ + CTXL;
constexpr int MAXBLK = 1120;
constexpr int NMOD = 6;
constexpr float EPS = 1e-6f;
constexpr float QSCALE = 0.17677669529663687f * 1.4426950408889634f;
constexpr float SMAX2 = 12.0f;

typedef unsigned short bf16;
typedef float f32x4 __attribute__((ext_vector_type(4)));
typedef unsigned u32x4 __attribute__((ext_vector_type(4)));
typedef unsigned u32x2 __attribute__((ext_vector_type(2)));

constexpr size_t MiB = 1u << 20;
constexpr size_t WS_CTL = 0, WS_MOD = 1 * MiB, WS_ROPE = 2 * MiB, WS_SCAL = 3 * MiB, WS_WIN = 4 * MiB, WS_WOUT = 14 * MiB, WS_WGU = 18 * MiB, WS_WDN = 274 * MiB;
constexpr size_t WS_H = 402 * MiB, WS_X1 = 538 * MiB, WS_X2C = 810 * MiB, WS_TOK = 826 * MiB, WS_RA = 858 * MiB, WS_RB = 1418 * MiB, WS_END = 1978 * MiB;
constexpr size_t TOK_AE = 0, TOK_AW = 2 * MiB, TOK_SLOTOF = 4 * MiB, TOK_ROWTOK = 6 * MiB, TOK_ROWW = 8 * MiB;
constexpr size_t RA_Q = 0, RA_QC = 64 * MiB, RA_K = 68 * MiB, RA_V = 136 * MiB, RA_CPU = 204 * MiB, RA_MIX = 306 * MiB;
constexpr int CTL_LSTRIDE = 4096, CTL_NBLK = 96, CTL_BLKE = 128;
constexpr int CTL_WGCNT = 8192, CTL_WGCNT_L = 8192;
constexpr int CTL_BAR = 32768, CTL_BAR_STRIDE = 4096;

constexpr int NWAVES = 8, NTHR = 512;
constexpr int LDS_SCR = 131072, LDS_CTL = 143360, LDS_BARW = LDS_CTL + 512, LDS_BYTES = 147456;
constexpr size_t WS_WRT = WS_SCAL + 65536;
constexpr int NPHASE = 1 + 9 * DEPTH;

typedef int i32x4 __attribute__((ext_vector_type(4)));
__device__ __forceinline__ unsigned f2bf(float f) { unsigned u = __builtin_bit_cast(unsigned, f); return (u + 0x7fffu + ((u >> 16) & 1u)) >> 16; }
__device__ __forceinline__ float bf2f(unsigned short b) { return __builtin_bit_cast(float, ((unsigned)b) << 16); }
__device__ __forceinline__ float bflo(unsigned w) { return __builtin_bit_cast(float, w << 16); }
__device__ __forceinline__ float bfhi(unsigned w) { return __builtin_bit_cast(float, w & 0xffff0000u); }
template <int CTRL> __device__ __forceinline__ float dpp_mov(float v) { return __builtin_bit_cast(float, __builtin_amdgcn_update_dpp(0, __builtin_bit_cast(int, v), CTRL, 0xf, 0xf, true)); }
__device__ __forceinline__ float rlane(float v, int l) { return __builtin_bit_cast(float, __builtin_amdgcn_readlane(__builtin_bit_cast(int, v), l)); }
__device__ __forceinline__ float wave_sum(float v) {
    v += dpp_mov<0xB1>(v); v += dpp_mov<0x4E>(v); v += dpp_mov<0x141>(v); v += dpp_mov<0x140>(v);
    return (rlane(v, 0) + rlane(v, 16)) + (rlane(v, 32) + rlane(v, 48));
}
typedef float f32x2v __attribute__((ext_vector_type(2)));
template <int CTRL> __device__ __forceinline__ int dpp_movi(int v) { return __builtin_amdgcn_update_dpp(0, v, CTRL, 0xf, 0xf, true); }
template <int CTRL> __device__ __forceinline__ float dpp_movf(float v) { return __builtin_bit_cast(float, __builtin_amdgcn_update_dpp(0, __builtin_bit_cast(int, v), CTRL, 0xf, 0xf, true)); }
__device__ __forceinline__ unsigned pk4_fp8(float a, float b, float c, float d) { int w = __builtin_amdgcn_cvt_pk_fp8_f32(a, b, 0, false); w = __builtin_amdgcn_cvt_pk_fp8_f32(c, d, w, true); return (unsigned)w; }
constexpr float Y8_SCALE = 8.0f, Y8_INV = 1.0f / 8.0f;
constexpr float W8_SCALE = 32.0f, W8_INV = 1.0f / 32.0f;
__device__ __forceinline__ u32x4 pack8(const f32x4 a, const f32x4 b) { u32x4 w; w.x = pg8::cvt_pk_bf16(a[0], a[1]); w.y = pg8::cvt_pk_bf16(a[2], a[3]); w.z = pg8::cvt_pk_bf16(b[0], b[1]); w.w = pg8::cvt_pk_bf16(b[2], b[3]); return w; }

__device__ __forceinline__ void lds_dma16(const void* gsrc, unsigned lds_dst) { unsigned keep;
    asm volatile("s_mov_b32 %0, m0\n\ts_mov_b32 m0, %2\n\ts_nop 0\n\tglobal_load_lds_dwordx4 %1, off\n\ts_mov_b32 m0, %0" : "=&s"(keep) : "v"(gsrc), "s"(lds_dst) : "memory"); }
constexpr int LDS_NBLK = LDS_CTL + 640, LDS_BTE = LDS_CTL + 1280;
constexpr int LDS_EPI = 131072;
struct PlainOrder : pg8::StaticOrder { };
struct InprojOrder {
    pg8::StaticOrder lat; int ncolc, G, c; static constexpr const int* rowtok = nullptr;
    __device__ __forceinline__ void init(int ncolc_, int G_, int c_) { lat.init(TL, INW, G_, c_); ncolc = ncolc_; G = G_; c = c_; }
    __device__ __forceinline__ bool next(int i, pg8::Unit& u) const {
        const int L = i * G + c;
        if (L < lat.nwg) return lat.next(i, u);
        const int idx = L - lat.nwg; if (idx >= 16 * ncolc) return false;
        u.pm = 256 + idx / ncolc; u.pn = (ncolc == 10) ? idx % 10 : 2 + idx % 4; return true;
    }
    __device__ __forceinline__ int brow(const pg8::Unit& u) const { return u.pn * 256; }
    __device__ __forceinline__ void a_ready(const pg8::Unit&) const {}
    __device__ __forceinline__ void done(const pg8::Unit&) const {}
};
struct GroupedOrder {
    const PG8_LAS unsigned char* bte; const int* rowtok; int nN, Nper, G, c, nblk;
    __device__ __forceinline__ void init(const PG8_LAS unsigned char* lds_, int nN_, int Nper_, int G_, int c_, const int* rowtok_ = nullptr) { bte = lds_ + LDS_BTE; rowtok = rowtok_; nN = nN_; Nper = Nper_; G = G_; c = c_; nblk = *(const PG8_LAS int*)(lds_ + LDS_NBLK); }
    __device__ __forceinline__ bool next(int i, pg8::Unit& u) const {
        const int xcd = c & 7, j = c >> 3, per = G / nN;
        u.pm = i * per + (j / nN) * 8 + xcd; u.pn = (j % nN) | ((int)bte[u.pm] << 8); return u.pm < nblk;
    }
    __device__ __forceinline__ int brow(const pg8::Unit& u) const { return (u.pn >> 8) * Nper + (u.pn & 255) * 256; }
    __device__ __forceinline__ void a_ready(const pg8::Unit&) const {}
    __device__ __forceinline__ void done(const pg8::Unit&) const {}
};

struct EpiInproj {
    static constexpr bool PERM = true, AFTER_DRAIN = false;
    __device__ __forceinline__ void pre(const pg8::Unit&, int, int) const {}
    bf16 *Q, *Qc, *K, *V, *CPU; const PG8_LAS float* tab;
    __device__ __forceinline__ void operator()(const f32x4 (&acc)[2][2][4][2], const pg8::Unit& u, int wr, int wc, int fr_in, int fq_in) const {
        int fr = fr_in, fq = fq_in; asm volatile("" : "+v"(fr), "+v"(fq));
        const int pn = u.pn; const bool lat = u.pm < 256; const int b = lat ? (u.pm >> 4) : (u.pm - 256);
        const int pbase = (lat ? (u.pm & 15) * 256 : 0) + wr * 64 + fr;
        const int rbase = u.pm * 256 + wr * 64 + fr;
        if (pn < 4) {
            const bool isq = pn < 2; const PG8_LAS float* g = tab + 1024 + (isq ? 0 : 32);
            const f32x4 g0 = *(const PG8_LAS f32x4*)(g + 8 * fq), g1 = *(const PG8_LAS f32x4*)(g + 8 * fq + 4);
            const float sgn = (fq & 1) ? 1.0f : -1.0f;
#pragma unroll
            for (int bj = 0; bj < 2; ++bj) {
                const int grp = bj * 4 + wc, head = (pn & 1) * 4 + (grp >> 1), comp = grp & 1, bh = b * NH + head;
#pragma unroll
                for (int ai = 0; ai < 2; ++ai)
#pragma unroll
                    for (int m = 0; m < 4; ++m) {
                        const int pos = pbase + ai * 128 + m * 16;
                        f32x4 v0 = acc[ai][bj][m][0], v1 = acc[ai][bj][m][1];
                        float ss = (v0[0] * v0[0] + v0[1] * v0[1]) + (v0[2] * v0[2] + v0[3] * v0[3]) + (v1[0] * v1[0] + v1[1] * v1[1]) + (v1[2] * v1[2] + v1[3] * v1[3]);
                        ss += __shfl_xor(ss, 16); ss += __shfl_xor(ss, 32);
                        const float r = __builtin_amdgcn_rsqf(ss * (1.0f / 32.0f) + EPS);
                        v0 = v0 * r * g0; v1 = v1 * r * g1;
                        if (lat) {
                            const int p = (fq >> 1) == 0 ? (pos >> 6) : (pos & 63);
                            const f32x4 c0 = *(const PG8_LAS f32x4*)(tab + p * 8), c1 = *(const PG8_LAS f32x4*)(tab + p * 8 + 4), s0 = *(const PG8_LAS f32x4*)(tab + 512 + p * 8), s1 = *(const PG8_LAS f32x4*)(tab + 512 + p * 8 + 4);
                            f32x4 o0, o1;
#pragma unroll
                            for (int j = 0; j < 4; ++j) { o0[j] = __shfl_xor(v0[j], 16); o1[j] = __shfl_xor(v1[j], 16); }
                            v0 = v0 * c0 + (o0 * s0) * sgn; v1 = v1 * c1 + (o1 * s1) * sgn;
                        }
                        if (isq) { v0 = v0 * QSCALE; v1 = v1 * QSCALE; }
                        bf16* dst;
                        if (isq) dst = lat ? Q + ((size_t)bh * SEQ + pos) * 64 : Qc + ((size_t)bh * CTXL + pos) * 64;
                        else dst = K + ((size_t)bh * NKEY + (lat ? CTXL + pos : pos)) * 64;
                        *(u32x4*)(dst + comp * 32 + 8 * fq) = pack8(v0, v1);
                    }
            }
        } else if (pn < 6) {
#pragma unroll
            for (int bj = 0; bj < 2; ++bj) {
                const int grp = bj * 4 + wc, head = (pn - 4) * 4 + (grp >> 1), bh = b * NH + head;
#pragma unroll
                for (int ai = 0; ai < 2; ++ai)
#pragma unroll
                    for (int m = 0; m < 4; ++m) {
                        const int pos = pbase + ai * 128 + m * 16;
                        bf16* dst = V + ((size_t)bh * NKEY + (lat ? CTXL + pos : pos)) * 64 + (grp & 1) * 32 + 8 * fq;
                        *(u32x4*)dst = pack8(acc[ai][bj][m][0], acc[ai][bj][m][1]);
                    }
            }
        } else if (pn == 7 || pn == 8) {
#pragma unroll
            for (int ai = 0; ai < 2; ++ai)
#pragma unroll
                for (int m = 0; m < 4; ++m) {
                    bf16* dst = CPU + (size_t)(rbase + ai * 128 + m * 16) * 768 + 256 + (pn - 7) * 128 + wc * 32 + 8 * fq;
                    *(u32x4*)dst = pack8(acc[ai][0][m][0] * acc[ai][1][m][0], acc[ai][0][m][1] * acc[ai][1][m][1]);
                }
        } else {
            const int cb = pn == 6 ? 0 : 512;
#pragma unroll
            for (int ai = 0; ai < 2; ++ai)
#pragma unroll
                for (int m = 0; m < 4; ++m)
#pragma unroll
                    for (int bj = 0; bj < 2; ++bj) {
                        bf16* dst = CPU + (size_t)(rbase + ai * 128 + m * 16) * 768 + cb + bj * 128 + wc * 32 + 8 * fq;
                        *(u32x4*)dst = pack8(acc[ai][bj][m][0], acc[ai][bj][m][1]);
                    }
        }
    }
};
struct EpiResid {
    static constexpr bool PERM = true, AFTER_DRAIN = false;
    const bf16* xb  ; const float* gate  ; bf16* out; PG8_LAS unsigned char* lds;
    __device__ __forceinline__ void pre(const pg8::Unit& u, int wid, int lane) const {
        if (wid == 0) lds_dma16(gate + (size_t)(u.pm < 256 ? (u.pm >> 4) : 16) * (NMOD * DM) + u.pn * 256 + lane * 4, (unsigned)(uintptr_t)(lds + LDS_EPI)); }
    __device__ __forceinline__ void operator()(const f32x4 (&acc)[2][2][4][2], const pg8::Unit& u, int wr, int wc, int fr_in, int fq_in) const {
        int fr = fr_in, fq = fq_in; asm volatile("" : "+v"(fr), "+v"(fq));
        const int row0 = u.pm * 256 + wr * 64 + fr, col0 = u.pn * 256 + wc * 32 + 8 * fq;
        const bool lat = u.pm < 256; const int b = lat ? (u.pm >> 4) : 16;
        const PG8_LAS float* gp = (const PG8_LAS float*)(lds + LDS_EPI) + wc * 32 + 8 * fq; (void)b;
        f32x4 gv[2][2];
#pragma unroll
        for (int bj = 0; bj < 2; ++bj)
#pragma unroll
            for (int n = 0; n < 2; ++n) gv[bj][n] = *(const PG8_LAS f32x4*)(gp + bj * 128 + n * 4);
#pragma unroll
        for (int ai = 0; ai < 2; ++ai)
#pragma unroll
            for (int m = 0; m < 4; ++m) {
                const int row = row0 + ai * 128 + m * 16;
                const bf16* bp = xb + (size_t)row * DM + col0;
#pragma unroll
                for (int bj = 0; bj < 2; ++bj) {
                    const u32x4 bb = *(const u32x4*)(bp + bj * 128);
                    const f32x4 b0 = (f32x4){bflo(bb.x), bfhi(bb.x), bflo(bb.y), bfhi(bb.y)}, b1 = (f32x4){bflo(bb.z), bfhi(bb.z), bflo(bb.w), bfhi(bb.w)};
                    *(u32x4*)(out + (size_t)row * DM + col0 + bj * 128) = pack8(b0 + gv[bj][0] * acc[ai][bj][m][0], b1 + gv[bj][1] * acc[ai][bj][m][1]);
                }
            }
    }
};
struct EpiSwiglu {
    static constexpr bool PERM = true, AFTER_DRAIN = false;
    const int* ctl; const float* bias  ; unsigned char* act  ; PG8_LAS unsigned char* lds;
    __device__ __forceinline__ void pre(const pg8::Unit& u, int wid, int lane) const {
        if (wid == 0) lds_dma16(bias + (size_t)(u.pn >> 8) * 2048 + (lane >> 5) * 1024 + (u.pn & 255) * 128 + (lane & 31) * 4, (unsigned)(uintptr_t)(lds + LDS_EPI)); }
    __device__ __forceinline__ void operator()(const f32x4 (&acc)[2][2][4][2], const pg8::Unit& u, int wr, int wc, int fr_in, int fq_in) const {
        int fr = fr_in, fq = fq_in; asm volatile("" : "+v"(fr), "+v"(fq));
        const int row0 = u.pm * 256 + wr * 64 + fr + (fq & 1) * 16, cl = (u.pn & 255) * 128 + wc * 32 + (fq >> 1) * 16;
        const PG8_LAS float* bl_ = (const PG8_LAS float*)(lds + LDS_EPI) + wc * 32 + 8 * fq;
        f32x4 bgl[2], bli[2];
#pragma unroll
        for (int n = 0; n < 2; ++n) { bgl[n] = *(const PG8_LAS f32x4*)(bl_ + 4 * n); bli[n] = *(const PG8_LAS f32x4*)(bl_ + 128 + 4 * n); }
#pragma unroll
        for (int ai = 0; ai < 2; ++ai)
#pragma unroll
            for (int mp = 0; mp < 2; ++mp) {
                u32x2 w8[2];
#pragma unroll
                for (int mm = 0; mm < 2; ++mm) {
                    const int m = 2 * mp + mm;
                    f32x4 r[2];
#pragma unroll
                    for (int n = 0; n < 2; ++n) {
                        f32x4 g = acc[ai][0][m][n] * W8_INV + bgl[n], li = acc[ai][1][m][n] * W8_INV + bli[n];
                        g = __builtin_elementwise_min(g, (f32x4){7.0f, 7.0f, 7.0f, 7.0f});
                        li = __builtin_elementwise_min(__builtin_elementwise_max(li, (f32x4){-7.0f, -7.0f, -7.0f, -7.0f}), (f32x4){7.0f, 7.0f, 7.0f, 7.0f});
                        const f32x4 t = g * (-1.702f * 1.4426950408889634f);
                        f32x4 d; d.x = __builtin_amdgcn_exp2f(t.x); d.y = __builtin_amdgcn_exp2f(t.y); d.z = __builtin_amdgcn_exp2f(t.z); d.w = __builtin_amdgcn_exp2f(t.w);
                        d = d + 1.0f;
                        f32x4 sg; sg.x = __builtin_amdgcn_rcpf(d.x); sg.y = __builtin_amdgcn_rcpf(d.y); sg.z = __builtin_amdgcn_rcpf(d.z); sg.w = __builtin_amdgcn_rcpf(d.w);
                        const f32x4 u2 = g * sg;
                        r[n] = u2 * li + u2;
                    }
                    w8[mm].x = pk4_fp8(r[0][0], r[0][1], r[0][2], r[0][3]); w8[mm].y = pk4_fp8(r[1][0], r[1][1], r[1][2], r[1][3]);
                }
                { auto rx = __builtin_amdgcn_permlane16_swap(w8[0].x, w8[1].x, false, false); auto ry = __builtin_amdgcn_permlane16_swap(w8[0].y, w8[1].y, false, false);
                  *(u32x4*)(act + (size_t)(row0 + ai * 128 + mp * 32) * 1024 + cl) = (u32x4){rx[0], ry[0], rx[1], ry[1]}; }
            }
    }
};
struct EpiDown {
    static constexpr bool PERM = true, AFTER_DRAIN = false;
    const int* ctl; const float* bias  ; const float* row_w; unsigned char* Y  ; PG8_LAS unsigned char* lds;
    __device__ __forceinline__ void pre(const pg8::Unit& u, int wid, int lane) const {
        if (wid == 0) lds_dma16(bias + (size_t)(u.pn >> 8) * 1024 + (u.pn & 255) * 256 + lane * 4, (unsigned)(uintptr_t)(lds + LDS_EPI));
        if (wid == 1) lds_dma16(row_w + (size_t)u.pm * 256 + lane * 4, (unsigned)(uintptr_t)(lds + LDS_EPI + 1024)); }
    __device__ __forceinline__ void operator()(const f32x4 (&acc)[2][2][4][2], const pg8::Unit& u, int wr, int wc, int fr_in, int fq_in) const {
        int fr = fr_in, fq = fq_in; asm volatile("" : "+v"(fr), "+v"(fq));
        const int row0 = u.pm * 256 + wr * 64 + fr + (fq & 1) * 16, col0 = (u.pn & 255) * 256 + wc * 32 + (fq >> 1) * 16;
        const PG8_LAS float* bl_ = (const PG8_LAS float*)(lds + LDS_EPI) + wc * 32 + 8 * fq; const PG8_LAS float* wl_ = (const PG8_LAS float*)(lds + LDS_EPI + 1024) + wr * 64 + fr;
        f32x4 bv[2][2];
#pragma unroll
        for (int bj = 0; bj < 2; ++bj)
#pragma unroll
            for (int n = 0; n < 2; ++n) bv[bj][n] = *(const PG8_LAS f32x4*)(bl_ + bj * 128 + 4 * n);
#pragma unroll
        for (int ai = 0; ai < 2; ++ai)
#pragma unroll
            for (int mp = 0; mp < 2; ++mp) {
                const float w0 = wl_[ai * 128 + mp * 32] * Y8_SCALE, w1 = wl_[ai * 128 + mp * 32 + 16] * Y8_SCALE;
#pragma unroll
                for (int bj = 0; bj < 2; ++bj) {
                    u32x2 o[2];
#pragma unroll
                    for (int mm = 0; mm < 2; ++mm) { const int m = 2 * mp + mm; const float w = mm ? w1 : w0;
                        const f32x4 y0 = (acc[ai][bj][m][0] * W8_INV + bv[bj][0]) * w, y1 = (acc[ai][bj][m][1] * W8_INV + bv[bj][1]) * w;
                        o[mm].x = pk4_fp8(y0[0], y0[1], y0[2], y0[3]); o[mm].y = pk4_fp8(y1[0], y1[1], y1[2], y1[3]); }
                    auto rx = __builtin_amdgcn_permlane16_swap(o[0].x, o[1].x, false, false); auto ry = __builtin_amdgcn_permlane16_swap(o[0].y, o[1].y, false, false);
                    *(u32x4*)(Y + (size_t)(row0 + ai * 128 + mp * 32) * 1024 + col0 + bj * 128) = (u32x4){rx[0], ry[0], rx[1], ry[1]};
                }
            }
    }
};

#define XB_TMO      128
#define XB_XCNT(j)  (256  + 64 * (j))
#define XB_XSUB(j)  (1280 + 64 * (j))
#define XB_XGEN(j)  (2304 + 64 * (j))
#define XB_TOP      3328
#define XB_TOPGEN   3392
#define XCD_BAR_WORDS 3456
#define XB_SPIN_CAP (1u << 18)
#define LAS __attribute__((address_space(3)))

__device__ __forceinline__ unsigned xb_ld(unsigned* p)              { return __hip_atomic_load(p, __ATOMIC_RELAXED, __HIP_MEMORY_SCOPE_AGENT); }
__device__ __forceinline__ unsigned xb_add(unsigned* p, unsigned v) { return __hip_atomic_fetch_add(p, v, __ATOMIC_RELAXED, __HIP_MEMORY_SCOPE_AGENT); }
__device__ __forceinline__ unsigned xb_xcc_id() { return (unsigned)__builtin_amdgcn_s_getreg((3 << 11) | 20) & 0xFu; }
#define XB_SPIN(cond, bar) do { unsigned _sp = 0; while (cond) { __builtin_amdgcn_s_sleep(1); \
    if ((++_sp & 255u) == 0u) { if (xb_ld(&(bar)[XB_TMO])) break; if (_sp > XB_SPIN_CAP) { atomicAdd(&(bar)[XB_TMO], 1u); break; } } } } while (0)

struct XcdBarrier {
    unsigned* bar; unsigned x;
    volatile LAS unsigned* st;
};

__device__ __forceinline__ XcdBarrier xcd_barrier_post(unsigned* bar, volatile LAS unsigned* st) {
    XcdBarrier b; b.bar = bar; b.x = xb_xcc_id(); b.st = st;
    if (threadIdx.x == 0) (void)xb_add(&bar[XB_XCNT(b.x)], 1u);
    return b;
}
__device__ __forceinline__ void xcd_barrier_complete(unsigned* bar, unsigned x, unsigned& nloc, unsigned& nx) {
    const unsigned G = gridDim.x * gridDim.y * gridDim.z;
    unsigned sum, cnt, mine, sp = 0u;
    for (;;) {
        sum = 0u; cnt = 0u; mine = 0u;
#pragma unroll
        for (unsigned j = 0; j < 16; ++j) { const unsigned c = xb_ld(&bar[XB_XCNT(j)]); sum += c; cnt += (c > 0u) ? 1u : 0u; mine = (j == x) ? c : mine; }
        if (sum == G) break;
        __builtin_amdgcn_s_sleep(1);
        if ((++sp & 255u) == 0u) { if (xb_ld(&bar[XB_TMO])) break; if (sp > XB_SPIN_CAP) { atomicAdd(&bar[XB_TMO], 1u); break; } }
    }
    nloc = mine > 0u ? mine : 1u; nx = cnt > 0u ? cnt : 1u;
}

__device__ __forceinline__ void xcd_barrier(const XcdBarrier& b) {
    asm volatile("s_waitcnt vmcnt(0)" ::: "memory");
    __syncthreads();
    if (threadIdx.x == 0) {
        unsigned* bar = b.bar;
        __builtin_amdgcn_s_waitcnt(0);
        unsigned nloc = b.st[0], nx = b.st[1];
        if (nloc == 0u) { xcd_barrier_complete(bar, b.x, nloc, nx); b.st[0] = nloc; b.st[1] = nx; }
        const unsigned old = xb_add(&bar[XB_XSUB(b.x)], 1u);
        const unsigned gen = old / nloc;
        if (old + 1u == (gen + 1u) * nloc) {
            __builtin_amdgcn_fence(__ATOMIC_RELEASE, "agent");
            asm volatile("s_waitcnt vmcnt(0)" ::: "memory");
            const unsigned og = xb_add(&bar[XB_TOP], 1u);
            const unsigned tg = og / nx;
            if (og + 1u == (tg + 1u) * nx) xb_add(&bar[XB_TOPGEN], 1u);
            else XB_SPIN(xb_ld(&bar[XB_TOPGEN]) == tg, bar);
            __builtin_amdgcn_fence(__ATOMIC_ACQUIRE, "agent");
            xb_add(&bar[XB_XGEN(b.x)], 1u);
            asm volatile("s_waitcnt vmcnt(0)" ::: "memory");
        } else {
            XB_SPIN(xb_ld(&bar[XB_XGEN(b.x)]) == gen, bar);
            __builtin_amdgcn_fence(__ATOMIC_ACQUIRE, "agent");
            asm volatile("s_waitcnt vmcnt(0)" ::: "memory");
        }
    }
    __syncthreads();
}


namespace fa {
using bf16x8 = __attribute__((ext_vector_type(8))) short;
using s16x4 = __attribute__((ext_vector_type(4))) short;
using f32x16 = __attribute__((ext_vector_type(16))) float;
typedef short v4i16_t __attribute__((ext_vector_type(4)));
constexpr int SUBB = 16384, SLOTB = 2 * SUBB, NSLOT = 3, PFD = NSLOT - 1;
constexpr int FA_WS = 131072, FA_OST = 0, OST_PITCH = 68;
static_assert(NSLOT * SLOTB <= 131072 && 8 * 32 * OST_PITCH * 4 <= NSLOT * SLOTB && FA_WS + 8 * 256 <= 139264, "attention LDS map");
__device__ __forceinline__ void glds16(const void* gsrc, unsigned lds_dst) { unsigned keep;
    asm volatile("s_mov_b32 %0, m0\n\ts_mov_b32 m0, %2\n\ts_nop 0\n\tglobal_load_lds_dwordx4 %1, off\n\ts_mov_b32 m0, %0" : "=&s"(keep) : "v"(gsrc), "s"(lds_dst) : "memory"); }
__device__ __forceinline__ s16x4 vtr(const LAS unsigned char* p) { return __builtin_bit_cast(s16x4, __builtin_amdgcn_ds_read_tr16_b64_v4i16((LAS v4i16_t*)p)); }
typedef float f32x2_t __attribute__((ext_vector_type(2))); typedef __bf16 bf16x2_t __attribute__((ext_vector_type(2)));
__device__ __forceinline__ unsigned cvtpk(float lo, float hi) { f32x2_t v = {lo, hi}; bf16x2_t b = __builtin_convertvector(v, bf16x2_t); return __builtin_bit_cast(unsigned, b); }
#define FA_WAIT_BAR(N) asm volatile("s_waitcnt vmcnt(" #N ") lgkmcnt(0)\n\ts_barrier" ::: "memory")
#define FA_MFMA(a, b, c) __builtin_amdgcn_mfma_f32_32x32x16_bf16((a), (b), (c), 0, 0, 0)

__device__ __forceinline__ void map_tile(const LAS unsigned char* kp, int ko0, int ko1, const bf16x8 (&qf)[2], const s16x4 (&vlo)[8], const s16x4 (&vhi)[8], f32x16 (&o)[2], float& l) {
    const bf16x8 k00 = *(const LAS bf16x8*)(kp + ko0), k01 = *(const LAS bf16x8*)(kp + ko1), k10 = *(const LAS bf16x8*)(kp + ko0 + 4096), k11 = *(const LAS bf16x8*)(kp + ko1 + 4096);
    f32x16 z;
#pragma unroll
    for (int i = 0; i < 16; ++i) z[i] = 0.f;
    f32x16 s0 = FA_MFMA(k00, qf[0], z), s1 = FA_MFMA(k10, qf[0], z);
    __builtin_amdgcn_sched_group_barrier(0x8, 2, 0);
    s0 = FA_MFMA(k01, qf[1], s0); s1 = FA_MFMA(k11, qf[1], s1);
#pragma unroll
    for (int i = 0; i < 16; ++i) { s0[i] = __builtin_amdgcn_exp2f(s0[i]); s1[i] = __builtin_amdgcn_exp2f(s1[i]); }
    float a = 0.f, b = 0.f;
#pragma unroll
    for (int i = 0; i < 16; ++i) { a += s0[i]; b += s1[i]; }
    l += a + b;
    u32x4 pw[4];
#pragma unroll
    for (int j = 0; j < 4; ++j) { pw[0][j] = cvtpk(s0[2 * j], s0[2 * j + 1]); pw[1][j] = cvtpk(s0[8 + 2 * j], s0[8 + 2 * j + 1]); pw[2][j] = cvtpk(s1[2 * j], s1[2 * j + 1]); pw[3][j] = cvtpk(s1[8 + 2 * j], s1[8 + 2 * j + 1]); }
#pragma unroll
    for (int ks = 0; ks < 4; ++ks)
#pragma unroll
        for (int d0 = 0; d0 < 2; ++d0) {
            const int i = d0 * 4 + ks;
            const bf16x8 vf = (bf16x8){vlo[i][0], vlo[i][1], vlo[i][2], vlo[i][3], vhi[i][0], vhi[i][1], vhi[i][2], vhi[i][3]};
            o[d0] = FA_MFMA(__builtin_bit_cast(bf16x8, pw[ks]), vf, o[d0]);
        }
}
template <class Mid> __device__ __forceinline__ void attn_unit(const Mid& mid, LAS unsigned char* lds, const bf16* __restrict__ Qu, const bf16* __restrict__ Kh, const bf16* __restrict__ Vh, int q0, int NT,
                                          float lam, float oscale, const float* __restrict__ subg, bf16* __restrict__ mixp, int tid) {
    int tid_u = tid; asm volatile("" : "+v"(tid_u));
    const int lane = tid_u & 63, r32 = lane & 31, hi = lane >> 5, wid = __builtin_amdgcn_readfirstlane(tid_u >> 6);
    const unsigned lds0 = (unsigned)(uintptr_t)lds;
    const bf16* ksrc = Kh + (size_t)(8 * wid + (lane >> 3)) * 64 + (((lane & 7) ^ ((4 * (wid & 1) + (lane >> 4)) & 7)) * 8);
    const bf16* vsrc = Vh + (size_t)(16 * (wid & 3) + (lane >> 2)) * 64 + (wid >> 2) * 32 + (lane & 3) * 8;
    const unsigned kdst = lds0 + wid * 1024, vdst = lds0 + 8192 + wid * 1024;
#define FA_DMA(t, slot) do { _Pragma("unroll") for (int sb_ = 0; sb_ < 2; ++sb_) { glds16(ksrc + (size_t)(2 * (t) + sb_) * 4096, (unsigned)__builtin_amdgcn_readfirstlane(kdst + (slot) + sb_ * SUBB)); glds16(vsrc + (size_t)(2 * (t) + sb_) * 4096, (unsigned)__builtin_amdgcn_readfirstlane(vdst + (slot) + sb_ * SUBB)); } } while (0)
    const int swr = (r32 >> 1) & 7;
    const LAS unsigned char* kp0 = lds + r32 * 128;
    const int ko10 = ((0 + hi) ^ swr) << 4, ko11 = ((2 + hi) ^ swr) << 4, ko20 = ((4 + hi) ^ swr) << 4, ko21 = ((6 + hi) ^ swr) << 4;
    const LAS unsigned char* vp0 = lds + 8192 + ((lane >> 4) & 1) * 32 + (lane & 3) * 8 + (4 * hi + ((lane & 15) >> 2)) * 64;
#pragma unroll
    for (int d = 0; d < PFD; ++d) FA_DMA((d < (NT >> 1) ? d : (NT >> 1) - 1), d * SLOTB);
    bf16x8 q1f[2], q2f[2];
    { const bf16* qrow = Qu + (size_t)(q0 + wid * 32 + r32) * 64 + hi * 8;
      q1f[0] = *(const bf16x8*)(qrow); q1f[1] = *(const bf16x8*)(qrow + 16); q2f[0] = *(const bf16x8*)(qrow + 32); q2f[1] = *(const bf16x8*)(qrow + 48); }
    asm volatile("" : "+v"(q1f[0]), "+v"(q1f[1]), "+v"(q2f[0]), "+v"(q2f[1]));
    f32x16 o1[2], o2[2]; float l1 = 0.f, l2 = 0.f;
#pragma unroll
    for (int i = 0; i < 16; ++i) { o1[0][i] = 0.f; o1[1][i] = 0.f; o2[0][i] = 0.f; o2[1][i] = 0.f; }
    const int NT2 = NT >> 1;
    int sl = 0;
    for (int t = 0; t < NT2; ++t) {
        FA_WAIT_BAR(4);
        { const int tn = (t + PFD < NT2) ? t + PFD : NT2 - 1; const int sn = (sl == 0) ? (NSLOT - 1) * SLOTB : sl - SLOTB; FA_DMA(tn, sn); }
#pragma unroll 1
        for (int sb = 0; sb < 2; ++sb) {
            const LAS unsigned char* kp = kp0 + sl + sb * SUBB; const LAS unsigned char* vp = vp0 + sl + sb * SUBB;
            s16x4 vlo[8], vhi[8];
#pragma unroll
            for (int i = 0; i < 8; ++i) { vlo[i] = vtr(vp + (i >> 2) * 4096 + (i & 3) * 1024); vhi[i] = vtr(vp + (i >> 2) * 4096 + (i & 3) * 1024 + 512); }
            map_tile(kp, ko10, ko11, q1f, vlo, vhi, o1, l1);
            map_tile(kp, ko20, ko21, q2f, vlo, vhi, o2, l2);
            __builtin_amdgcn_sched_barrier(0);
        }
        sl += SLOTB; if (sl >= NSLOT * SLOTB) sl = 0;
    }
#undef FA_DMA
    asm volatile("s_waitcnt vmcnt(0) lgkmcnt(0)\n\ts_barrier" ::: "memory");
    f32x4 xv[32]; mid.load(xv);
    l1 += __shfl_xor(l1, 32); l2 += __shfl_xor(l2, 32);
    int lane_e = lane; asm volatile("" : "+v"(lane_e));
    const int r32e = lane_e & 31, hie = lane_e >> 5;
    LAS float* wsf = (LAS float*)(lds + FA_WS) + wid * 64;
    if (hie == 0) { wsf[r32e] = 1.0f / l1; wsf[32 + r32e] = lam / l2; }
    const LAS float* wq = wsf + 4 * hie;
    LAS float* sb = (LAS float*)(lds + FA_OST) + wid * (32 * OST_PITCH) + (4 * hie) * OST_PITCH + r32e;
#pragma unroll
    for (int i = 0; i < 16; ++i) {
        const int qc = (i & 3) + 8 * (i >> 2); const float a = wq[qc], b = wq[32 + qc];
        sb[qc * OST_PITCH] = o1[0][i] * a - o2[0][i] * b; sb[qc * OST_PITCH + 32] = o1[1][i] * a - o2[1][i] * b;
    }
    const int ch = lane_e & 7;
    const f32x4 g0 = *(const f32x4*)(subg + ch * 8), g1 = *(const f32x4*)(subg + ch * 8 + 4);
    const LAS float* rb = (const LAS float*)(lds + FA_OST) + wid * (32 * OST_PITCH) + (lane_e >> 3) * OST_PITCH + ch * 8;
    bf16* mrow = mixp + (size_t)(wid * 32 + (lane_e >> 3)) * DM + ch * 8;
#pragma unroll
    for (int ps = 0; ps < 4; ++ps) {
        const f32x4 x0 = *(const LAS f32x4*)(rb + ps * 8 * OST_PITCH), x1 = *(const LAS f32x4*)(rb + ps * 8 * OST_PITCH + 4);
        float ss = (x0[0] * x0[0] + x0[1] * x0[1]) + (x0[2] * x0[2] + x0[3] * x0[3]) + (x1[0] * x1[0] + x1[1] * x1[1]) + (x1[2] * x1[2] + x1[3] * x1[3]);
        ss += __shfl_xor(ss, 1); ss += __shfl_xor(ss, 2); ss += __shfl_xor(ss, 4);
        const float r = oscale * __builtin_amdgcn_rsqf(ss * (1.0f / 64.0f) + EPS);
        *(u32x4*)(mrow + (size_t)ps * 8 * DM) = pack8(x0 * r * g0, x1 * r * g1);
    }
    mid.store(xv);
    asm volatile("s_waitcnt vmcnt(0) lgkmcnt(0)\n\ts_barrier" ::: "memory");
}
#undef FA_MFMA
}
struct Args { const float* in[26]; float* out; unsigned char* ws; int ph_lo, ph_hi, bar_region, pad; };

__device__ __forceinline__ int perm_row(int n, int mode) {
    if (mode == 1) return ((n & 1023) >> 7) * 256 + (n >> 10) * 128 + (n & 127);
    if (mode == 2) { if (n >= 1792 && n < 2304) { const int u = n >= 2048, j = n - (u ? 2048 : 1792); return 1792 + (j >> 7) * 256 + u * 128 + (j & 127); } return n; }
    return n;
}
__device__ __forceinline__ void transpose_item(const float* __restrict__ src, int N, int nb, int kq, bf16* __restrict__ dst, int mode, int lane) {
    const int n = nb * 64 + lane, np = perm_row(n, mode);
#pragma unroll 1
    for (int it = 0; it < 2; ++it) {
        const int k0 = kq * 64 + it * 32; float v[32];
#pragma unroll
        for (int i = 0; i < 32; ++i) v[i] = src[(size_t)(k0 + i) * N + n];
        u32x4* d = (u32x4*)(dst + (size_t)np * DM + k0);
#pragma unroll
        for (int q = 0; q < 4; ++q) { u32x4 a; a.x = pg8::cvt_pk_bf16(v[8 * q], v[8 * q + 1]); a.y = pg8::cvt_pk_bf16(v[8 * q + 2], v[8 * q + 3]); a.z = pg8::cvt_pk_bf16(v[8 * q + 4], v[8 * q + 5]); a.w = pg8::cvt_pk_bf16(v[8 * q + 6], v[8 * q + 7]); d[q] = a; }
    }
}
__device__ __forceinline__ void transpose_item8(const float* __restrict__ src, int N, int nb, int kq, unsigned char* __restrict__ dst, int mode, int lane) {
    const int n = nb * 64 + lane, np = perm_row(n, mode);
#pragma unroll 1
    for (int it = 0; it < 2; ++it) {
        const int k0 = kq * 64 + it * 32; float v[32];
#pragma unroll
        for (int i = 0; i < 32; ++i) v[i] = src[(size_t)(k0 + i) * N + n] * W8_SCALE;
        u32x4* d = (u32x4*)(dst + (size_t)np * DM + k0);
#pragma unroll
        for (int q = 0; q < 2; ++q) { u32x4 a; a.x = pk4_fp8(v[16 * q], v[16 * q + 1], v[16 * q + 2], v[16 * q + 3]); a.y = pk4_fp8(v[16 * q + 4], v[16 * q + 5], v[16 * q + 6], v[16 * q + 7]);
            a.z = pk4_fp8(v[16 * q + 8], v[16 * q + 9], v[16 * q + 10], v[16 * q + 11]); a.w = pk4_fp8(v[16 * q + 12], v[16 * q + 13], v[16 * q + 14], v[16 * q + 15]); d[q] = a; }
    }
}

__device__ __forceinline__ void transpose_batch8w(const float* __restrict__ src, int N, int nb, int k0, unsigned char* __restrict__ dst, int mode, int lane) {
    const int n0 = nb * 256 + lane * 4; f32x4 v[32];
#pragma unroll
    for (int i = 0; i < 32; ++i) v[i] = *(const f32x4*)(src + (size_t)(k0 + i) * N + n0);
#pragma unroll
    for (int c = 0; c < 4; ++c) {
        const int np = perm_row(n0 + c, mode); u32x4* d = (u32x4*)(dst + (size_t)np * DM + k0);
#pragma unroll
        for (int q = 0; q < 2; ++q) { u32x4 a;
            a.x = pk4_fp8(v[16 * q][c] * W8_SCALE, v[16 * q + 1][c] * W8_SCALE, v[16 * q + 2][c] * W8_SCALE, v[16 * q + 3][c] * W8_SCALE);
            a.y = pk4_fp8(v[16 * q + 4][c] * W8_SCALE, v[16 * q + 5][c] * W8_SCALE, v[16 * q + 6][c] * W8_SCALE, v[16 * q + 7][c] * W8_SCALE);
            a.z = pk4_fp8(v[16 * q + 8][c] * W8_SCALE, v[16 * q + 9][c] * W8_SCALE, v[16 * q + 10][c] * W8_SCALE, v[16 * q + 11][c] * W8_SCALE);
            a.w = pk4_fp8(v[16 * q + 12][c] * W8_SCALE, v[16 * q + 13][c] * W8_SCALE, v[16 * q + 14][c] * W8_SCALE, v[16 * q + 15][c] * W8_SCALE);
            d[q] = a; }
    }
}
__device__ __forceinline__ void transpose_batch16w(const float* __restrict__ src, int N, int nb, int k0, bf16* __restrict__ dst, int mode, int lane) {
    const int n0 = nb * 256 + lane * 4; f32x4 v[32];
#pragma unroll
    for (int i = 0; i < 32; ++i) v[i] = *(const f32x4*)(src + (size_t)(k0 + i) * N + n0);
#pragma unroll
    for (int c = 0; c < 4; ++c) {
        const int np = perm_row(n0 + c, mode); u32x4* d = (u32x4*)(dst + (size_t)np * DM + k0);
#pragma unroll
        for (int q = 0; q < 4; ++q) { u32x4 a; a.x = pg8::cvt_pk_bf16(v[8 * q][c], v[8 * q + 1][c]); a.y = pg8::cvt_pk_bf16(v[8 * q + 2][c], v[8 * q + 3][c]); a.z = pg8::cvt_pk_bf16(v[8 * q + 4][c], v[8 * q + 5][c]); a.w = pg8::cvt_pk_bf16(v[8 * q + 6][c], v[8 * q + 7][c]); d[q] = a; }
    }
}
constexpr int XW_BATCHES = 2 * (NEXP * 8 * 16 + NEXP * 4 * 16);
__device__ __forceinline__ void expert_weight_batch(int l, int bi, const float* __restrict__ w_gu, const float* __restrict__ w_dn, unsigned char* __restrict__ Wgu8, unsigned char* __restrict__ Wdn8, int lane) {
    const int item = bi >> 1, k32 = (bi & 1) * 32;
    if (item < NEXP * 8 * 16) { const int kq = item & 15, nb = (item >> 4) & 7, m = l * NEXP + (item >> 7);
        transpose_batch8w(w_gu + (size_t)m * DM * 2048, 2048, nb, kq * 64 + k32, Wgu8 + (size_t)m * 2048 * DM, 1, lane); }
    else { const int it2 = item - NEXP * 8 * 16, kq = it2 & 15, nb = (it2 >> 4) & 3, m = l * NEXP + (it2 >> 6);
        transpose_batch8w(w_dn + (size_t)m * DM * DM, DM, nb, kq * 64 + k32, Wdn8 + (size_t)m * DM * DM, 0, lane); }
}

struct XwMid {
    const float* src; unsigned char* dst; int N, n0, k0, mode; bool on;
    __device__ __forceinline__ void setup(int l, int bi, const float* w_gu, const float* w_dn, unsigned char* Wgu8, unsigned char* Wdn8, int lane) {
        on = bi < XW_BATCHES; const int item = bi >> 1, k32 = (bi & 1) * 32;
        if (item < NEXP * 8 * 16) { const int kq = item & 15, nb = (item >> 4) & 7, m = l * NEXP + (item >> 7); src = w_gu + (size_t)m * DM * 2048; dst = Wgu8 + (size_t)m * 2048 * DM; N = 2048; n0 = nb * 256 + lane * 4; k0 = kq * 64 + k32; mode = 1; }
        else { const int it2 = item - NEXP * 8 * 16, kq = it2 & 15, nb = (it2 >> 4) & 3, m = l * NEXP + (it2 >> 6); src = w_dn + (size_t)m * DM * DM; dst = Wdn8 + (size_t)m * DM * DM; N = DM; n0 = nb * 256 + lane * 4; k0 = kq * 64 + k32; mode = 0; }
    }
    __device__ __forceinline__ void load(f32x4 (&v)[32]) const { if (on) {
#pragma unroll
        for (int i = 0; i < 32; ++i) v[i] = *(const f32x4*)(src + (size_t)(k0 + i) * N + n0); } }
    __device__ __forceinline__ void store(const f32x4 (&v)[32]) const { if (on) {
#pragma unroll
        for (int c = 0; c < 4; ++c) {
            const int np = perm_row(n0 + c, mode); u32x4* d = (u32x4*)(dst + (size_t)np * DM + k0);
#pragma unroll
            for (int q = 0; q < 2; ++q) { u32x4 a;
                a.x = pk4_fp8(v[16 * q][c] * W8_SCALE, v[16 * q + 1][c] * W8_SCALE, v[16 * q + 2][c] * W8_SCALE, v[16 * q + 3][c] * W8_SCALE);
                a.y = pk4_fp8(v[16 * q + 4][c] * W8_SCALE, v[16 * q + 5][c] * W8_SCALE, v[16 * q + 6][c] * W8_SCALE, v[16 * q + 7][c] * W8_SCALE);
                a.z = pk4_fp8(v[16 * q + 8][c] * W8_SCALE, v[16 * q + 9][c] * W8_SCALE, v[16 * q + 10][c] * W8_SCALE, v[16 * q + 11][c] * W8_SCALE);
                a.w = pk4_fp8(v[16 * q + 12][c] * W8_SCALE, v[16 * q + 13][c] * W8_SCALE, v[16 * q + 14][c] * W8_SCALE, v[16 * q + 15][c] * W8_SCALE);
                d[q] = a; }
        } } }
};

__global__ void __launch_bounds__(NTHR, 2) mk_fwd(Args args) {
    extern __shared__ __attribute__((aligned(16))) unsigned char lds_raw[];
    LAS unsigned char* lds = (LAS unsigned char*)lds_raw;
    const int G = gridDim.x, bx = blockIdx.x, NGW = G * NWAVES;
#define PH_IDS() int tid = threadIdx.x; asm volatile("" : "+v"(tid)); const int lane = tid & 63, wave = __builtin_amdgcn_readfirstlane(tid >> 6), gw = bx * NWAVES + wave; (void)lane; (void)gw
    const int vcu = (G % 8 == 0) ? (bx % 8) * (G / 8) + bx / 8 : bx;
    typedef const __attribute__((address_space(4))) Args* KArgs;
    const KArgs ka0 = (KArgs)__builtin_amdgcn_kernarg_segment_ptr();
#define KA() ({ KArgs p_ = ka0; asm volatile("" : "+s"(p_)); p_; })
#define WSP(T, off) ((T*)(A->ws + (off)))
#define DEF_WS() KArgs A = KA(); int* ctl = WSP(int, WS_CTL); float* mod = WSP(float, WS_MOD); float* ropeC = WSP(float, WS_ROPE); float* ropeS = ropeC + 512; float* scal = WSP(float, WS_SCAL); \
    bf16* Win = WSP(bf16, WS_WIN); bf16* Wout = WSP(bf16, WS_WOUT); bf16* Wgu = WSP(bf16, WS_WGU); bf16* Wdn = WSP(bf16, WS_WDN); \
    bf16* H = WSP(bf16, WS_H); bf16* X1 = WSP(bf16, WS_X1); float* X2C = WSP(float, WS_X2C); \
    int* ASGE = WSP(int, WS_TOK + TOK_AE); float* ASGW = WSP(float, WS_TOK + TOK_AW); int* SLOTOF = WSP(int, WS_TOK + TOK_SLOTOF); int* ROWTOK = WSP(int, WS_TOK + TOK_ROWTOK); float* ROWW = WSP(float, WS_TOK + TOK_ROWW); \
    bf16* Qb = WSP(bf16, WS_RA + RA_Q); bf16* Qcb = WSP(bf16, WS_RA + RA_QC); bf16* Kb = WSP(bf16, WS_RA + RA_K); bf16* Vb = WSP(bf16, WS_RA + RA_V); \
    bf16* CPU = WSP(bf16, WS_RA + RA_CPU); bf16* MIX = WSP(bf16, WS_RA + RA_MIX); bf16* XS = WSP(bf16, WS_RA); bf16* Y = WSP(bf16, WS_RA); bf16* ACT = WSP(bf16, WS_RB); \
    float* out = A->out; const float* xl = l == 0 ? A->in[0] : out; const float* xc = l == 0 ? A->in[2] : X2C; \
    const float* modl = mod + (size_t)l * 17 * NMOD * DM; int* ctll = ctl + l * CTL_LSTRIDE; int* wgcnt = ctl + CTL_WGCNT + l * CTL_WGCNT_L; \
    (void)ctl; (void)mod; (void)ropeC; (void)ropeS; (void)scal; (void)Win; (void)Wout; (void)Wgu; (void)Wdn; (void)H; (void)X1; (void)X2C; (void)ASGE; (void)ASGW; (void)SLOTOF; (void)ROWTOK; (void)ROWW; \
    (void)Qb; (void)Qcb; (void)Kb; (void)Vb; (void)CPU; (void)MIX; (void)XS; (void)Y; (void)ACT; (void)out; (void)xl; (void)xc; (void)modl; (void)ctll; (void)wgcnt
    LAS int* lctl = (LAS int*)(lds + LDS_CTL);
    for (int u = threadIdx.x; u < (LDS_BYTES - LDS_CTL) / 4; u += NTHR) ((LAS unsigned*)(lds + LDS_CTL))[u] = 0u;
    __syncthreads();
    XcdBarrier bar = xcd_barrier_post((unsigned*)(ka0->ws + WS_CTL) + CTL_BAR + ka0->bar_region * CTL_BAR_STRIDE, (volatile LAS unsigned*)(lds + LDS_BARW));
    const int lo = ka0->ph_lo, hi = ka0->ph_hi;
#define IN(k) (lo <= (k) && (k) < hi)
#define SEAM(k) do { if (IN(k) && IN((k) + 1)) xcd_barrier(bar); } while (0)

    if (IN(0)) {
        const int l = 0; PH_IDS(); DEF_WS();
        const float* cvec = A->in[1]; const float* c_ctx = A->in[3]; const float* w_mod = A->in[4]; const float* b_mod = A->in[5];
        const float* w_in = A->in[8]; const float* pool_w = A->in[17]; const float* pool_scale = A->in[18]; const float* w_out = A->in[19]; const float* w_gu = A->in[22]; const float* w_dn = A->in[24];
        if (bx < 192) {
            LAS float* sl = (LAS float*)lds + 8704;
            for (int i = tid; i < 17 * DM; i += NTHR) { const float cv = i < 16 * DM ? cvec[i] : c_ctx[i - 16 * DM]; sl[i] = cv * __builtin_amdgcn_rcpf(1.0f + __builtin_amdgcn_exp2f(cv * -1.4426950408889634f)); }
            __syncthreads();
        }
        for (int t = bx; t < 192; t += G) {
            LAS float* red = (LAS float*)lds;
            const LAS float* sl = (const LAS float*)lds + 8704;
            const int l = t / 96, nb = t % 96, n = nb * 64 + lane;
            float acc[17];
#pragma unroll
            for (int r = 0; r < 17; ++r) acc[r] = 0.f;
            const float* W = w_mod + (size_t)l * DM * (NMOD * DM) + n;
#pragma unroll 1
            for (int k0 = wave * 128; k0 < wave * 128 + 128; k0 += 16) {
                float wv[16];
#pragma unroll
                for (int i = 0; i < 16; ++i) wv[i] = W[(size_t)(k0 + i) * (NMOD * DM)];
#pragma unroll
                for (int i = 0; i < 16; ++i)
#pragma unroll
                    for (int r = 0; r < 17; ++r) acc[r] += sl[r * DM + k0 + i] * wv[i];
            }
#pragma unroll
            for (int r = 0; r < 17; ++r) red[(wave * 17 + r) * 64 + lane] = acc[r];
            __syncthreads();
            for (int idx = tid; idx < 17 * 64; idx += NTHR) {
                const int r = idx >> 6, ln = idx & 63; float sm = 0.f;
#pragma unroll
                for (int ww = 0; ww < 8; ++ww) sm += red[(ww * 17 + r) * 64 + ln];
                mod[((size_t)l * 17 + r) * (NMOD * DM) + nb * 64 + ln] = sm + b_mod[l * (NMOD * DM) + nb * 64 + ln];
            }
            __syncthreads();
        }
        if (bx == G - 1) {
            { const int pos = tid >> 3, pair = tid & 7; const float inv = powf(10000.0f, -(float)pair / 8.0f), ang = (float)pos * inv; ropeC[tid] = cosf(ang); ropeS[tid] = sinf(ang); }
            if (tid < DEPTH) {
                const float *lq1 = A->in[11] + tid * 32, *lk1 = A->in[12] + tid * 32, *lq2 = A->in[13] + tid * 32, *lk2 = A->in[14] + tid * 32;
                float s1 = 0.f, s2 = 0.f;
                for (int d = 0; d < 32; ++d) { s1 += lq1[d] * lk1[d]; s2 += lq2[d] * lk2[d]; }
                const float lam_init = 0.8f - 0.6f * expf(-0.3f * (float)tid);
                scal[tid * 2 + 0] = expf(s1) - expf(s2) + lam_init; scal[tid * 2 + 1] = lam_init;
            }
        }
        {
            const float* router_w = A->in[20]; bf16* wrt = WSP(bf16, WS_WRT);
            for (int i = bx * NTHR + tid; i < DEPTH * NEXP * DM; i += G * NTHR) {
                const int ll = i >> 15, e = (i >> 10) & 31, k = i & 1023; const float w = router_w[((size_t)ll * DM + k) * NEXP + e];
                const unsigned hb = f2bf(w); const float hf = __builtin_bit_cast(float, hb << 16);
                wrt[(size_t)ll * 65536 + e * DM + k] = (bf16)hb; wrt[(size_t)ll * 65536 + 32768 + e * DM + k] = (bf16)f2bf(w - hf);
            }
        }
        constexpr int I_OUTT = DEPTH * 4 * 24, I_FOLD = DEPTH * 16 * 4 * 4, I_OUT = I_OUTT + I_FOLD, I_IN = DEPTH * 10 * 32, I_GU = 0, I_DN = 0;
        for (int step = 0; ; ++step) {
            int it;
            if (G == 256) { if (bx >= 192) { if (step > 0) break; it = gw - 192 * NWAVES; if (it >= I_FOLD) break; } else { it = I_FOLD + gw + step * 192 * NWAVES; if (it >= I_OUT + I_IN + I_GU + I_DN) break; } }
            else { it = gw + step * NGW; if (it >= I_OUT + I_IN + I_GU + I_DN) break; }
            int r = it;
            if (r < I_FOLD) {
                const int i4 = r & 3, gi = (r >> 2) & 3, nb = (r >> 4) & 15, l = r >> 8, n = nb * 64 + lane;
                const float* wo = w_out + (size_t)l * DM * DM + (size_t)(768 + gi * 64) * DM + n;
                const float* __restrict__ wp = pool_w + (size_t)l * 16384 + gi * 4096; const float* __restrict__ ps = pool_scale + l * 256 + gi * 64;
                float v[16];
#pragma unroll
                for (int i = 0; i < 16; ++i) v[i] = 0.f;
                for (int cp = 0; cp < 64; ++cp) { const float w = wo[(size_t)cp * DM] * ps[cp];
#pragma unroll
                    for (int i = 0; i < 16; ++i) v[i] += wp[(i4 * 16 + i) * 64 + cp] * w; }
                u32x4 a, b2;
                a.x = f2bf(v[0]) | (f2bf(v[1]) << 16); a.y = f2bf(v[2]) | (f2bf(v[3]) << 16); a.z = f2bf(v[4]) | (f2bf(v[5]) << 16); a.w = f2bf(v[6]) | (f2bf(v[7]) << 16);
                b2.x = f2bf(v[8]) | (f2bf(v[9]) << 16); b2.y = f2bf(v[10]) | (f2bf(v[11]) << 16); b2.z = f2bf(v[12]) | (f2bf(v[13]) << 16); b2.w = f2bf(v[14]) | (f2bf(v[15]) << 16);
                u32x4* d = (u32x4*)(Wout + (size_t)l * DM * DM + (size_t)n * DM + 768 + gi * 64 + i4 * 16); d[0] = a; d[1] = b2;
                continue;
            }
            if (r < I_OUT) { const int q = r - I_FOLD, kb = q % 24, nb = (q / 24) & 3, l = q / 96; transpose_batch16w(w_out + (size_t)l * DM * DM, DM, nb, kb * 32, Wout + (size_t)l * DM * DM, 0, lane); continue; }
            r -= I_OUT;
            if (r < I_IN) { const int kb = r & 31, nb = (r >> 5) % 10, l = (r >> 5) / 10; transpose_batch16w(w_in + (size_t)l * DM * INW, INW, nb, kb * 32, Win + (size_t)l * INW * DM, 2, lane); continue; }
        }
    }
    SEAM(0);

    { constexpr int l = 0;
        const int pb = 1 + 9 * l; const bool has_next = l + 1 < DEPTH;
        const int nmoe = has_next ? TT : TL;

        if (IN(pb + 0) && l == 0) {
            PH_IDS(); DEF_WS(); const float* g = A->in[6] + l * DM;
            f32x4 vn[2][4];
            if (gw * 2 < TT) {
#pragma unroll
                for (int r = 0; r < 2; ++r) { const int row = gw * 2 + r; const float* src = row < TL ? xl + (size_t)row * DM : xc + (size_t)(row - TL) * DM;
#pragma unroll
                    for (int jj = 0; jj < 2; ++jj) { const int col = (lane + 64 * jj) * 8; vn[r][2 * jj] = *(const f32x4*)(src + col); vn[r][2 * jj + 1] = *(const f32x4*)(src + col + 4); } }
            }
            for (int row0 = gw * 2; row0 < TT; row0 += NGW * 2) {
                f32x4 v[2][4]; float ss[2];
#pragma unroll
                for (int r = 0; r < 2; ++r)
#pragma unroll
                    for (int j = 0; j < 4; ++j) v[r][j] = vn[r][j];
                if (row0 + NGW * 2 < TT) {
#pragma unroll
                    for (int r = 0; r < 2; ++r) { const int row = row0 + NGW * 2 + r; const float* src = row < TL ? xl + (size_t)row * DM : xc + (size_t)(row - TL) * DM;
#pragma unroll
                        for (int jj = 0; jj < 2; ++jj) { const int col = (lane + 64 * jj) * 8; vn[r][2 * jj] = *(const f32x4*)(src + col); vn[r][2 * jj + 1] = *(const f32x4*)(src + col + 4); } }
                }
#pragma unroll
                for (int r = 0; r < 2; ++r) {
                    const int row = row0 + r; ss[r] = 0.f;
#pragma unroll
                    for (int jj = 0; jj < 2; ++jj) { const int col = (lane + 64 * jj) * 8;
                        *(u32x4*)((bf16*)ACT + (size_t)row * DM + col) = pack8(v[r][2 * jj], v[r][2 * jj + 1]); }
                }
#pragma unroll
                for (int r = 0; r < 2; ++r) {
                    const int row = row0 + r; const int b = row < TL ? (row >> 12) : 16;
                    const float* sh = modl + (size_t)b * (NMOD * DM); const float* sc = sh + DM;
#pragma unroll
                    for (int j = 0; j < 4; ++j) ss[r] += (v[r][j].x * v[r][j].x + v[r][j].y * v[r][j].y) + (v[r][j].z * v[r][j].z + v[r][j].w * v[r][j].w);
                    const float rstd = __builtin_amdgcn_rsqf(wave_sum(ss[r]) * (1.0f / DM) + EPS);
#pragma unroll
                    for (int jj = 0; jj < 2; ++jj) {
                        const int col = (lane + 64 * jj) * 8; f32x4 y[2];
#pragma unroll
                        for (int h = 0; h < 2; ++h) y[h] = (v[r][2 * jj + h] * rstd) * *(const f32x4*)(g + col + 4 * h) * (*(const f32x4*)(sc + col + 4 * h) + 1.0f) + *(const f32x4*)(sh + col + 4 * h);
                        *(u32x4*)(H + (size_t)row * DM + col) = pack8(y[0], y[1]);
                    }
                }
            }
        }
        if (l == 0)
        SEAM(pb + 0);
        if (IN(pb + 1)) {
            PH_IDS(); DEF_WS(); const float* q_norm_g = A->in[9]; const float* k_norm_g = A->in[10];
            pg8::Gemm g{H, Win + (size_t)l * INW * DM, TT, INW, DM, 0}; InprojOrder S; S.init(has_next ? 10 : 4, G, bx);
            { PG8_LAS float* tb = (PG8_LAS float*)(lds + LDS_EPI);
              for (int i = tid; i < 1088; i += NTHR) tb[i] = i < 512 ? ropeC[i] : (i < 1024 ? ropeS[i - 512] : (i < 1056 ? q_norm_g[l * 32 + i - 1024] : k_norm_g[l * 32 + i - 1056]));
              __syncthreads(); }
            EpiInproj E{Qb, Qcb, Kb, Vb, CPU, (const PG8_LAS float*)(lds + LDS_EPI)};
            pg8::gemm_phase<EpiInproj, InprojOrder, true, true>(lds, g, S, E);
        }
        SEAM(pb + 1);
        if (IN(pb + 2)) {
            PH_IDS(); DEF_WS(); const float* subln_g = A->in[15]; const float* conv_w = A->in[16];
            {
                const float lam = scal[2 * l], oscale = 1.0f - scal[2 * l + 1]; const float* sg = subln_g + l * 64;
                const int vcu = (G % 8 == 0) ? (bx % 8) * (G / 8) + bx / 8 : bx;
                const int nunits = 2048 + (has_next ? 128 : 0);
                int xwb = gw;
                for (int u = vcu; u < nunits; u += G) {
                    const bool latq = u < 2048; const int i = u >> 8, v = u & 255;
                    const int bh = latq ? (v >> 5) * 16 + i * 2 + ((v & 31) >> 4) : u - 2048, qb = latq ? (v & 15) : 0;
                    const bf16* Qu = latq ? Qb + (size_t)bh * SEQ * 64 : Qcb + (size_t)bh * CTXL * 64;
                    bf16* mp = MIX + (latq ? ((size_t)(bh >> 3) * SEQ + qb * 256) : ((size_t)TL + (bh >> 3) * CTXL)) * DM + (bh & 7) * 64;
                    XwMid mid; mid.setup(l, xwb, A->in[22], A->in[24], (unsigned char*)Wgu, (unsigned char*)Wdn, lane);
                    fa::attn_unit(mid, lds, Qu, Kb + (size_t)bh * NKEY * 64, Vb + (size_t)bh * NKEY * 64, qb * 256, latq ? NKEY / 64 : CTXL / 64, lam, oscale, sg, mp, tid);
                    if (xwb < XW_BATCHES) xwb += NGW;
                }
                for (; xwb < XW_BATCHES; xwb += NGW) expert_weight_batch(l, xwb, A->in[22], A->in[24], (unsigned char*)Wgu, (unsigned char*)Wdn, lane);
            }
            {
                const int nrows = has_next ? TT : TL; const float* cw = conv_w + l * 768;
                for (int row0 = gw * 4; row0 < nrows; row0 += NGW * 4) {
                    const bool lat = row0 < TL; const int pos0 = lat ? (row0 & 4095) : ((row0 - TL) & 255), len = lat ? SEQ : CTXL;
                    const bf16* prow = CPU + (size_t)row0 * 768;
                    const bool cv = lane < 32; const int ch = (lane & 31) * 8, half = cv ? 1 : 1 << ((lane - 32) >> 3);
                    const int off0 = half, nk = cv ? 6 : 2 * half + 3, colA = cv ? ch : 512 + ch, colB = cv ? 256 + ch : 512 + ch;
                    u32x4 v[23];
#pragma unroll
                    for (int r = 0; r < 4; ++r) v[r] = *(const u32x4*)(prow + (size_t)r * 768 + colA);
#pragma unroll
                    for (int k = 0; k < 19; ++k) { const int ro = k - off0, p = pos0 + ro; v[4 + k] = (u32x4){0u, 0u, 0u, 0u}; if (k < nk && p >= 0 && p < len) v[4 + k] = *(const u32x4*)(prow + (long)ro * 768 + colB); }
                    if (cv) {
                        f32x4 w0[2], w1[2], w2[2];
#pragma unroll
                        for (int hh = 0; hh < 2; ++hh) { w0[hh] = *(const f32x4*)(cw + ch + 4 * hh); w1[hh] = *(const f32x4*)(cw + 256 + ch + 4 * hh); w2[hh] = *(const f32x4*)(cw + 512 + ch + 4 * hh); }
#pragma unroll
                        for (int r = 0; r < 4; ++r) {
                            f32x4 o[2];
#pragma unroll
                            for (int hh = 0; hh < 2; ++hh) {
                                const f32x4 m = (f32x4){bflo(v[4 + r][2 * hh]), bfhi(v[4 + r][2 * hh]), bflo(v[4 + r][2 * hh + 1]), bfhi(v[4 + r][2 * hh + 1])};
                                const f32x4 c = (f32x4){bflo(v[5 + r][2 * hh]), bfhi(v[5 + r][2 * hh]), bflo(v[5 + r][2 * hh + 1]), bfhi(v[5 + r][2 * hh + 1])};
                                const f32x4 p = (f32x4){bflo(v[6 + r][2 * hh]), bfhi(v[6 + r][2 * hh]), bflo(v[6 + r][2 * hh + 1]), bfhi(v[6 + r][2 * hh + 1])};
                                const f32x4 b = (f32x4){bflo(v[r][2 * hh]), bfhi(v[r][2 * hh]), bflo(v[r][2 * hh + 1]), bfhi(v[r][2 * hh + 1])};
                                o[hh] = b * (w0[hh] * m + w1[hh] * c + w2[hh] * p);
                            }
                            *(u32x4*)(MIX + (size_t)(row0 + r) * DM + 512 + ch) = pack8(o[0], o[1]);
                        }
                    } else {
                        f32x4 s0[4], s1[4];
#pragma unroll
                        for (int r = 0; r < 4; ++r) { s0[r] = (f32x4){0.f, 0.f, 0.f, 0.f}; s1[r] = (f32x4){0.f, 0.f, 0.f, 0.f}; }
#pragma unroll
                        for (int u = 0; u < 19; ++u) {
                            const u32x4 x = v[4 + u];
                            const f32x4 a0 = (f32x4){bflo(x.x), bfhi(x.x), bflo(x.y), bfhi(x.y)}, a1 = (f32x4){bflo(x.z), bfhi(x.z), bflo(x.w), bfhi(x.w)};
#pragma unroll
                            for (int r = 0; r < 4; ++r) { const bool in = (u >= r) && (u < r + 2 * half); const float m = in ? 1.0f : 0.0f; s0[r] += a0 * m; s1[r] += a1 * m; }
                        }
#pragma unroll
                        for (int r = 0; r < 4; ++r) {
                            const int pos = pos0 + r; const int cnt = min(pos + half, len) - max(pos - half, 0);
                            const u32x4 uc = v[r]; const float inv = __builtin_amdgcn_rcpf((float)cnt);
                            const f32x4 d0 = s0[r] * inv - (f32x4){bflo(uc.x), bfhi(uc.x), bflo(uc.y), bfhi(uc.y)}, d1 = s1[r] * inv - (f32x4){bflo(uc.z), bfhi(uc.z), bflo(uc.w), bfhi(uc.w)};
                            *(u32x4*)(MIX + (size_t)(row0 + r) * DM + 768 + ch) = pack8(d0, d1);
                        }
                    }
                }
            }
        }
        SEAM(pb + 2);
        if (IN(pb + 3)) {
            PH_IDS(); DEF_WS();
            const int M = has_next ? TT : TL;
            pg8::Gemm g{MIX, Wout + (size_t)l * DM * DM, M, DM, DM, 0}; PlainOrder S; S.init(M, DM, G, bx);
            EpiResid E{(const bf16*)ACT, modl + 2 * DM, X1, lds};
            pg8::gemm_phase<EpiResid, PlainOrder, true, true>(lds, g, S, E);
        }
        SEAM(pb + 3);
        if (IN(pb + 4)) {
            PH_IDS(); DEF_WS(); const float* router_b = A->in[21]; const float* norm2_g = A->in[7];
            const bf16* wrt_hi = WSP(bf16, WS_WRT) + (size_t)l * 65536; const bf16* wrt_lo = wrt_hi + 32768;
            const float* br = router_b + l * NEXP; const float* g = norm2_g + l * DM;
            constexpr int TP = 2064;
            LAS unsigned char* Thi = lds; LAS unsigned char* Tlo = lds + 32 * TP; LAS unsigned char* PART = lds + 64 * TP; LAS float* LOG = (LAS float*)(lds + 64 * TP + 4096);
            static_assert(64 * TP + 8192 <= LDS_CTL, "router LDS map");
            const int eh = wave & 1, rh = (wave >> 1) & 1, kh = wave >> 2, n16 = lane & 15, q4 = lane >> 4;
            fa::bf16x8 ah[16];
#pragma unroll
            for (int st = 0; st < 16; ++st) { const int k = kh * 512 + 32 * st + 8 * q4;
                ah[st] = *(const fa::bf16x8*)(wrt_hi + (eh * 16 + n16) * DM + k); }
            const bf16* alp = wrt_lo + (eh * 16 + n16) * DM + kh * 512 + 8 * q4;
            const f32x4 brv = *(const f32x4*)(br + eh * 16 + 4 * q4);
            if (tid < 32) lctl[tid] = 0;
            __syncthreads();
            u32x4 xq[4][2];
            if (bx < nmoe / 32) {
#pragma unroll
                for (int rr = 0; rr < 4; ++rr)
#pragma unroll
                    for (int j = 0; j < 2; ++j) xq[rr][j] = *(const u32x4*)(X1 + (size_t)(bx * 32 + wave * 4 + rr) * DM + lane * 16 + 8 * j);
            }
            for (int grp = bx; grp < nmoe / 32; grp += G) {
                const int row0 = grp * 32; const int b = row0 < TL ? (row0 >> 12) : 16;
                const float* sh = modl + (size_t)b * (NMOD * DM) + 3 * DM; const float* sc = sh + DM;
                const int col = lane * 16;
                f32x4 gm[4], sv[4];
#pragma unroll
                for (int j = 0; j < 4; ++j) { gm[j] = *(const f32x4*)(g + col + 4 * j) * (*(const f32x4*)(sc + col + 4 * j) + 1.0f); sv[j] = *(const f32x4*)(sh + col + 4 * j); }
#pragma unroll
                for (int rr = 0; rr < 4; ++rr) {
                    const int rl = wave * 4 + rr, row = row0 + rl; f32x4 v[4]; float ss = 0.f;
#pragma unroll
                    for (int j = 0; j < 2; ++j) { const u32x4 xb = xq[rr][j]; v[2 * j] = (f32x4){bflo(xb.x), bfhi(xb.x), bflo(xb.y), bfhi(xb.y)}; v[2 * j + 1] = (f32x4){bflo(xb.z), bfhi(xb.z), bflo(xb.w), bfhi(xb.w)}; }
#pragma unroll
                    for (int j = 0; j < 4; ++j) ss += (v[j].x * v[j].x + v[j].y * v[j].y) + (v[j].z * v[j].z + v[j].w * v[j].w);
                    const float rstd = __builtin_amdgcn_rsqf(wave_sum(ss) * (1.0f / DM) + EPS);
                    u32x4 h8, hiw[2], low[2];
#pragma unroll
                    for (int j = 0; j < 4; ++j) {
                        const f32x4 h = (v[j] * rstd) * gm[j] + sv[j];
                        h8[j] = pk4_fp8(h.x, h.y, h.z, h.w);
                        const unsigned h0 = pg8::cvt_pk_bf16(h.x, h.y), h1 = pg8::cvt_pk_bf16(h.z, h.w);
                        hiw[j >> 1][2 * (j & 1)] = h0; hiw[j >> 1][2 * (j & 1) + 1] = h1;
                        low[j >> 1][2 * (j & 1)] = pg8::cvt_pk_bf16(h.x - bflo(h0), h.y - bfhi(h0)); low[j >> 1][2 * (j & 1) + 1] = pg8::cvt_pk_bf16(h.z - bflo(h1), h.w - bfhi(h1));
                    }
                    *(u32x4*)((unsigned char*)H + (size_t)row * DM + col) = h8;
#pragma unroll
                    for (int j = 0; j < 2; ++j) { *(LAS u32x4*)(Thi + rl * TP + col * 2 + 16 * j) = hiw[j]; *(LAS u32x4*)(Tlo + rl * TP + col * 2 + 16 * j) = low[j]; }
                }
                __syncthreads();
                if (grp + G < nmoe / 32) {
#pragma unroll
                    for (int rr = 0; rr < 4; ++rr)
#pragma unroll
                        for (int j = 0; j < 2; ++j) xq[rr][j] = *(const u32x4*)(X1 + (size_t)((grp + G) * 32 + wave * 4 + rr) * DM + lane * 16 + 8 * j);
                }
                f32x4 acc = (f32x4){0.f, 0.f, 0.f, 0.f};
#pragma unroll
                for (int st = 0; st < 16; ++st) {
                    const int kb = (kh * 512 + 32 * st + 8 * q4) * 2;
                    const fa::bf16x8 bh = *(const LAS fa::bf16x8*)(Thi + (rh * 16 + n16) * TP + kb), bl = *(const LAS fa::bf16x8*)(Tlo + (rh * 16 + n16) * TP + kb);
                    acc = __builtin_amdgcn_mfma_f32_16x16x32_bf16(ah[st], bh, acc, 0, 0, 0);
                    acc = __builtin_amdgcn_mfma_f32_16x16x32_bf16(ah[st], bl, acc, 0, 0, 0);
                    acc = __builtin_amdgcn_mfma_f32_16x16x32_bf16(*(const fa::bf16x8*)(alp + 32 * st), bh, acc, 0, 0, 0);
                }
                if (kh == 1) *(LAS f32x4*)(PART + (wave & 3) * 1024 + lane * 16) = acc;
                __syncthreads();
                if (kh == 0) { acc += *(const LAS f32x4*)(PART + (wave & 3) * 1024 + lane * 16); acc += brv; *(LAS f32x4*)(LOG + (rh * 16 + n16) * 32 + eh * 16 + 4 * q4) = acc; }
                __syncthreads();
                {
                    const int rr = lane >> 4, j16 = lane & 15, rl = wave * 4 + rr, tok = row0 + rl;
                    const f32x2v xx = *(const LAS f32x2v*)(LOG + rl * 32 + 2 * j16);
                    float x0 = xx[0], x1 = xx[1];
                    float bv[4]; int be[4];
#pragma unroll
                    for (int k = 0; k < 4; ++k) {
                        float v = x0 >= x1 ? x0 : x1; int e = x0 >= x1 ? 2 * j16 : 2 * j16 + 1;
#define TOP_STEP(CTRL) { const float v2 = dpp_movf<CTRL>(v); const int e2 = dpp_movi<CTRL>(e); const bool tk = (v2 > v) || (v2 == v && e2 < e); v = tk ? v2 : v; e = tk ? e2 : e; }
                        TOP_STEP(0xB1) TOP_STEP(0x4E) TOP_STEP(0x141) TOP_STEP(0x140)
#undef TOP_STEP
                        bv[k] = v; be[k] = e;
                        if (e == 2 * j16) x0 = -3.0e38f;
                        if (e == 2 * j16 + 1) x1 = -3.0e38f;
                    }
                    float pe[4], sm = 0.f;
#pragma unroll
                    for (int k = 0; k < 4; ++k) { pe[k] = __builtin_amdgcn_exp2f((bv[k] - bv[0]) * 1.4426950408889634f); sm += pe[k]; }
                    if (j16 < 4) {
                        const int ek = j16 == 0 ? be[0] : j16 == 1 ? be[1] : j16 == 2 ? be[2] : be[3]; const float pk = j16 == 0 ? pe[0] : j16 == 1 ? pe[1] : j16 == 2 ? pe[2] : pe[3];
                        const int rank = atomicAdd((int*)(lctl + ek), 1);
                        ASGE[(size_t)tok * 4 + j16] = ek | (rank << 8); ASGW[(size_t)tok * 4 + j16] = pk * __builtin_amdgcn_rcpf(sm);
                    }
                }
            }
            __syncthreads();
            if (tid < 32) wgcnt[bx * 32 + tid] = lctl[tid];
        }
        SEAM(pb + 4);
        if (IN(pb + 5)) {
            PH_IDS(); DEF_WS();
            {
                LAS int* sc = (LAS int*)lds; const int e = tid & 31, part = tid >> 5, per = (G + 15) >> 4;
                int tot = 0, off = 0;
                for (int j = 0; j < per; ++j) { const int w = part * per + j; if (w < G) { const int cc = wgcnt[w * 32 + e]; tot += cc; if (w < bx) off += cc; } }
                sc[part * 32 + e] = tot; sc[512 + part * 32 + e] = off;
                __syncthreads();
                if (tid < 32) { int t2 = 0, o2 = 0;
#pragma unroll
                    for (int p = 0; p < 16; ++p) { t2 += sc[p * 32 + tid]; o2 += sc[512 + p * 32 + tid]; }
                    lctl[96 + tid] = t2; lctl[64 + tid] = o2; }
            }
            __syncthreads();
            if (tid == 0) {
                int blk = 0;
                for (int e = 0; e < NEXP; ++e) { lctl[32 + e] = blk * 256; blk += (lctl[96 + e] + 255) >> 8; }
                *(LAS int*)(lds + LDS_NBLK) = blk;
                if (bx == 0) ctll[CTL_NBLK] = blk;
            }
            __syncthreads();
            if (tid < NEXP) { const int b0 = lctl[32 + tid] >> 8, nb = (lctl[96 + tid] + 255) >> 8; for (int j = 0; j < nb; ++j) (lds + LDS_BTE)[b0 + j] = (unsigned char)tid; }
            if (bx == 0 && tid < NEXP) { const int b0 = lctl[32 + tid] >> 8, nb = (lctl[96 + tid] + 255) >> 8; for (int j = 0; j < nb; ++j) ctll[CTL_BLKE + b0 + j] = tid; }
            for (int e = bx; e < NEXP; e += G) {
                const int beg = lctl[32 + e] + lctl[96 + e], end = lctl[32 + e] + (((lctl[96 + e] + 255) >> 8) << 8);
                for (int s = beg + tid; s < end; s += NTHR) { ROWTOK[s] = 0; ROWW[s] = 0.f; }
            }
            for (int grp = bx; grp < nmoe / 32; grp += G) {
                if (tid < 128) {
                    const int tok = grp * 32 + (tid >> 2), k = tid & 3; const int ev = ASGE[(size_t)tok * 4 + k], e = ev & 255, rank = ev >> 8;
                    const int slot = lctl[32 + e] + lctl[64 + e] + rank;
                    ROWTOK[slot] = tok; ROWW[slot] = ASGW[(size_t)tok * 4 + k]; SLOTOF[(size_t)tok * 4 + k] = slot;
                }
            }
        }
        SEAM(pb + 5);
        if (IN(pb + 6)) {
            PH_IDS(); DEF_WS(); const float* b_gu = A->in[23];
            pg8::Gemm g{H, (const bf16*)((const unsigned char*)Wgu + (size_t)l * NEXP * 2048 * DM), 0, 2048, DM / 2, 0}; GroupedOrder S; S.init(lds, 8, 2048, G, bx, ROWTOK);
            EpiSwiglu E{ctll, b_gu + (size_t)l * NEXP * 2048, (unsigned char*)ACT, lds};
            pg8::gemm_phase<EpiSwiglu, GroupedOrder, true, true, true, true>(lds, g, S, E);
        }
        SEAM(pb + 6);
        if (IN(pb + 7)) {
            PH_IDS(); DEF_WS(); const float* b_dn = A->in[25];
            pg8::Gemm g{ACT, (const bf16*)((const unsigned char*)Wdn + (size_t)l * NEXP * DM * DM), 0, DM, DM / 2, 0}; GroupedOrder S; S.init(lds, 4, 1024, G, bx);
            EpiDown E{ctll, b_dn + (size_t)l * NEXP * DM, ROWW, (unsigned char*)Y, lds};
            pg8::gemm_phase<EpiDown, GroupedOrder, true, true, true>(lds, g, S, E);
        }
        SEAM(pb + 7);
        if (IN(pb + 8)) {
            PH_IDS(); DEF_WS();
            const float* g1n = A->in[6] + (has_next ? (l + 1) * DM : 0); const float* modn = mod + (size_t)(has_next ? l + 1 : l) * 17 * NMOD * DM;
            i32x4 sl4n[4];
            if (gw * 4 < nmoe) {
#pragma unroll
                for (int r = 0; r < 4; ++r) sl4n[r] = *(const i32x4*)(SLOTOF + (size_t)(gw * 4 + r) * 4);
            }
            for (int row0 = gw * 4; row0 < nmoe; row0 += NGW * 4) {
                const int b = row0 < TL ? (row0 >> 12) : 16;
                const float* gp = modl + (size_t)b * (NMOD * DM) + 5 * DM;
                const int col = lane * 8;
                i32x4 sl4[4];
#pragma unroll
                for (int r = 0; r < 4; ++r) sl4[r] = sl4n[r];
                if (row0 + NGW * 4 < nmoe) {
#pragma unroll
                    for (int r = 0; r < 4; ++r) sl4n[r] = *(const i32x4*)(SLOTOF + (size_t)(row0 + NGW * 4 + r) * 4);
                }
                u32x4 xb[4][2];
#pragma unroll
                for (int r = 0; r < 4; ++r) { xb[r][0] = *(const u32x4*)(X1 + (size_t)(row0 + r) * DM + col); xb[r][1] = *(const u32x4*)(X1 + (size_t)(row0 + r) * DM + 512 + col); }
                f32x4 gt[4], gm[4], sv[4];
#pragma unroll
                for (int q = 0; q < 4; ++q) gt[q] = *(const f32x4*)(gp + (q >> 1) * 512 + col + 4 * (q & 1)) * Y8_INV;
                if (has_next) { const float* sh = modn + (size_t)b * (NMOD * DM); const float* sc = sh + DM;
#pragma unroll
                    for (int q = 0; q < 4; ++q) { const int cq = (q >> 1) * 512 + col + 4 * (q & 1); gm[q] = *(const f32x4*)(g1n + cq) * (*(const f32x4*)(sc + cq) + 1.0f); sv[q] = *(const f32x4*)(sh + cq); } }
                u32x2 yv[4][4][2];
#pragma unroll
                for (int r = 0; r < 4; ++r)
#pragma unroll
                    for (int k = 0; k < 4; ++k) { yv[r][k][0] = *(const u32x2*)((const unsigned char*)Y + (size_t)sl4[r][k] * DM + col); yv[r][k][1] = *(const u32x2*)((const unsigned char*)Y + (size_t)sl4[r][k] * DM + 512 + col); }
#pragma unroll
                for (int r = 0; r < 4; ++r) {
                    const int row = row0 + r;
                    float* op = row < TL ? out + (size_t)row * DM : X2C + (size_t)(row - TL) * DM;
                    f32x4 a[4];
#pragma unroll
                    for (int q = 0; q < 4; ++q) a[q] = (f32x4){0.f, 0.f, 0.f, 0.f};
#pragma unroll
                    for (int k = 0; k < 4; ++k)
#pragma unroll
                        for (int q = 0; q < 4; ++q) { const unsigned y = yv[r][k][q >> 1][q & 1]; const auto lo = __builtin_amdgcn_cvt_pk_f32_fp8((int)y, false), hi = __builtin_amdgcn_cvt_pk_f32_fp8((int)y, true); a[q] += (f32x4){lo[0], lo[1], hi[0], hi[1]}; }
                    f32x4 xo[4]; float ss = 0.f;
#pragma unroll
                    for (int q = 0; q < 4; ++q) {
                        xo[q] = (f32x4){bflo(xb[r][q >> 1][(q & 1) * 2]), bfhi(xb[r][q >> 1][(q & 1) * 2]), bflo(xb[r][q >> 1][(q & 1) * 2 + 1]), bfhi(xb[r][q >> 1][(q & 1) * 2 + 1])} + gt[q] * a[q];
                        if (!has_next) *(f32x4*)(op + (q >> 1) * 512 + col + 4 * (q & 1)) = xo[q];
                    }
                    if (has_next) { *(u32x4*)((bf16*)ACT + (size_t)row * DM + col) = pack8(xo[0], xo[1]); *(u32x4*)((bf16*)ACT + (size_t)row * DM + 512 + col) = pack8(xo[2], xo[3]); }
                    if (has_next) {
#pragma unroll
                        for (int q = 0; q < 4; ++q) ss += (xo[q].x * xo[q].x + xo[q].y * xo[q].y) + (xo[q].z * xo[q].z + xo[q].w * xo[q].w);
                        const float rstd = __builtin_amdgcn_rsqf(wave_sum(ss) * (1.0f / DM) + EPS);
                        f32x4 y[4];
#pragma unroll
                        for (int q = 0; q < 4; ++q) y[q] = (xo[q] * rstd) * gm[q] + sv[q];
                        *(u32x4*)(H + (size_t)row * DM + col) = pack8(y[0], y[1]); *(u32x4*)(H + (size_t)row * DM + 512 + col) = pack8(y[2], y[3]);
                    }
                }
            }
        }
        SEAM(pb + 8);
    }
    { constexpr int l = 1;
        const int pb = 1 + 9 * l; const bool has_next = l + 1 < DEPTH;
        const int nmoe = has_next ? TT : TL;

        if (IN(pb + 0) && l == 0) {
            PH_IDS(); DEF_WS(); const float* g = A->in[6] + l * DM;
            f32x4 vn[2][4];
            if (gw * 2 < TT) {
#pragma unroll
                for (int r = 0; r < 2; ++r) { const int row = gw * 2 + r; const float* src = row < TL ? xl + (size_t)row * DM : xc + (size_t)(row - TL) * DM;
#pragma unroll
                    for (int jj = 0; jj < 2; ++jj) { const int col = (lane + 64 * jj) * 8; vn[r][2 * jj] = *(const f32x4*)(src + col); vn[r][2 * jj + 1] = *(const f32x4*)(src + col + 4); } }
            }
            for (int row0 = gw * 2; row0 < TT; row0 += NGW * 2) {
                f32x4 v[2][4]; float ss[2];
#pragma unroll
                for (int r = 0; r < 2; ++r)
#pragma unroll
                    for (int j = 0; j < 4; ++j) v[r][j] = vn[r][j];
                if (row0 + NGW * 2 < TT) {
#pragma unroll
                    for (int r = 0; r < 2; ++r) { const int row = row0 + NGW * 2 + r; const float* src = row < TL ? xl + (size_t)row * DM : xc + (size_t)(row - TL) * DM;
#pragma unroll
                        for (int jj = 0; jj < 2; ++jj) { const int col = (lane + 64 * jj) * 8; vn[r][2 * jj] = *(const f32x4*)(src + col); vn[r][2 * jj + 1] = *(const f32x4*)(src + col + 4); } }
                }
#pragma unroll
                for (int r = 0; r < 2; ++r) {
                    const int row = row0 + r; ss[r] = 0.f;
#pragma unroll
                    for (int jj = 0; jj < 2; ++jj) { const int col = (lane + 64 * jj) * 8;
                        *(u32x4*)((bf16*)ACT + (size_t)row * DM + col) = pack8(v[r][2 * jj], v[r][2 * jj + 1]); }
                }
#pragma unroll
                for (int r = 0; r < 2; ++r) {
                    const int row = row0 + r; const int b = row < TL ? (row >> 12) : 16;
                    const float* sh = modl + (size_t)b * (NMOD * DM); const float* sc = sh + DM;
#pragma unroll
                    for (int j = 0; j < 4; ++j) ss[r] += (v[r][j].x * v[r][j].x + v[r][j].y * v[r][j].y) + (v[r][j].z * v[r][j].z + v[r][j].w * v[r][j].w);
                    const float rstd = __builtin_amdgcn_rsqf(wave_sum(ss[r]) * (1.0f / DM) + EPS);
#pragma unroll
                    for (int jj = 0; jj < 2; ++jj) {
                        const int col = (lane + 64 * jj) * 8; f32x4 y[2];
#pragma unroll
                        for (int h = 0; h < 2; ++h) y[h] = (v[r][2 * jj + h] * rstd) * *(const f32x4*)(g + col + 4 * h) * (*(const f32x4*)(sc + col + 4 * h) + 1.0f) + *(const f32x4*)(sh + col + 4 * h);
                        *(u32x4*)(H + (size_t)row * DM + col) = pack8(y[0], y[1]);
                    }
                }
            }
        }
        if (l == 0)
        SEAM(pb + 0);
        if (IN(pb + 1)) {
            PH_IDS(); DEF_WS(); const float* q_norm_g = A->in[9]; const float* k_norm_g = A->in[10];
            pg8::Gemm g{H, Win + (size_t)l * INW * DM, TT, INW, DM, 0}; InprojOrder S; S.init(has_next ? 10 : 4, G, bx);
            { PG8_LAS float* tb = (PG8_LAS float*)(lds + LDS_EPI);
              for (int i = tid; i < 1088; i += NTHR) tb[i] = i < 512 ? ropeC[i] : (i < 1024 ? ropeS[i - 512] : (i < 1056 ? q_norm_g[l * 32 + i - 1024] : k_norm_g[l * 32 + i - 1056]));
              __syncthreads(); }
            EpiInproj E{Qb, Qcb, Kb, Vb, CPU, (const PG8_LAS float*)(lds + LDS_EPI)};
            pg8::gemm_phase<EpiInproj, InprojOrder, true, true>(lds, g, S, E);
        }
        SEAM(pb + 1);
        if (IN(pb + 2)) {
            PH_IDS(); DEF_WS(); const float* subln_g = A->in[15]; const float* conv_w = A->in[16];
            {
                const float lam = scal[2 * l], oscale = 1.0f - scal[2 * l + 1]; const float* sg = subln_g + l * 64;
                const int vcu = (G % 8 == 0) ? (bx % 8) * (G / 8) + bx / 8 : bx;
                const int nunits = 2048 + (has_next ? 128 : 0);
                int xwb = gw;
                for (int u = vcu; u < nunits; u += G) {
                    const bool latq = u < 2048; const int i = u >> 8, v = u & 255;
                    const int bh = latq ? (v >> 5) * 16 + i * 2 + ((v & 31) >> 4) : u - 2048, qb = latq ? (v & 15) : 0;
                    const bf16* Qu = latq ? Qb + (size_t)bh * SEQ * 64 : Qcb + (size_t)bh * CTXL * 64;
                    bf16* mp = MIX + (latq ? ((size_t)(bh >> 3) * SEQ + qb * 256) : ((size_t)TL + (bh >> 3) * CTXL)) * DM + (bh & 7) * 64;
                    XwMid mid; mid.setup(l, xwb, A->in[22], A->in[24], (unsigned char*)Wgu, (unsigned char*)Wdn, lane);
                    fa::attn_unit(mid, lds, Qu, Kb + (size_t)bh * NKEY * 64, Vb + (size_t)bh * NKEY * 64, qb * 256, latq ? NKEY / 64 : CTXL / 64, lam, oscale, sg, mp, tid);
                    if (xwb < XW_BATCHES) xwb += NGW;
                }
                for (; xwb < XW_BATCHES; xwb += NGW) expert_weight_batch(l, xwb, A->in[22], A->in[24], (unsigned char*)Wgu, (unsigned char*)Wdn, lane);
            }
            {
                const int nrows = has_next ? TT : TL; const float* cw = conv_w + l * 768;
                for (int row0 = gw * 4; row0 < nrows; row0 += NGW * 4) {
                    const bool lat = row0 < TL; const int pos0 = lat ? (row0 & 4095) : ((row0 - TL) & 255), len = lat ? SEQ : CTXL;
                    const bf16* prow = CPU + (size_t)row0 * 768;
                    const bool cv = lane < 32; const int ch = (lane & 31) * 8, half = cv ? 1 : 1 << ((lane - 32) >> 3);
                    const int off0 = half, nk = cv ? 6 : 2 * half + 3, colA = cv ? ch : 512 + ch, colB = cv ? 256 + ch : 512 + ch;
                    u32x4 v[23];
#pragma unroll
                    for (int r = 0; r < 4; ++r) v[r] = *(const u32x4*)(prow + (size_t)r * 768 + colA);
#pragma unroll
                    for (int k = 0; k < 19; ++k) { const int ro = k - off0, p = pos0 + ro; v[4 + k] = (u32x4){0u, 0u, 0u, 0u}; if (k < nk && p >= 0 && p < len) v[4 + k] = *(const u32x4*)(prow + (long)ro * 768 + colB); }
                    if (cv) {
                        f32x4 w0[2], w1[2], w2[2];
#pragma unroll
                        for (int hh = 0; hh < 2; ++hh) { w0[hh] = *(const f32x4*)(cw + ch + 4 * hh); w1[hh] = *(const f32x4*)(cw + 256 + ch + 4 * hh); w2[hh] = *(const f32x4*)(cw + 512 + ch + 4 * hh); }
#pragma unroll
                        for (int r = 0; r < 4; ++r) {
                            f32x4 o[2];
#pragma unroll
                            for (int hh = 0; hh < 2; ++hh) {
                                const f32x4 m = (f32x4){bflo(v[4 + r][2 * hh]), bfhi(v[4 + r][2 * hh]), bflo(v[4 + r][2 * hh + 1]), bfhi(v[4 + r][2 * hh + 1])};
                                const f32x4 c = (f32x4){bflo(v[5 + r][2 * hh]), bfhi(v[5 + r][2 * hh]), bflo(v[5 + r][2 * hh + 1]), bfhi(v[5 + r][2 * hh + 1])};
                                const f32x4 p = (f32x4){bflo(v[6 + r][2 * hh]), bfhi(v[6 + r][2 * hh]), bflo(v[6 + r][2 * hh + 1]), bfhi(v[6 + r][2 * hh + 1])};
                                const f32x4 b = (f32x4){bflo(v[r][2 * hh]), bfhi(v[r][2 * hh]), bflo(v[r][2 * hh + 1]), bfhi(v[r][2 * hh + 1])};
                                o[hh] = b * (w0[hh] * m + w1[hh] * c + w2[hh] * p);
                            }
                            *(u32x4*)(MIX + (size_t)(row0 + r) * DM + 512 + ch) = pack8(o[0], o[1]);
                        }
                    } else {
                        f32x4 s0[4], s1[4];
#pragma unroll
                        for (int r = 0; r < 4; ++r) { s0[r] = (f32x4){0.f, 0.f, 0.f, 0.f}; s1[r] = (f32x4){0.f, 0.f, 0.f, 0.f}; }
#pragma unroll
                        for (int u = 0; u < 19; ++u) {
                            const u32x4 x = v[4 + u];
                            const f32x4 a0 = (f32x4){bflo(x.x), bfhi(x.x), bflo(x.y), bfhi(x.y)}, a1 = (f32x4){bflo(x.z), bfhi(x.z), bflo(x.w), bfhi(x.w)};
#pragma unroll
                            for (int r = 0; r < 4; ++r) { const bool in = (u >= r) && (u < r + 2 * half); const float m = in ? 1.0f : 0.0f; s0[r] += a0 * m; s1[r] += a1 * m; }
                        }
#pragma unroll
                        for (int r = 0; r < 4; ++r) {
                            const int pos = pos0 + r; const int cnt = min(pos + half, len) - max(pos - half, 0);
                            const u32x4 uc = v[r]; const float inv = __builtin_amdgcn_rcpf((float)cnt);
                            const f32x4 d0 = s0[r] * inv - (f32x4){bflo(uc.x), bfhi(uc.x), bflo(uc.y), bfhi(uc.y)}, d1 = s1[r] * inv - (f32x4){bflo(uc.z), bfhi(uc.z), bflo(uc.w), bfhi(uc.w)};
                            *(u32x4*)(MIX + (size_t)(row0 + r) * DM + 768 + ch) = pack8(d0, d1);
                        }
                    }
                }
            }
        }
        SEAM(pb + 2);
        if (IN(pb + 3)) {
            PH_IDS(); DEF_WS();
            const int M = has_next ? TT : TL;
            pg8::Gemm g{MIX, Wout + (size_t)l * DM * DM, M, DM, DM, 0}; PlainOrder S; S.init(M, DM, G, bx);
            EpiResid E{(const bf16*)ACT, modl + 2 * DM, X1, lds};
            pg8::gemm_phase<EpiResid, PlainOrder, true, true>(lds, g, S, E);
        }
        SEAM(pb + 3);
        if (IN(pb + 4)) {
            PH_IDS(); DEF_WS(); const float* router_b = A->in[21]; const float* norm2_g = A->in[7];
            const bf16* wrt_hi = WSP(bf16, WS_WRT) + (size_t)l * 65536; const bf16* wrt_lo = wrt_hi + 32768;
            const float* br = router_b + l * NEXP; const float* g = norm2_g + l * DM;
            constexpr int TP = 2064;
            LAS unsigned char* Thi = lds; LAS unsigned char* Tlo = lds + 32 * TP; LAS unsigned char* PART = lds + 64 * TP; LAS float* LOG = (LAS float*)(lds + 64 * TP + 4096);
            static_assert(64 * TP + 8192 <= LDS_CTL, "router LDS map");
            const int eh = wave & 1, rh = (wave >> 1) & 1, kh = wave >> 2, n16 = lane & 15, q4 = lane >> 4;
            fa::bf16x8 ah[16];
#pragma unroll
            for (int st = 0; st < 16; ++st) { const int k = kh * 512 + 32 * st + 8 * q4;
                ah[st] = *(const fa::bf16x8*)(wrt_hi + (eh * 16 + n16) * DM + k); }
            const bf16* alp = wrt_lo + (eh * 16 + n16) * DM + kh * 512 + 8 * q4;
            const f32x4 brv = *(const f32x4*)(br + eh * 16 + 4 * q4);
            if (tid < 32) lctl[tid] = 0;
            __syncthreads();
            u32x4 xq[4][2];
            if (bx < nmoe / 32) {
#pragma unroll
                for (int rr = 0; rr < 4; ++rr)
#pragma unroll
                    for (int j = 0; j < 2; ++j) xq[rr][j] = *(const u32x4*)(X1 + (size_t)(bx * 32 + wave * 4 + rr) * DM + lane * 16 + 8 * j);
            }
            for (int grp = bx; grp < nmoe / 32; grp += G) {
                const int row0 = grp * 32; const int b = row0 < TL ? (row0 >> 12) : 16;
                const float* sh = modl + (size_t)b * (NMOD * DM) + 3 * DM; const float* sc = sh + DM;
                const int col = lane * 16;
                f32x4 gm[4], sv[4];
#pragma unroll
                for (int j = 0; j < 4; ++j) { gm[j] = *(const f32x4*)(g + col + 4 * j) * (*(const f32x4*)(sc + col + 4 * j) + 1.0f); sv[j] = *(const f32x4*)(sh + col + 4 * j); }
#pragma unroll
                for (int rr = 0; rr < 4; ++rr) {
                    const int rl = wave * 4 + rr, row = row0 + rl; f32x4 v[4]; float ss = 0.f;
#pragma unroll
                    for (int j = 0; j < 2; ++j) { const u32x4 xb = xq[rr][j]; v[2 * j] = (f32x4){bflo(xb.x), bfhi(xb.x), bflo(xb.y), bfhi(xb.y)}; v[2 * j + 1] = (f32x4){bflo(xb.z), bfhi(xb.z), bflo(xb.w), bfhi(xb.w)}; }
#pragma unroll
                    for (int j = 0; j < 4; ++j) ss += (v[j].x * v[j].x + v[j].y * v[j].y) + (v[j].z * v[j].z + v[j].w * v[j].w);
                    const float rstd = __builtin_amdgcn_rsqf(wave_sum(ss) * (1.0f / DM) + EPS);
                    u32x4 h8, hiw[2], low[2];
#pragma unroll
                    for (int j = 0; j < 4; ++j) {
                        const f32x4 h = (v[j] * rstd) * gm[j] + sv[j];
                        h8[j] = pk4_fp8(h.x, h.y, h.z, h.w);
                        const unsigned h0 = pg8::cvt_pk_bf16(h.x, h.y), h1 = pg8::cvt_pk_bf16(h.z, h.w);
                        hiw[j >> 1][2 * (j & 1)] = h0; hiw[j >> 1][2 * (j & 1) + 1] = h1;
                        low[j >> 1][2 * (j & 1)] = pg8::cvt_pk_bf16(h.x - bflo(h0), h.y - bfhi(h0)); low[j >> 1][2 * (j & 1) + 1] = pg8::cvt_pk_bf16(h.z - bflo(h1), h.w - bfhi(h1));
                    }
                    *(u32x4*)((unsigned char*)H + (size_t)row * DM + col) = h8;
#pragma unroll
                    for (int j = 0; j < 2; ++j) { *(LAS u32x4*)(Thi + rl * TP + col * 2 + 16 * j) = hiw[j]; *(LAS u32x4*)(Tlo + rl * TP + col * 2 + 16 * j) = low[j]; }
                }
                __syncthreads();
                if (grp + G < nmoe / 32) {
#pragma unroll
                    for (int rr = 0; rr < 4; ++rr)
#pragma unroll
                        for (int j = 0; j < 2; ++j) xq[rr][j] = *(const u32x4*)(X1 + (size_t)((grp + G) * 32 + wave * 4 + rr) * DM + lane * 16 + 8 * j);
                }
                f32x4 acc = (f32x4){0.f, 0.f, 0.f, 0.f};
#pragma unroll
                for (int st = 0; st < 16; ++st) {
                    const int kb = (kh * 512 + 32 * st + 8 * q4) * 2;
                    const fa::bf16x8 bh = *(const LAS fa::bf16x8*)(Thi + (rh * 16 + n16) * TP + kb), bl = *(const LAS fa::bf16x8*)(Tlo + (rh * 16 + n16) * TP + kb);
                    acc = __builtin_amdgcn_mfma_f32_16x16x32_bf16(ah[st], bh, acc, 0, 0, 0);
                    acc = __builtin_amdgcn_mfma_f32_16x16x32_bf16(ah[st], bl, acc, 0, 0, 0);
                    acc = __builtin_amdgcn_mfma_f32_16x16x32_bf16(*(const fa::bf16x8*)(alp + 32 * st), bh, acc, 0, 0, 0);
                }
                if (kh == 1) *(LAS f32x4*)(PART + (wave & 3) * 1024 + lane * 16) = acc;
                __syncthreads();
                if (kh == 0) { acc += *(const LAS f32x4*)(PART + (wave & 3) * 1024 + lane * 16); acc += brv; *(LAS f32x4*)(LOG + (rh * 16 + n16) * 32 + eh * 16 + 4 * q4) = acc; }
                __syncthreads();
                {
                    const int rr = lane >> 4, j16 = lane & 15, rl = wave * 4 + rr, tok = row0 + rl;
                    const f32x2v xx = *(const LAS f32x2v*)(LOG + rl * 32 + 2 * j16);
                    float x0 = xx[0], x1 = xx[1];
                    float bv[4]; int be[4];
#pragma unroll
                    for (int k = 0; k < 4; ++k) {
                        float v = x0 >= x1 ? x0 : x1; int e = x0 >= x1 ? 2 * j16 : 2 * j16 + 1;
#define TOP_STEP(CTRL) { const float v2 = dpp_movf<CTRL>(v); const int e2 = dpp_movi<CTRL>(e); const bool tk = (v2 > v) || (v2 == v && e2 < e); v = tk ? v2 : v; e = tk ? e2 : e; }
                        TOP_STEP(0xB1) TOP_STEP(0x4E) TOP_STEP(0x141) TOP_STEP(0x140)
#undef TOP_STEP
                        bv[k] = v; be[k] = e;
                        if (e == 2 * j16) x0 = -3.0e38f;
                        if (e == 2 * j16 + 1) x1 = -3.0e38f;
                    }
                    float pe[4], sm = 0.f;
#pragma unroll
                    for (int k = 0; k < 4; ++k) { pe[k] = __builtin_amdgcn_exp2f((bv[k] - bv[0]) * 1.4426950408889634f); sm += pe[k]; }
                    if (j16 < 4) {
                        const int ek = j16 == 0 ? be[0] : j16 == 1 ? be[1] : j16 == 2 ? be[2] : be[3]; const float pk = j16 == 0 ? pe[0] : j16 == 1 ? pe[1] : j16 == 2 ? pe[2] : pe[3];
                        const int rank = atomicAdd((int*)(lctl + ek), 1);
                        ASGE[(size_t)tok * 4 + j16] = ek | (rank << 8); ASGW[(size_t)tok * 4 + j16] = pk * __builtin_amdgcn_rcpf(sm);
                    }
                }
            }
            __syncthreads();
            if (tid < 32) wgcnt[bx * 32 + tid] = lctl[tid];
        }
        SEAM(pb + 4);
        if (IN(pb + 5)) {
            PH_IDS(); DEF_WS();
            {
                LAS int* sc = (LAS int*)lds; const int e = tid & 31, part = tid >> 5, per = (G + 15) >> 4;
                int tot = 0, off = 0;
                for (int j = 0; j < per; ++j) { const int w = part * per + j; if (w < G) { const int cc = wgcnt[w * 32 + e]; tot += cc; if (w < bx) off += cc; } }
                sc[part * 32 + e] = tot; sc[512 + part * 32 + e] = off;
                __syncthreads();
                if (tid < 32) { int t2 = 0, o2 = 0;
#pragma unroll
                    for (int p = 0; p < 16; ++p) { t2 += sc[p * 32 + tid]; o2 += sc[512 + p * 32 + tid]; }
                    lctl[96 + tid] = t2; lctl[64 + tid] = o2; }
            }
            __syncthreads();
            if (tid == 0) {
                int blk = 0;
                for (int e = 0; e < NEXP; ++e) { lctl[32 + e] = blk * 256; blk += (lctl[96 + e] + 255) >> 8; }
                *(LAS int*)(lds + LDS_NBLK) = blk;
                if (bx == 0) ctll[CTL_NBLK] = blk;
            }
            __syncthreads();
            if (tid < NEXP) { const int b0 = lctl[32 + tid] >> 8, nb = (lctl[96 + tid] + 255) >> 8; for (int j = 0; j < nb; ++j) (lds + LDS_BTE)[b0 + j] = (unsigned char)tid; }
            if (bx == 0 && tid < NEXP) { const int b0 = lctl[32 + tid] >> 8, nb = (lctl[96 + tid] + 255) >> 8; for (int j = 0; j < nb; ++j) ctll[CTL_BLKE + b0 + j] = tid; }
            for (int e = bx; e < NEXP; e += G) {
                const int beg = lctl[32 + e] + lctl[96 + e], end = lctl[32 + e] + (((lctl[96 + e] + 255) >> 8) << 8);
                for (int s = beg + tid; s < end; s += NTHR) { ROWTOK[s] = 0; ROWW[s] = 0.f; }
            }
            for (int grp = bx; grp < nmoe / 32; grp += G) {
                if (tid < 128) {
                    const int tok = grp * 32 + (tid >> 2), k = tid & 3; const int ev = ASGE[(size_t)tok * 4 + k], e = ev & 255, rank = ev >> 8;
                    const int slot = lctl[32 + e] + lctl[64 + e] + rank;
                    ROWTOK[slot] = tok; ROWW[slot] = ASGW[(size_t)tok * 4 + k]; SLOTOF[(size_t)tok * 4 + k] = slot;
                }
            }
        }
        SEAM(pb + 5);
        if (IN(pb + 6)) {
            PH_IDS(); DEF_WS(); const float* b_gu = A->in[23];
            pg8::Gemm g{H, (const bf16*)((const unsigned char*)Wgu + (size_t)l * NEXP * 2048 * DM), 0, 2048, DM / 2, 0}; GroupedOrder S; S.init(lds, 8, 2048, G, bx, ROWTOK);
            EpiSwiglu E{ctll, b_gu + (size_t)l * NEXP * 2048, (unsigned char*)ACT, lds};
            pg8::gemm_phase<EpiSwiglu, GroupedOrder, true, true, true, true>(lds, g, S, E);
        }
        SEAM(pb + 6);
        if (IN(pb + 7)) {
            PH_IDS(); DEF_WS(); const float* b_dn = A->in[25];
            pg8::Gemm g{ACT, (const bf16*)((const unsigned char*)Wdn + (size_t)l * NEXP * DM * DM), 0, DM, DM / 2, 0}; GroupedOrder S; S.init(lds, 4, 1024, G, bx);
            EpiDown E{ctll, b_dn + (size_t)l * NEXP * DM, ROWW, (unsigned char*)Y, lds};
            pg8::gemm_phase<EpiDown, GroupedOrder, true, true, true>(lds, g, S, E);
        }
        SEAM(pb + 7);
        if (IN(pb + 8)) {
            PH_IDS(); DEF_WS();
            const float* g1n = A->in[6] + (has_next ? (l + 1) * DM : 0); const float* modn = mod + (size_t)(has_next ? l + 1 : l) * 17 * NMOD * DM;
            i32x4 sl4n[4];
            if (gw * 4 < nmoe) {
#pragma unroll
                for (int r = 0; r < 4; ++r) sl4n[r] = *(const i32x4*)(SLOTOF + (size_t)(gw * 4 + r) * 4);
            }
            for (int row0 = gw * 4; row0 < nmoe; row0 += NGW * 4) {
                const int b = row0 < TL ? (row0 >> 12) : 16;
                const float* gp = modl + (size_t)b * (NMOD * DM) + 5 * DM;
                const int col = lane * 8;
                i32x4 sl4[4];
#pragma unroll
                for (int r = 0; r < 4; ++r) sl4[r] = sl4n[r];
                if (row0 + NGW * 4 < nmoe) {
#pragma unroll
                    for (int r = 0; r < 4; ++r) sl4n[r] = *(const i32x4*)(SLOTOF + (size_t)(row0 + NGW * 4 + r) * 4);
                }
                u32x4 xb[4][2];
#pragma unroll
                for (int r = 0; r < 4; ++r) { xb[r][0] = *(const u32x4*)(X1 + (size_t)(row0 + r) * DM + col); xb[r][1] = *(const u32x4*)(X1 + (size_t)(row0 + r) * DM + 512 + col); }
                f32x4 gt[4], gm[4], sv[4];
#pragma unroll
                for (int q = 0; q < 4; ++q) gt[q] = *(const f32x4*)(gp + (q >> 1) * 512 + col + 4 * (q & 1)) * Y8_INV;
                if (has_next) { const float* sh = modn + (size_t)b * (NMOD * DM); const float* sc = sh + DM;
#pragma unroll
                    for (int q = 0; q < 4; ++q) { const int cq = (q >> 1) * 512 + col + 4 * (q & 1); gm[q] = *(const f32x4*)(g1n + cq) * (*(const f32x4*)(sc + cq) + 1.0f); sv[q] = *(const f32x4*)(sh + cq); } }
                u32x2 yv[4][4][2];
#pragma unroll
                for (int r = 0; r < 4; ++r)
#pragma unroll
                    for (int k = 0; k < 4; ++k) { yv[r][k][0] = *(const u32x2*)((const unsigned char*)Y + (size_t)sl4[r][k] * DM + col); yv[r][k][1] = *(const u32x2*)((const unsigned char*)Y + (size_t)sl4[r][k] * DM + 512 + col); }
#pragma unroll
                for (int r = 0; r < 4; ++r) {
                    const int row = row0 + r;
                    float* op = row < TL ? out + (size_t)row * DM : X2C + (size_t)(row - TL) * DM;
                    f32x4 a[4];
#pragma unroll
                    for (int q = 0; q < 4; ++q) a[q] = (f32x4){0.f, 0.f, 0.f, 0.f};
#pragma unroll
                    for (int k = 0; k < 4; ++k)
#pragma unroll
                        for (int q = 0; q < 4; ++q) { const unsigned y = yv[r][k][q >> 1][q & 1]; const auto lo = __builtin_amdgcn_cvt_pk_f32_fp8((int)y, false), hi = __builtin_amdgcn_cvt_pk_f32_fp8((int)y, true); a[q] += (f32x4){lo[0], lo[1], hi[0], hi[1]}; }
                    f32x4 xo[4]; float ss = 0.f;
#pragma unroll
                    for (int q = 0; q < 4; ++q) {
                        xo[q] = (f32x4){bflo(xb[r][q >> 1][(q & 1) * 2]), bfhi(xb[r][q >> 1][(q & 1) * 2]), bflo(xb[r][q >> 1][(q & 1) * 2 + 1]), bfhi(xb[r][q >> 1][(q & 1) * 2 + 1])} + gt[q] * a[q];
                        if (!has_next) *(f32x4*)(op + (q >> 1) * 512 + col + 4 * (q & 1)) = xo[q];
                    }
                    if (has_next) { *(u32x4*)((bf16*)ACT + (size_t)row * DM + col) = pack8(xo[0], xo[1]); *(u32x4*)((bf16*)ACT + (size_t)row * DM + 512 + col) = pack8(xo[2], xo[3]); }
                    if (has_next) {
#pragma unroll
                        for (int q = 0; q < 4; ++q) ss += (xo[q].x * xo[q].x + xo[q].y * xo[q].y) + (xo[q].z * xo[q].z + xo[q].w * xo[q].w);
                        const float rstd = __builtin_amdgcn_rsqf(wave_sum(ss) * (1.0f / DM) + EPS);
                        f32x4 y[4];
#pragma unroll
                        for (int q = 0; q < 4; ++q) y[q] = (xo[q] * rstd) * gm[q] + sv[q];
                        *(u32x4*)(H + (size_t)row * DM + col) = pack8(y[0], y[1]); *(u32x4*)(H + (size_t)row * DM + 512 + col) = pack8(y[2], y[3]);
                    }
                }
            }
        }
        SEAM(pb + 8);
    }
#undef IN
#undef SEAM
}

#ifndef MK_SPLIT
#define MK_SPLIT 0
#endif
extern "C" void kernel_launch(void* const* d_in, const int* in_sizes, int n_in, void* d_out, int out_size, void* d_ws, size_t ws_size, hipStream_t stream) {
    static int grid = 0;
    if (grid == 0) {
        if (n_in != 26 || ws_size < WS_END) { fprintf(stderr, "kernel_launch: need 26 inputs and %zu bytes of workspace (got %d, %zu)\n", (size_t)WS_END, n_in, ws_size); grid = -1; return; }
        int dev = 0, cus = 0, per_cu = 0;
        if (hipGetDevice(&dev) != hipSuccess || hipDeviceGetAttribute(&cus, hipDeviceAttributeMultiprocessorCount, dev) != hipSuccess) { grid = -1; return; }
        if (hipFuncSetAttribute((const void*)mk_fwd, hipFuncAttributeMaxDynamicSharedMemorySize, LDS_BYTES) != hipSuccess) { fprintf(stderr, "kernel_launch: hipFuncSetAttribute failed\n"); grid = -1; return; }
        if (hipOccupancyMaxActiveBlocksPerMultiprocessor(&per_cu, (const void*)mk_fwd, NTHR, LDS_BYTES) != hipSuccess || per_cu < 1) { fprintf(stderr, "kernel_launch: occupancy query says %d\n", per_cu); }
        (void)hipGetLastError();
        grid = cus;
    }
    if (grid < 0) return;
#if MK_SPLIT
    (void)hipMemsetAsync((char*)d_ws + WS_CTL, 0, 1 * MiB, stream);
#else
    (void)hipMemsetAsync((char*)d_ws + WS_CTL + (size_t)CTL_BAR * 4, 0, 16384, stream);
#endif
    Args a; memset(&a, 0, sizeof(a));
    for (int i = 0; i < 26; ++i) a.in[i] = (const float*)d_in[i];
    a.out = (float*)d_out; a.ws = (unsigned char*)d_ws;
#if MK_SPLIT
    for (int p = 0; p < NPHASE; ++p) { a.ph_lo = p; a.ph_hi = p + 1; a.bar_region = p; hipLaunchKernelGGL(mk_fwd, dim3(grid), dim3(NTHR), LDS_BYTES, stream, a); }
#else
    a.ph_lo = 0; a.ph_hi = NPHASE; a.bar_region = 0;
    hipLaunchKernelGGL(mk_fwd, dim3(grid), dim3(NTHR), LDS_BYTES, stream, a);
#endif
}
```

```cpp
#include <hip/hip_runtime.h>
#include <cstdio>
#include <cstdint>
#include <cstring>
namespace pg8 {
#define PG8_LAS __attribute__((address_space(3)))
typedef unsigned short bf16_t;
typedef short bf16x8 __attribute__((ext_vector_type(8)));
typedef float f32x4 __attribute__((ext_vector_type(4)));
typedef unsigned u32x4 __attribute__((ext_vector_type(4)));
typedef int pg8_v4i __attribute__((ext_vector_type(4)));
typedef int pg8_v8i __attribute__((ext_vector_type(8)));
constexpr int BM = 256, BK = 64, HALF = 128, HTB = HALF * BK * 2  , STAGE_BYTES = 8 * HTB, NXCD = 8, WGM = 8;

__host__ __device__ __forceinline__ int lds_byte(int r, int c) { const int st = (r >> 4) * 2 + (c >> 5), rr = r & 15, cc = c & 31, ob = rr * 64 + cc * 2; return st * 1024 + (ob ^ (((ob >> 9) & 1) << 5)); }
__host__ __device__ __forceinline__ void stage_rc(int b, int& R, int& C) { const int st = b / 1024, sb = b % 1024, swz = sb ^ (((sb >> 9) & 1) << 5); R = (st >> 1) * 16 + swz / 64; C = (st & 1) * 32 + (swz % 64) / 2; }
__host__ __device__ __forceinline__ int perm32(int rho) { const int n = rho >> 4, i = rho & 15; return 8 * (i >> 2) + 4 * n + (i & 3); }

struct Unit { int pm, pn; };
struct Gemm { const bf16_t* A; const bf16_t* Bt; int M, N, K, pad; };

struct StaticOrder {
    int nM, nN, nwg, G, c;
    __host__ __device__ void init(int M, int N, int G_, int c_) { nM = M / BM; nN = N / BM; nwg = nM * nN; G = G_; c = c_; }
    __host__ __device__ bool next(int i, Unit& u) const {
        const long L = (long)i * G + c; if (L >= nwg) return false;
        int wgid = (int)L; { const int q = nwg / NXCD, r = nwg % NXCD, xcd = wgid % NXCD, off = wgid / NXCD; wgid = (xcd < r ? xcd * (q + 1) : r * (q + 1) + (xcd - r) * q) + off; }
        const int nig = WGM * nN, gid = wgid / nig, fm = gid * WGM, gsz = (nM - fm) < WGM ? (nM - fm) : WGM;
        u.pm = fm + ((wgid % nig) % gsz); u.pn = (wgid % nig) / gsz; return true;
    }
    __device__ __forceinline__ int brow(const Unit& u) const { return u.pn * BM; }
    static constexpr const int* rowtok = nullptr;
    __device__ __forceinline__ void a_ready(const Unit&) const {}
    __device__ __forceinline__ void done(const Unit&) const {}
};

__device__ __forceinline__ unsigned cvt_pk_bf16(float lo, float hi) { unsigned r; asm volatile("v_cvt_pk_bf16_f32 %0, %1, %2" : "=v"(r) : "v"(lo), "v"(hi)); return r; }
typedef float f32x2 __attribute__((ext_vector_type(2)));
template <class Epi, class Sched, bool ALIGN_EPI = false, bool SP2 = false, bool FP8 = false, bool GATHER = false>
__device__ __forceinline__ void gemm_phase(PG8_LAS unsigned char* lds, const Gemm g, const Sched& S, const Epi& E) {
    int tid_l = threadIdx.x; asm volatile("" : "+v"(tid_l));
    const int tid = tid_l, wid = __builtin_amdgcn_readfirstlane(tid >> 6), lane = tid & 63, wr = wid >> 2, wc = wid & 3, fr = lane & 15, fq = lane >> 4;
    const int K = g.K, nt = K / BK;
    unsigned voffA[2], voffB[2]; int gR[2]; unsigned gC[2];
#pragma unroll
    for (int i = 0; i < 2; ++i) { int R, C; stage_rc(tid * 16 + i * 8192, R, C); const int Rb = Epi::PERM ? ((R & ~31) + perm32(R & 31)) : R;
        voffA[i] = (unsigned)(R * K + C) * 2u; voffB[i] = (unsigned)(Rb * K + C) * 2u; gR[i] = R; gC[i] = (unsigned)C * 2u; }
    static_assert(!GATHER || SP2, "GATHER is written for the SP2 loop");
    unsigned gcur[2][2] = {{0u, 0u}, {0u, 0u}}, gnxt[2][2] = {{0u, 0u}, {0u, 0u}}, graw[2][2] = {{0u, 0u}, {0u, 0u}};
#define PG8_GLOAD(gv, u) do { _Pragma("unroll") for (int h_ = 0; h_ < 2; ++h_) _Pragma("unroll") for (int i_ = 0; i_ < 2; ++i_) gv[h_][i_] = (unsigned)S.rowtok[(u).pm * BM + h_ * HALF + gR[i_]] * (unsigned)(K * 2) + gC[i_]; } while (0)
    const size_t kstep = (size_t)(BK * 2);
    const size_t hstep = (size_t)HALF * K * 2;
    const size_t tstep = 2 * hstep;
    const unsigned ldsw = (unsigned)wid * 1024u;
    const int aoff = lds_byte(wr * 64 + fr, fq * 8), boff = lds_byte(wc * 32 + fr, fq * 8);
#define PG8_CAT8(x, y) __builtin_shufflevector(__builtin_bit_cast(pg8_v4i, (x)), __builtin_bit_cast(pg8_v4i, (y)), 0, 1, 2, 3, 4, 5, 6, 7)
#define PG8_SA(b, h) (((b) * 2 + (h)) * HTB)
#define PG8_SB(b, h) ((4 + (b) * 2 + (h)) * HTB)
#define PG8_STAGE(bufoff, gbase, voff) do { _Pragma("unroll") for (int _i = 0; _i < 2; ++_i) \
        __builtin_amdgcn_global_load_lds((const unsigned*)((const char*)(gbase) + (voff)[_i]), (PG8_LAS unsigned*)(lds + (bufoff) + ldsw + _i * 8192), 16, 0, 0); } while (0)
#define PG8_STAGE_A(bufoff, kbase, h, gv) do { if constexpr (GATHER) { PG8_STAGE(bufoff, kbase, (gv)[h]); } else { PG8_STAGE(bufoff, (kbase) + (h) * hstep, voffA); } } while (0)
#define PG8_LDA(dst, b, h) do { _Pragma("unroll") for (int m = 0; m < 4; ++m) { if constexpr (FP8) dst##8[m] = PG8_CAT8(*(const PG8_LAS bf16x8*)(lds + PG8_SA(b, h) + aoff + m * 2048), *(const PG8_LAS bf16x8*)(lds + PG8_SA(b, h) + aoff + m * 2048 + 1024)); \
        else { _Pragma("unroll") for (int k = 0; k < 2; ++k) dst[m][k] = *(const PG8_LAS bf16x8*)(lds + PG8_SA(b, h) + aoff + m * 2048 + k * 1024); } } } while (0)
#define PG8_LDB(dst, b, h) do { _Pragma("unroll") for (int n = 0; n < 2; ++n) { if constexpr (FP8) dst##8[n] = PG8_CAT8(*(const PG8_LAS bf16x8*)(lds + PG8_SB(b, h) + boff + n * 2048), *(const PG8_LAS bf16x8*)(lds + PG8_SB(b, h) + boff + n * 2048 + 1024)); \
        else { _Pragma("unroll") for (int k = 0; k < 2; ++k) dst[n][k] = *(const PG8_LAS bf16x8*)(lds + PG8_SB(b, h) + boff + n * 2048 + k * 1024); } } } while (0)
#define PG8_MMA(ai, bj, At, Bt) do { __builtin_amdgcn_s_setprio(1); _Pragma("unroll") for (int m = 0; m < 4; ++m) _Pragma("unroll") for (int n = 0; n < 2; ++n) { \
        if constexpr (FP8) asm volatile("v_mfma_f32_16x16x128_f8f6f4 %0, %1, %2, %0" : "+v"(acc[ai][bj][m][n]) : "v"(Bt##8[n]), "v"(At##8[m]));     \
        else { _Pragma("unroll") for (int k = 0; k < 2; ++k) acc[ai][bj][m][n] = __builtin_amdgcn_mfma_f32_16x16x32_bf16(Bt[n][k], At[m][k], acc[ai][bj][m][n], 0, 0, 0); } } __builtin_amdgcn_s_setprio(0); } while (0)
#define PG8_WAIT_V(n) asm volatile("s_waitcnt vmcnt(" #n ")" ::: "memory")
#define PG8_WAIT_L(n) asm volatile("s_waitcnt lgkmcnt(" #n ")" ::: "memory")
#define PG8_BAR __builtin_amdgcn_s_barrier()
#define PG8_SCHED __builtin_amdgcn_sched_barrier(0)
    Unit cur, nxt; int ui = 0;
    if (!S.next(0, cur)) return;
    f32x4 acc[2][2][4][2];
#pragma unroll
    for (int a = 0; a < 2; ++a)
#pragma unroll
        for (int b = 0; b < 2; ++b)
#pragma unroll
            for (int m = 0; m < 4; ++m)
#pragma unroll
                for (int n = 0; n < 2; ++n) acc[a][b][m][n] = (f32x4){0.f, 0.f, 0.f, 0.f};
    bf16x8 At[4][2], B0[2][2], B1[2][2]; pg8_v8i At8[4], B08[2], B18[2];
    const char* cA = (const char*)g.A + (GATHER ? (size_t)0 : (size_t)cur.pm * tstep); if constexpr (GATHER) PG8_GLOAD(gcur, cur);
    const char* cB = (const char*)g.Bt + (size_t)S.brow(cur) * (size_t)K * 2;
    S.a_ready(cur);
    if constexpr (SP2) {
        PG8_STAGE(PG8_SB(0, 0), cB, voffB); PG8_STAGE(PG8_SB(0, 1), cB + hstep, voffB); PG8_STAGE_A(PG8_SA(0, 0), cA, 0, gcur); PG8_STAGE_A(PG8_SA(0, 1), cA, 1, gcur);
        if (wr == 1) PG8_BAR;
        PG8_WAIT_V(2); PG8_BAR;
        PG8_STAGE(PG8_SB(1, 0), cB + kstep, voffB); PG8_STAGE_A(PG8_SA(1, 0), cA + kstep, 0, gcur); PG8_STAGE(PG8_SB(1, 1), cB + hstep + kstep, voffB);
        PG8_WAIT_V(6); PG8_BAR;
    } else {
        PG8_STAGE(PG8_SB(0, 0), cB, voffB); PG8_STAGE(PG8_SA(0, 0), cA, voffA); PG8_STAGE(PG8_SB(0, 1), cB + hstep, voffB); PG8_STAGE(PG8_SA(0, 1), cA + hstep, voffA);
        if (wr == 1) PG8_BAR;
        PG8_WAIT_V(4); PG8_BAR;
        PG8_STAGE(PG8_SB(1, 0), cB + kstep, voffB); PG8_STAGE(PG8_SA(1, 0), cA + kstep, voffA); PG8_STAGE(PG8_SB(1, 1), cB + hstep + kstep, voffB);
        PG8_WAIT_V(6); PG8_BAR;
    }
    for (;;) {
        const bool has_next = S.next(ui + 1, nxt);
        const char* nA = (has_next && !GATHER) ? (const char*)g.A + (size_t)nxt.pm * tstep : cA; const char* nB = has_next ? (const char*)g.Bt + (size_t)S.brow(nxt) * (size_t)K * 2 : cB;
#pragma nounroll
        for (int t = 0; t < nt; t += 2) {
            const bool last = (t == nt - 2);
            const char* a1 = cA + (size_t)(t + 1) * kstep;
            const char* a2 = last ? nA : cA + (size_t)(t + 2) * kstep; const char* b2 = last ? nB : cB + (size_t)(t + 2) * kstep;
            const char* a3 = a2 + kstep; const char* b3 = b2 + kstep;
            if (last && has_next) S.a_ready(nxt);
            if (last) E.pre(cur, wid, lane);
            if constexpr (GATHER) { if (t == nt - 4 && has_next) { _Pragma("unroll") for (int h_ = 0; h_ < 2; ++h_) _Pragma("unroll") for (int i_ = 0; i_ < 2; ++i_)
                asm volatile("global_load_dword %0, %1, off" : "+v"(graw[h_][i_]) : "v"(S.rowtok + (nxt.pm * BM + h_ * HALF + gR[i_])) : "memory"); } }
            unsigned gsel[2][2];
            if constexpr (GATHER) { _Pragma("unroll") for (int h_ = 0; h_ < 2; ++h_) _Pragma("unroll") for (int i_ = 0; i_ < 2; ++i_) { if (last && has_next) gnxt[h_][i_] = graw[h_][i_] * (unsigned)(K * 2) + gC[i_]; gsel[h_][i_] = (last && has_next) ? gnxt[h_][i_] : gcur[h_][i_]; } }
            if constexpr (SP2) {
            PG8_LDB(B0, 0, 0); PG8_LDB(B1, 0, 1); PG8_SCHED; PG8_LDA(At, 0, 0); PG8_STAGE_A(PG8_SA(1, 1), a1, 1, gcur);
            PG8_WAIT_V(8); PG8_WAIT_L(0); PG8_BAR; PG8_MMA(0, 0, At, B0); PG8_MMA(0, 1, At, B1); PG8_BAR; PG8_SCHED;
            PG8_LDA(At, 0, 1); PG8_STAGE(PG8_SB(0, 0), b2, voffB); PG8_STAGE(PG8_SB(0, 1), b2 + hstep, voffB); PG8_STAGE_A(PG8_SA(0, 0), a2, 0, gsel);
            PG8_WAIT_V(8); PG8_WAIT_L(0); PG8_BAR; PG8_MMA(1, 0, At, B0); PG8_MMA(1, 1, At, B1); PG8_BAR; PG8_SCHED;
            PG8_LDB(B0, 1, 0); PG8_LDB(B1, 1, 1); PG8_SCHED; PG8_LDA(At, 1, 0); PG8_STAGE_A(PG8_SA(0, 1), a2, 1, gsel);
            PG8_WAIT_V(8); PG8_WAIT_L(0); PG8_BAR; PG8_MMA(0, 0, At, B0); PG8_MMA(0, 1, At, B1); PG8_BAR; PG8_SCHED;
            PG8_LDA(At, 1, 1); PG8_STAGE(PG8_SB(1, 0), b3, voffB); PG8_STAGE(PG8_SB(1, 1), b3 + hstep, voffB); PG8_STAGE_A(PG8_SA(1, 0), a3, 0, gsel);
            PG8_WAIT_V(8); PG8_WAIT_L(0); PG8_BAR; PG8_MMA(1, 0, At, B0); PG8_MMA(1, 1, At, B1); PG8_BAR; PG8_SCHED;
            } else {
            PG8_LDB(B0, 0, 0); PG8_SCHED; PG8_LDA(At, 0, 0); PG8_STAGE(PG8_SA(1, 1), a1 + hstep, voffA);
            PG8_WAIT_L(8); PG8_BAR; PG8_WAIT_L(0); PG8_MMA(0, 0, At, B0); PG8_BAR; PG8_SCHED;
            PG8_LDB(B1, 0, 1); PG8_STAGE(PG8_SB(0, 0), b2, voffB);
            PG8_BAR; PG8_WAIT_L(0); PG8_MMA(0, 1, At, B1); PG8_BAR;
            PG8_LDA(At, 0, 1); PG8_STAGE(PG8_SA(0, 0), a2, voffA);
            PG8_BAR; PG8_WAIT_L(0); PG8_MMA(1, 0, At, B0); PG8_BAR; PG8_SCHED;
            PG8_STAGE(PG8_SB(0, 1), b2 + hstep, voffB);
            PG8_WAIT_V(6); PG8_BAR; PG8_MMA(1, 1, At, B1); PG8_BAR;
            PG8_LDB(B0, 1, 0); PG8_SCHED; PG8_LDA(At, 1, 0); PG8_STAGE(PG8_SA(0, 1), a2 + hstep, voffA);
            PG8_WAIT_L(8); PG8_BAR; PG8_WAIT_L(0); PG8_MMA(0, 0, At, B0); PG8_BAR; PG8_SCHED;
            PG8_LDB(B1, 1, 1); PG8_STAGE(PG8_SB(1, 0), b3, voffB);
            PG8_BAR; PG8_WAIT_L(0); PG8_MMA(0, 1, At, B1); PG8_BAR;
            PG8_LDA(At, 1, 1); PG8_STAGE(PG8_SA(1, 0), a3, voffA);
            PG8_BAR; PG8_WAIT_L(0); PG8_MMA(1, 0, At, B0); PG8_BAR; PG8_SCHED;
            PG8_STAGE(PG8_SB(1, 1), b3 + hstep, voffB);
            PG8_WAIT_V(6); PG8_BAR; PG8_MMA(1, 1, At, B1); PG8_BAR;
            }
        }
        if constexpr (FP8) asm volatile("s_nop 15\n\ts_nop 15" ::: "memory");
        if constexpr (ALIGN_EPI) { if (wr == 0) PG8_BAR; }
        if constexpr (!Epi::AFTER_DRAIN) { E(acc, cur, wr, wc, fr, fq); S.done(cur); }
        if (!has_next) break;
#pragma unroll
        for (int a = 0; a < 2; ++a)
#pragma unroll
            for (int b = 0; b < 2; ++b)
#pragma unroll
                for (int m = 0; m < 4; ++m)
#pragma unroll
                    for (int n = 0; n < 2; ++n) acc[a][b][m][n] = (f32x4){0.f, 0.f, 0.f, 0.f};
        cur = nxt; cA = nA; cB = nB; ++ui;
        if constexpr (GATHER) { _Pragma("unroll") for (int h_ = 0; h_ < 2; ++h_) _Pragma("unroll") for (int i_ = 0; i_ < 2; ++i_) gcur[h_][i_] = gnxt[h_][i_]; }
        if constexpr (ALIGN_EPI) { if (wr == 1) PG8_BAR; }
    }
    PG8_WAIT_V(0);
    if constexpr (!ALIGN_EPI) { if (wr == 0) PG8_BAR; }
    PG8_BAR;
    if constexpr (Epi::AFTER_DRAIN) { E.fused(acc, cur, wr, wc, fr, fq, lds, wid, lane); S.done(cur); }
#undef PG8_SA
#undef PG8_SB
#undef PG8_STAGE
#undef PG8_STAGE_A
#undef PG8_GLOAD
#undef PG8_LDA
#undef PG8_LDB
#undef PG8_MMA
#undef PG8_CAT8
#undef PG8_WAIT_V
#undef PG8_WAIT_L
#undef PG8_BAR
#undef PG8_SCHED
}
}


constexpr int NB = 16, SEQ = 4096, DM = 1024, CTXL = 256, DEPTH = 2, INW = 2560, NEXP = 32, TOPK = 4;
constexpr int TL = NB * SEQ, TC = NB * CTXL, TT = TL + TC;
constexpr int NH = 8, NKEY = SEQ + CTXL;
constexpr int MAXBLK = 1120;
constexpr int NMOD = 6;
constexpr float EPS = 1e-6f;
constexpr float QSCALE = 0.17677669529663687f * 1.4426950408889634f;
constexpr float SMAX2 = 12.0f;

typedef unsigned short bf16;
typedef float f32x4 __attribute__((ext_vector_type(4)));
typedef unsigned u32x4 __attribute__((ext_vector_type(4)));
typedef unsigned u32x2 __attribute__((ext_vector_type(2)));

constexpr size_t MiB = 1u << 20;
constexpr size_t WS_CTL = 0, WS_MOD = 1 * MiB, WS_ROPE = 2 * MiB, WS_SCAL = 3 * MiB, WS_WIN = 4 * MiB, WS_WOUT = 14 * MiB, WS_WGU = 18 * MiB, WS_WDN = 274 * MiB;
constexpr size_t WS_H = 402 * MiB, WS_X1 = 538 * MiB, WS_X2C = 810 * MiB, WS_TOK = 826 * MiB, WS_RA = 858 * MiB, WS_RB = 1418 * MiB, WS_END = 1978 * MiB;
constexpr size_t TOK_AE = 0, TOK_AW = 2 * MiB, TOK_SLOTOF = 4 * MiB, TOK_ROWTOK = 6 * MiB, TOK_ROWW = 8 * MiB;
constexpr size_t RA_Q = 0, RA_QC = 64 * MiB, RA_K = 68 * MiB, RA_V = 136 * MiB, RA_CPU = 204 * MiB, RA_MIX = 306 * MiB;
constexpr int CTL_LSTRIDE = 4096, CTL_NBLK = 96, CTL_BLKE = 128;
constexpr int CTL_WGCNT = 8192, CTL_WGCNT_L = 8192;
constexpr int CTL_BAR = 32768, CTL_BAR_STRIDE = 4096;

constexpr int NWAVES = 8, NTHR = 512;
constexpr int LDS_SCR = 131072, LDS_CTL = 143360, LDS_BARW = LDS_CTL + 512, LDS_BYTES = 147456;
constexpr size_t WS_WRT = WS_SCAL + 65536;
constexpr int NPHASE = 1 + 9 * DEPTH;

typedef int i32x4 __attribute__((ext_vector_type(4)));
__device__ __forceinline__ unsigned f2bf(float f) { unsigned u = __builtin_bit_cast(unsigned, f); return (u + 0x7fffu + ((u >> 16) & 1u)) >> 16; }
__device__ __forceinline__ float bf2f(unsigned short b) { return __builtin_bit_cast(float, ((unsigned)b) << 16); }
__device__ __forceinline__ float bflo(unsigned w) { return __builtin_bit_cast(float, w << 16); }
__device__ __forceinline__ float bfhi(unsigned w) { return __builtin_bit_cast(float, w & 0xffff0000u); }
template <int CTRL> __device__ __forceinline__ float dpp_mov(float v) { return __builtin_bit_cast(float, __builtin_amdgcn_update_dpp(0, __builtin_bit_cast(int, v), CTRL, 0xf, 0xf, true)); }
__device__ __forceinline__ float rlane(float v, int l) { return __builtin_bit_cast(float, __builtin_amdgcn_readlane(__builtin_bit_cast(int, v), l)); }
__device__ __forceinline__ float wave_sum(float v) {
    v += dpp_mov<0xB1>(v); v += dpp_mov<0x4E>(v); v += dpp_mov<0x141>(v); v += dpp_mov<0x140>(v);
    return (rlane(v, 0) + rlane(v, 16)) + (rlane(v, 32) + rlane(v, 48));
}
typedef float f32x2v __attribute__((ext_vector_type(2)));
template <int CTRL> __device__ __forceinline__ int dpp_movi(int v) { return __builtin_amdgcn_update_dpp(0, v, CTRL, 0xf, 0xf, true); }
template <int CTRL> __device__ __forceinline__ float dpp_movf(float v) { return __builtin_bit_cast(float, __builtin_amdgcn_update_dpp(0, __builtin_bit_cast(int, v), CTRL, 0xf, 0xf, true)); }
__device__ __forceinline__ unsigned pk4_fp8(float a, float b, float c, float d) { int w = __builtin_amdgcn_cvt_pk_fp8_f32(a, b, 0, false); w = __builtin_amdgcn_cvt_pk_fp8_f32(c, d, w, true); return (unsigned)w; }
constexpr float Y8_SCALE = 8.0f, Y8_INV = 1.0f / 8.0f;
constexpr float W8_SCALE = 32.0f, W8_INV = 1.0f / 32.0f;
__device__ __forceinline__ u32x4 pack8(const f32x4 a, const f32x4 b) { u32x4 w; w.x = pg8::cvt_pk_bf16(a[0], a[1]); w.y = pg8::cvt_pk_bf16(a[2], a[3]); w.z = pg8::cvt_pk_bf16(b[0], b[1]); w.w = pg8::cvt_pk_bf16(b[2], b[3]); return w; }

__device__ __forceinline__ void lds_dma16(const void* gsrc, unsigned lds_dst) { unsigned keep;
    asm volatile("s_mov_b32 %0, m0\n\ts_mov_b32 m0, %2\n\ts_nop 0\n\tglobal_load_lds_dwordx4 %1, off\n\ts_mov_b32 m0, %0" : "=&s"(keep) : "v"(gsrc), "s"(lds_dst) : "memory"); }
constexpr int LDS_NBLK = LDS_CTL + 640, LDS_BTE = LDS_CTL + 1280;
constexpr int LDS_EPI = 131072;
struct PlainOrder : pg8::StaticOrder { };
struct InprojOrder {
    pg8::StaticOrder lat; int ncolc, G, c; static constexpr const int* rowtok = nullptr;
    __device__ __forceinline__ void init(int ncolc_, int G_, int c_) { lat.init(TL, INW, G_, c_); ncolc = ncolc_; G = G_; c = c_; }
    __device__ __forceinline__ bool next(int i, pg8::Unit& u) const {
        const int L = i * G + c;
        if (L < lat.nwg) return lat.next(i, u);
        const int idx = L - lat.nwg; if (idx >= 16 * ncolc) return false;
        u.pm = 256 + idx / ncolc; u.pn = (ncolc == 10) ? idx % 10 : 2 + idx % 4; return true;
    }
    __device__ __forceinline__ int brow(const pg8::Unit& u) const { return u.pn * 256; }
    __device__ __forceinline__ void a_ready(const pg8::Unit&) const {}
    __device__ __forceinline__ void done(const pg8::Unit&) const {}
};
struct GroupedOrder {
    const PG8_LAS unsigned char* bte; const int* rowtok; int nN, Nper, G, c, nblk;
    __device__ __forceinline__ void init(const PG8_LAS unsigned char* lds_, int nN_, int Nper_, int G_, int c_, const int* rowtok_ = nullptr) { bte = lds_ + LDS_BTE; rowtok = rowtok_; nN = nN_; Nper = Nper_; G = G_; c = c_; nblk = *(const PG8_LAS int*)(lds_ + LDS_NBLK); }
    __device__ __forceinline__ bool next(int i, pg8::Unit& u) const {
        const int xcd = c & 7, j = c >> 3, per = G / nN;
        u.pm = i * per + (j / nN) * 8 + xcd; u.pn = (j % nN) | ((int)bte[u.pm] << 8); return u.pm < nblk;
    }
    __device__ __forceinline__ int brow(const pg8::Unit& u) const { return (u.pn >> 8) * Nper + (u.pn & 255) * 256; }
    __device__ __forceinline__ void a_ready(const pg8::Unit&) const {}
    __device__ __forceinline__ void done(const pg8::Unit&) const {}
};

struct EpiInproj {
    static constexpr bool PERM = true, AFTER_DRAIN = false;
    __device__ __forceinline__ void pre(const pg8::Unit&, int, int) const {}
    bf16 *Q, *Qc, *K, *V, *CPU; const PG8_LAS float* tab;
    __device__ __forceinline__ void operator()(const f32x4 (&acc)[2][2][4][2], const pg8::Unit& u, int wr, int wc, int fr_in, int fq_in) const {
        int fr = fr_in, fq = fq_in; asm volatile("" : "+v"(fr), "+v"(fq));
        const int pn = u.pn; const bool lat = u.pm < 256; const int b = lat ? (u.pm >> 4) : (u.pm - 256);
        const int pbase = (lat ? (u.pm & 15) * 256 : 0) + wr * 64 + fr;
        const int rbase = u.pm * 256 + wr * 64 + fr;
        if (pn < 4) {
            const bool isq = pn < 2; const PG8_LAS float* g = tab + 1024 + (isq ? 0 : 32);
            const f32x4 g0 = *(const PG8_LAS f32x4*)(g + 8 * fq), g1 = *(const PG8_LAS f32x4*)(g + 8 * fq + 4);
            const float sgn = (fq & 1) ? 1.0f : -1.0f;
#pragma unroll
            for (int bj = 0; bj < 2; ++bj) {
                const int grp = bj * 4 + wc, head = (pn & 1) * 4 + (grp >> 1), comp = grp & 1, bh = b * NH + head;
#pragma unroll
                for (int ai = 0; ai < 2; ++ai)
#pragma unroll
                    for (int m = 0; m < 4; ++m) {
                        const int pos = pbase + ai * 128 + m * 16;
                        f32x4 v0 = acc[ai][bj][m][0], v1 = acc[ai][bj][m][1];
                        float ss = (v0[0] * v0[0] + v0[1] * v0[1]) + (v0[2] * v0[2] + v0[3] * v0[3]) + (v1[0] * v1[0] + v1[1] * v1[1]) + (v1[2] * v1[2] + v1[3] * v1[3]);
                        ss += __shfl_xor(ss, 16); ss += __shfl_xor(ss, 32);
                        const float r = __builtin_amdgcn_rsqf(ss * (1.0f / 32.0f) + EPS);
                        v0 = v0 * r * g0; v1 = v1 * r * g1;
                        if (lat) {
                            const int p = (fq >> 1) == 0 ? (pos >> 6) : (pos & 63);
                            const f32x4 c0 = *(const PG8_LAS f32x4*)(tab + p * 8), c1 = *(const PG8_LAS f32x4*)(tab + p * 8 + 4), s0 = *(const PG8_LAS f32x4*)(tab + 512 + p * 8), s1 = *(const PG8_LAS f32x4*)(tab + 512 + p * 8 + 4);
                            f32x4 o0, o1;
#pragma unroll
                            for (int j = 0; j < 4; ++j) { o0[j] = __shfl_xor(v0[j], 16); o1[j] = __shfl_xor(v1[j], 16); }
                            v0 = v0 * c0 + (o0 * s0) * sgn; v1 = v1 * c1 + (o1 * s1) * sgn;
                        }
                        if (isq) { v0 = v0 * QSCALE; v1 = v1 * QSCALE; }
                        bf16* dst;
                        if (isq) dst = lat ? Q + ((size_t)bh * SEQ + pos) * 64 : Qc + ((size_t)bh * CTXL + pos) * 64;
                        else dst = K + ((size_t)bh * NKEY + (lat ? CTXL + pos : pos)) * 64;
                        *(u32x4*)(dst + comp * 32 + 8 * fq) = pack8(v0, v1);
                    }
            }
        } else if (pn < 6) {
#pragma unroll
            for (int bj = 0; bj < 2; ++bj) {
                const int grp = bj * 4 + wc, head = (pn - 4) * 4 + (grp >> 1), bh = b * NH + head;
#pragma unroll
                for (int ai = 0; ai < 2; ++ai)
#pragma unroll
                    for (int m = 0; m < 4; ++m) {
                        const int pos = pbase + ai * 128 + m * 16;
                        bf16* dst = V + ((size_t)bh * NKEY + (lat ? CTXL + pos : pos)) * 64 + (grp & 1) * 32 + 8 * fq;
                        *(u32x4*)dst = pack8(acc[ai][bj][m][0], acc[ai][bj][m][1]);
                    }
            }
        } else if (pn == 7 || pn == 8) {
#pragma unroll
            for (int ai = 0; ai < 2; ++ai)
#pragma unroll
                for (int m = 0; m < 4; ++m) {
                    bf16* dst = CPU + (size_t)(rbase + ai * 128 + m * 16) * 768 + 256 + (pn - 7) * 128 + wc * 32 + 8 * fq;
                    *(u32x4*)dst = pack8(acc[ai][0][m][0] * acc[ai][1][m][0], acc[ai][0][m][1] * acc[ai][1][m][1]);
                }
        } else {
            const int cb = pn == 6 ? 0 : 512;
#pragma unroll
            for (int ai = 0; ai < 2; ++ai)
#pragma unroll
                for (int m = 0; m < 4; ++m)
#pragma unroll
                    for (int bj = 0; bj < 2; ++bj) {
                        bf16* dst = CPU + (size_t)(rbase + ai * 128 + m * 16) * 768 + cb + bj * 128 + wc * 32 + 8 * fq;
                        *(u32x4*)dst = pack8(acc[ai][bj][m][0], acc[ai][bj][m][1]);
                    }
        }
    }
};
struct EpiResid {
    static constexpr bool PERM = true, AFTER_DRAIN = false;
    const bf16* xb  ; const float* gate  ; bf16* out; PG8_LAS unsigned char* lds;
    __device__ __forceinline__ void pre(const pg8::Unit& u, int wid, int lane) const {
        if (wid == 0) lds_dma16(gate + (size_t)(u.pm < 256 ? (u.pm >> 4) : 16) * (NMOD * DM) + u.pn * 256 + lane * 4, (unsigned)(uintptr_t)(lds + LDS_EPI)); }
    __device__ __forceinline__ void operator()(const f32x4 (&acc)[2][2][4][2], const pg8::Unit& u, int wr, int wc, int fr_in, int fq_in) const {
        int fr = fr_in, fq = fq_in; asm volatile("" : "+v"(fr), "+v"(fq));
        const int row0 = u.pm * 256 + wr * 64 + fr, col0 = u.pn * 256 + wc * 32 + 8 * fq;
        const bool lat = u.pm < 256; const int b = lat ? (u.pm >> 4) : 16;
        const PG8_LAS float* gp = (const PG8_LAS float*)(lds + LDS_EPI) + wc * 32 + 8 * fq; (void)b;
        f32x4 gv[2][2];
#pragma unroll
        for (int bj = 0; bj < 2; ++bj)
#pragma unroll
            for (int n = 0; n < 2; ++n) gv[bj][n] = *(const PG8_LAS f32x4*)(gp + bj * 128 + n * 4);
#pragma unroll
        for (int ai = 0; ai < 2; ++ai)
#pragma unroll
            for (int m = 0; m < 4; ++m) {
                const int row = row0 + ai * 128 + m * 16;
                const bf16* bp = xb + (size_t)row * DM + col0;
#pragma unroll
                for (int bj = 0; bj < 2; ++bj) {
                    const u32x4 bb = *(const u32x4*)(bp + bj * 128);
                    const f32x4 b0 = (f32x4){bflo(bb.x), bfhi(bb.x), bflo(bb.y), bfhi(bb.y)}, b1 = (f32x4){bflo(bb.z), bfhi(bb.z), bflo(bb.w), bfhi(bb.w)};
                    *(u32x4*)(out + (size_t)row * DM + col0 + bj * 128) = pack8(b0 + gv[bj][0] * acc[ai][bj][m][0], b1 + gv[bj][1] * acc[ai][bj][m][1]);
                }
            }
    }
};
struct EpiSwiglu {
    static constexpr bool PERM = true, AFTER_DRAIN = false;
    const int* ctl; const float* bias  ; unsigned char* act  ; PG8_LAS unsigned char* lds;
    __device__ __forceinline__ void pre(const pg8::Unit& u, int wid, int lane) const {
        if (wid == 0) lds_dma16(bias + (size_t)(u.pn >> 8) * 2048 + (lane >> 5) * 1024 + (u.pn & 255) * 128 + (lane & 31) * 4, (unsigned)(uintptr_t)(lds + LDS_EPI)); }
    __device__ __forceinline__ void operator()(const f32x4 (&acc)[2][2][4][2], const pg8::Unit& u, int wr, int wc, int fr_in, int fq_in) const {
        int fr = fr_in, fq = fq_in; asm volatile("" : "+v"(fr), "+v"(fq));
        const int row0 = u.pm * 256 + wr * 64 + fr + (fq & 1) * 16, cl = (u.pn & 255) * 128 + wc * 32 + (fq >> 1) * 16;
        const PG8_LAS float* bl_ = (const PG8_LAS float*)(lds + LDS_EPI) + wc * 32 + 8 * fq;
        f32x4 bgl[2], bli[2];
#pragma unroll
        for (int n = 0; n < 2; ++n) { bgl[n] = *(const PG8_LAS f32x4*)(bl_ + 4 * n); bli[n] = *(const PG8_LAS f32x4*)(bl_ + 128 + 4 * n); }
#pragma unroll
        for (int ai = 0; ai < 2; ++ai)
#pragma unroll
            for (int mp = 0; mp < 2; ++mp) {
                u32x2 w8[2];
#pragma unroll
                for (int mm = 0; mm < 2; ++mm) {
                    const int m = 2 * mp + mm;
                    f32x4 r[2];
#pragma unroll
                    for (int n = 0; n < 2; ++n) {
                        f32x4 g = acc[ai][0][m][n] * W8_INV + bgl[n], li = acc[ai][1][m][n] * W8_INV + bli[n];
                        g = __builtin_elementwise_min(g, (f32x4){7.0f, 7.0f, 7.0f, 7.0f});
                        li = __builtin_elementwise_min(__builtin_elementwise_max(li, (f32x4){-7.0f, -7.0f, -7.0f, -7.0f}), (f32x4){7.0f, 7.0f, 7.0f, 7.0f});
                        const f32x4 t = g * (-1.702f * 1.4426950408889634f);
                        f32x4 d; d.x = __builtin_amdgcn_exp2f(t.x); d.y = __builtin_amdgcn_exp2f(t.y); d.z = __builtin_amdgcn_exp2f(t.z); d.w = __builtin_amdgcn_exp2f(t.w);
                        d = d + 1.0f;
                        f32x4 sg; sg.x = __builtin_amdgcn_rcpf(d.x); sg.y = __builtin_amdgcn_rcpf(d.y); sg.z = __builtin_amdgcn_rcpf(d.z); sg.w = __builtin_amdgcn_rcpf(d.w);
                        const f32x4 u2 = g * sg;
                        r[n] = u2 * li + u2;
                    }
                    w8[mm].x = pk4_fp8(r[0][0], r[0][1], r[0][2], r[0][3]); w8[mm].y = pk4_fp8(r[1][0], r[1][1], r[1][2], r[1][3]);
                }
                { auto rx = __builtin_amdgcn_permlane16_swap(w8[0].x, w8[1].x, false, false); auto ry = __builtin_amdgcn_permlane16_swap(w8[0].y, w8[1].y, false, false);
                  *(u32x4*)(act + (size_t)(row0 + ai * 128 + mp * 32) * 1024 + cl) = (u32x4){rx[0], ry[0], rx[1], ry[1]}; }
            }
    }
};
struct EpiDown {
    static constexpr bool PERM = true, AFTER_DRAIN = false;
    const int* ctl; const float* bias  ; const float* row_w; unsigned char* Y  ; PG8_LAS unsigned char* lds;
    __device__ __forceinline__ void pre(const pg8::Unit& u, int wid, int lane) const {
        if (wid == 0) lds_dma16(bias + (size_t)(u.pn >> 8) * 1024 + (u.pn & 255) * 256 + lane * 4, (unsigned)(uintptr_t)(lds + LDS_EPI));
        if (wid == 1) lds_dma16(row_w + (size_t)u.pm * 256 + lane * 4, (unsigned)(uintptr_t)(lds + LDS_EPI + 1024)); }
    __device__ __forceinline__ void operator()(const f32x4 (&acc)[2][2][4][2], const pg8::Unit& u, int wr, int wc, int fr_in, int fq_in) const {
        int fr = fr_in, fq = fq_in; asm volatile("" : "+v"(fr), "+v"(fq));
        const int row0 = u.pm * 256 + wr * 64 + fr + (fq & 1) * 16, col0 = (u.pn & 255) * 256 + wc * 32 + (fq >> 1) * 16;
        const PG8_LAS float* bl_ = (const PG8_LAS float*)(lds + LDS_EPI) + wc * 32 + 8 * fq; const PG8_LAS float* wl_ = (const PG8_LAS float*)(lds + LDS_EPI + 1024) + wr * 64 + fr;
        f32x4 bv[2][2];
#pragma unroll
        for (int bj = 0; bj < 2; ++bj)
#pragma unroll
            for (int n = 0; n < 2; ++n) bv[bj][n] = *(const PG8_LAS f32x4*)(bl_ + bj * 128 + 4 * n);
#pragma unroll
        for (int ai = 0; ai < 2; ++ai)
#pragma unroll
            for (int mp = 0; mp < 2; ++mp) {
                const float w0 = wl_[ai * 128 + mp * 32] * Y8_SCALE, w1 = wl_[ai * 128 + mp * 32 + 16] * Y8_SCALE;
#pragma unroll
                for (int bj = 0; bj < 2; ++bj) {
                    u32x2 o[2];
#pragma unroll
                    for (int mm = 0; mm < 2; ++mm) { const int m = 2 * mp + mm; const float w = mm ? w1 : w0;
                        const f32x4 y0 = (acc[ai][bj][m][0] * W8_INV + bv[bj][0]) * w, y1 = (acc[ai][bj][m][1] * W8_INV + bv[bj][1]) * w;
                        o[mm].x = pk4_fp8(y0[0], y0[1], y0[2], y0[3]); o[mm].y = pk4_fp8(y1[0], y1[1], y1[2], y1[3]); }
                    auto rx = __builtin_amdgcn_permlane16_swap(o[0].x, o[1].x, false, false); auto ry = __builtin_amdgcn_permlane16_swap(o[0].y, o[1].y, false, false);
                    *(u32x4*)(Y + (size_t)(row0 + ai * 128 + mp * 32) * 1024 + col0 + bj * 128) = (u32x4){rx[0], ry[0], rx[1], ry[1]};
                }
            }
    }
};

#define XB_TMO      128
#define XB_XCNT(j)  (256  + 64 * (j))
#define XB_XSUB(j)  (1280 + 64 * (j))
#define XB_XGEN(j)  (2304 + 64 * (j))
#define XB_TOP      3328
#define XB_TOPGEN   3392
#define XCD_BAR_WORDS 3456
#define XB_SPIN_CAP (1u << 18)
#define LAS __attribute__((address_space(3)))

__device__ __forceinline__ unsigned xb_ld(unsigned* p)              { return __hip_atomic_load(p, __ATOMIC_RELAXED, __HIP_MEMORY_SCOPE_AGENT); }
__device__ __forceinline__ unsigned xb_add(unsigned* p, unsigned v) { return __hip_atomic_fetch_add(p, v, __ATOMIC_RELAXED, __HIP_MEMORY_SCOPE_AGENT); }
__device__ __forceinline__ unsigned xb_xcc_id() { return (unsigned)__builtin_amdgcn_s_getreg((3 << 11) | 20) & 0xFu; }
#define XB_SPIN(cond, bar) do { unsigned _sp = 0; while (cond) { __builtin_amdgcn_s_sleep(1); \
    if ((++_sp & 255u) == 0u) { if (xb_ld(&(bar)[XB_TMO])) break; if (_sp > XB_SPIN_CAP) { atomicAdd(&(bar)[XB_TMO], 1u); break; } } } } while (0)

struct XcdBarrier {
    unsigned* bar; unsigned x;
    volatile LAS unsigned* st;
};

__device__ __forceinline__ XcdBarrier xcd_barrier_post(unsigned* bar, volatile LAS unsigned* st) {
    XcdBarrier b; b.bar = bar; b.x = xb_xcc_id(); b.st = st;
    if (threadIdx.x == 0) (void)xb_add(&bar[XB_XCNT(b.x)], 1u);
    return b;
}
__device__ __forceinline__ void xcd_barrier_complete(unsigned* bar, unsigned x, unsigned& nloc, unsigned& nx) {
    const unsigned G = gridDim.x * gridDim.y * gridDim.z;
    unsigned sum, cnt, mine, sp = 0u;
    for (;;) {
        sum = 0u; cnt = 0u; mine = 0u;
#pragma unroll
        for (unsigned j = 0; j < 16; ++j) { const unsigned c = xb_ld(&bar[XB_XCNT(j)]); sum += c; cnt += (c > 0u) ? 1u : 0u; mine = (j == x) ? c : mine; }
        if (sum == G) break;
        __builtin_amdgcn_s_sleep(1);
        if ((++sp & 255u) == 0u) { if (xb_ld(&bar[XB_TMO])) break; if (sp > XB_SPIN_CAP) { atomicAdd(&bar[XB_TMO], 1u); break; } }
    }
    nloc = mine > 0u ? mine : 1u; nx = cnt > 0u ? cnt : 1u;
}

__device__ __forceinline__ void xcd_barrier(const XcdBarrier& b) {
    asm volatile("s_waitcnt vmcnt(0)" ::: "memory");
    __syncthreads();
    if (threadIdx.x == 0) {
        unsigned* bar = b.bar;
        __builtin_amdgcn_s_waitcnt(0);
        unsigned nloc = b.st[0], nx = b.st[1];
        if (nloc == 0u) { xcd_barrier_complete(bar, b.x, nloc, nx); b.st[0] = nloc; b.st[1] = nx; }
        const unsigned old = xb_add(&bar[XB_XSUB(b.x)], 1u);
        const unsigned gen = old / nloc;
        if (old + 1u == (gen + 1u) * nloc) {
            __builtin_amdgcn_fence(__ATOMIC_RELEASE, "agent");
            asm volatile("s_waitcnt vmcnt(0)" ::: "memory");
            const unsigned og = xb_add(&bar[XB_TOP], 1u);
            const unsigned tg = og / nx;
            if (og + 1u == (tg + 1u) * nx) xb_add(&bar[XB_TOPGEN], 1u);
            else XB_SPIN(xb_ld(&bar[XB_TOPGEN]) == tg, bar);
            __builtin_amdgcn_fence(__ATOMIC_ACQUIRE, "agent");
            xb_add(&bar[XB_XGEN(b.x)], 1u);
            asm volatile("s_waitcnt vmcnt(0)" ::: "memory");
        } else {
            XB_SPIN(xb_ld(&bar[XB_XGEN(b.x)]) == gen, bar);
            __builtin_amdgcn_fence(__ATOMIC_ACQUIRE, "agent");
            asm volatile("s_waitcnt vmcnt(0)" ::: "memory");
        }
    }
    __syncthreads();
}


namespace fa {
using bf16x8 = __attribute__((ext_vector_type(8))) short;
using s16x4 = __attribute__((ext_vector_type(4))) short;
using f32x16 = __attribute__((ext_vector_type(16))) float;
typedef short v4i16_t __attribute__((ext_vector_type(4)));
constexpr int SUBB = 16384, SLOTB = 2 * SUBB, NSLOT = 3, PFD = NSLOT - 1;
constexpr int FA_WS = 131072, FA_OST = 0, OST_PITCH = 68;
static_assert(NSLOT * SLOTB <= 131072 && 8 * 32 * OST_PITCH * 4 <= NSLOT * SLOTB && FA_WS + 8 * 256 <= 139264, "attention LDS map");
__device__ __forceinline__ void glds16(const void* gsrc, unsigned lds_dst) { unsigned keep;
    asm volatile("s_mov_b32 %0, m0\n\ts_mov_b32 m0, %2\n\ts_nop 0\n\tglobal_load_lds_dwordx4 %1, off\n\ts_mov_b32 m0, %0" : "=&s"(keep) : "v"(gsrc), "s"(lds_dst) : "memory"); }
__device__ __forceinline__ s16x4 vtr(const LAS unsigned char* p) { return __builtin_bit_cast(s16x4, __builtin_amdgcn_ds_read_tr16_b64_v4i16((LAS v4i16_t*)p)); }
typedef float f32x2_t __attribute__((ext_vector_type(2))); typedef __bf16 bf16x2_t __attribute__((ext_vector_type(2)));
__device__ __forceinline__ unsigned cvtpk(float lo, float hi) { f32x2_t v = {lo, hi}; bf16x2_t b = __builtin_convertvector(v, bf16x2_t); return __builtin_bit_cast(unsigned, b); }
#define FA_WAIT_BAR(N) asm volatile("s_waitcnt vmcnt(" #N ") lgkmcnt(0)\n\ts_barrier" ::: "memory")
#define FA_MFMA(a, b, c) __builtin_amdgcn_mfma_f32_32x32x16_bf16((a), (b), (c), 0, 0, 0)

__device__ __forceinline__ void map_tile(const LAS unsigned char* kp, int ko0, int ko1, const bf16x8 (&qf)[2], const s16x4 (&vlo)[8], const s16x4 (&vhi)[8], f32x16 (&o)[2], float& l) {
    const bf16x8 k00 = *(const LAS bf16x8*)(kp + ko0), k01 = *(const LAS bf16x8*)(kp + ko1), k10 = *(const LAS bf16x8*)(kp + ko0 + 4096), k11 = *(const LAS bf16x8*)(kp + ko1 + 4096);
    f32x16 z;
#pragma unroll
    for (int i = 0; i < 16; ++i) z[i] = 0.f;
    f32x16 s0 = FA_MFMA(k00, qf[0], z), s1 = FA_MFMA(k10, qf[0], z);
    __builtin_amdgcn_sched_group_barrier(0x8, 2, 0);
    s0 = FA_MFMA(k01, qf[1], s0); s1 = FA_MFMA(k11, qf[1], s1);
#pragma unroll
    for (int i = 0; i < 16; ++i) { s0[i] = __builtin_amdgcn_exp2f(s0[i]); s1[i] = __builtin_amdgcn_exp2f(s1[i]); }
    float a = 0.f, b = 0.f;
#pragma unroll
    for (int i = 0; i < 16; ++i) { a += s0[i]; b += s1[i]; }
    l += a + b;
    u32x4 pw[4];
#pragma unroll
    for (int j = 0; j < 4; ++j) { pw[0][j] = cvtpk(s0[2 * j], s0[2 * j + 1]); pw[1][j] = cvtpk(s0[8 + 2 * j], s0[8 + 2 * j + 1]); pw[2][j] = cvtpk(s1[2 * j], s1[2 * j + 1]); pw[3][j] = cvtpk(s1[8 + 2 * j], s1[8 + 2 * j + 1]); }
#pragma unroll
    for (int ks = 0; ks < 4; ++ks)
#pragma unroll
        for (int d0 = 0; d0 < 2; ++d0) {
            const int i = d0 * 4 + ks;
            const bf16x8 vf = (bf16x8){vlo[i][0], vlo[i][1], vlo[i][2], vlo[i][3], vhi[i][0], vhi[i][1], vhi[i][2], vhi[i][3]};
            o[d0] = FA_MFMA(__builtin_bit_cast(bf16x8, pw[ks]), vf, o[d0]);
        }
}
template <class Mid> __device__ __forceinline__ void attn_unit(const Mid& mid, LAS unsigned char* lds, const bf16* __restrict__ Qu, const bf16* __restrict__ Kh, const bf16* __restrict__ Vh, int q0, int NT,
                                          float lam, float oscale, const float* __restrict__ subg, bf16* __restrict__ mixp, int tid) {
    int tid_u = tid; asm volatile("" : "+v"(tid_u));
    const int lane = tid_u & 63, r32 = lane & 31, hi = lane >> 5, wid = __builtin_amdgcn_readfirstlane(tid_u >> 6);
    const unsigned lds0 = (unsigned)(uintptr_t)lds;
    const bf16* ksrc = Kh + (size_t)(8 * wid + (lane >> 3)) * 64 + (((lane & 7) ^ ((4 * (wid & 1) + (lane >> 4)) & 7)) * 8);
    const bf16* vsrc = Vh + (size_t)(16 * (wid & 3) + (lane >> 2)) * 64 + (wid >> 2) * 32 + (lane & 3) * 8;
    const unsigned kdst = lds0 + wid * 1024, vdst = lds0 + 8192 + wid * 1024;
#define FA_DMA(t, slot) do { _Pragma("unroll") for (int sb_ = 0; sb_ < 2; ++sb_) { glds16(ksrc + (size_t)(2 * (t) + sb_) * 4096, (unsigned)__builtin_amdgcn_readfirstlane(kdst + (slot) + sb_ * SUBB)); glds16(vsrc + (size_t)(2 * (t) + sb_) * 4096, (unsigned)__builtin_amdgcn_readfirstlane(vdst + (slot) + sb_ * SUBB)); } } while (0)
    const int swr = (r32 >> 1) & 7;
    const LAS unsigned char* kp0 = lds + r32 * 128;
    const int ko10 = ((0 + hi) ^ swr) << 4, ko11 = ((2 + hi) ^ swr) << 4, ko20 = ((4 + hi) ^ swr) << 4, ko21 = ((6 + hi) ^ swr) << 4;
    const LAS unsigned char* vp0 = lds + 8192 + ((lane >> 4) & 1) * 32 + (lane & 3) * 8 + (4 * hi + ((lane & 15) >> 2)) * 64;
#pragma unroll
    for (int d = 0; d < PFD; ++d) FA_DMA((d < (NT >> 1) ? d : (NT >> 1) - 1), d * SLOTB);
    bf16x8 q1f[2], q2f[2];
    { const bf16* qrow = Qu + (size_t)(q0 + wid * 32 + r32) * 64 + hi * 8;
      q1f[0] = *(const bf16x8*)(qrow); q1f[1] = *(const bf16x8*)(qrow + 16); q2f[0] = *(const bf16x8*)(qrow + 32); q2f[1] = *(const bf16x8*)(qrow + 48); }
    asm volatile("" : "+v"(q1f[0]), "+v"(q1f[1]), "+v"(q2f[0]), "+v"(q2f[1]));
    f32x16 o1[2], o2[2]; float l1 = 0.f, l2 = 0.f;
#pragma unroll
    for (int i = 0; i < 16; ++i) { o1[0][i] = 0.f; o1[1][i] = 0.f; o2[0][i] = 0.f; o2[1][i] = 0.f; }
    const int NT2 = NT >> 1;
    int sl = 0;
    for (int t = 0; t < NT2; ++t) {
        FA_WAIT_BAR(4);
        { const int tn = (t + PFD < NT2) ? t + PFD : NT2 - 1; const int sn = (sl == 0) ? (NSLOT - 1) * SLOTB : sl - SLOTB; FA_DMA(tn, sn); }
#pragma unroll 1
        for (int sb = 0; sb < 2; ++sb) {
            const LAS unsigned char* kp = kp0 + sl + sb * SUBB; const LAS unsigned char* vp = vp0 + sl + sb * SUBB;
            s16x4 vlo[8], vhi[8];
#pragma unroll
            for (int i = 0; i < 8; ++i) { vlo[i] = vtr(vp + (i >> 2) * 4096 + (i & 3) * 1024); vhi[i] = vtr(vp + (i >> 2) * 4096 + (i & 3) * 1024 + 512); }
            map_tile(kp, ko10, ko11, q1f, vlo, vhi, o1, l1);
            map_tile(kp, ko20, ko21, q2f, vlo, vhi, o2, l2);
            __builtin_amdgcn_sched_barrier(0);
        }
        sl += SLOTB; if (sl >= NSLOT * SLOTB) sl = 0;
    }
#undef FA_DMA
    asm volatile("s_waitcnt vmcnt(0) lgkmcnt(0)\n\ts_barrier" ::: "memory");
    f32x4 xv[32]; mid.load(xv);
    l1 += __shfl_xor(l1, 32); l2 += __shfl_xor(l2, 32);
    int lane_e = lane; asm volatile("" : "+v"(lane_e));
    const int r32e = lane_e & 31, hie = lane_e >> 5;
    LAS float* wsf = (LAS float*)(lds + FA_WS) + wid * 64;
    if (hie == 0) { wsf[r32e] = 1.0f / l1; wsf[32 + r32e] = lam / l2; }
    const LAS float* wq = wsf + 4 * hie;
    LAS float* sb = (LAS float*)(lds + FA_OST) + wid * (32 * OST_PITCH) + (4 * hie) * OST_PITCH + r32e;
#pragma unroll
    for (int i = 0; i < 16; ++i) {
        const int qc = (i & 3) + 8 * (i >> 2); const float a = wq[qc], b = wq[32 + qc];
        sb[qc * OST_PITCH] = o1[0][i] * a - o2[0][i] * b; sb[qc * OST_PITCH + 32] = o1[1][i] * a - o2[1][i] * b;
    }
    const int ch = lane_e & 7;
    const f32x4 g0 = *(const f32x4*)(subg + ch * 8), g1 = *(const f32x4*)(subg + ch * 8 + 4);
    const LAS float* rb = (const LAS float*)(lds + FA_OST) + wid * (32 * OST_PITCH) + (lane_e >> 3) * OST_PITCH + ch * 8;
    bf16* mrow = mixp + (size_t)(wid * 32 + (lane_e >> 3)) * DM + ch * 8;
#pragma unroll
    for (int ps = 0; ps < 4; ++ps) {
        const f32x4 x0 = *(const LAS f32x4*)(rb + ps * 8 * OST_PITCH), x1 = *(const LAS f32x4*)(rb + ps * 8 * OST_PITCH + 4);
        float ss = (x0[0] * x0[0] + x0[1] * x0[1]) + (x0[2] * x0[2] + x0[3] * x0[3]) + (x1[0] * x1[0] + x1[1] * x1[1]) + (x1[2] * x1[2] + x1[3] * x1[3]);
        ss += __shfl_xor(ss, 1); ss += __shfl_xor(ss, 2); ss += __shfl_xor(ss, 4);
        const float r = oscale * __builtin_amdgcn_rsqf(ss * (1.0f / 64.0f) + EPS);
        *(u32x4*)(mrow + (size_t)ps * 8 * DM) = pack8(x0 * r * g0, x1 * r * g1);
    }
    mid.store(xv);
    asm volatile("s_waitcnt vmcnt(0) lgkmcnt(0)\n\ts_barrier" ::: "memory");
}
#undef FA_MFMA
}
struct Args { const float* in[26]; float* out; unsigned char* ws; int ph_lo, ph_hi, bar_region, pad; };

__device__ __forceinline__ int perm_row(int n, int mode) {
    if (mode == 1) return ((n & 1023) >> 7) * 256 + (n >> 10) * 128 + (n & 127);
    if (mode == 2) { if (n >= 1792 && n < 2304) { const int u = n >= 2048, j = n - (u ? 2048 : 1792); return 1792 + (j >> 7) * 256 + u * 128 + (j & 127); } return n; }
    return n;
}
__device__ __forceinline__ void transpose_item(const float* __restrict__ src, int N, int nb, int kq, bf16* __restrict__ dst, int mode, int lane) {
    const int n = nb * 64 + lane, np = perm_row(n, mode);
#pragma unroll 1
    for (int it = 0; it < 2; ++it) {
        const int k0 = kq * 64 + it * 32; float v[32];
#pragma unroll
        for (int i = 0; i < 32; ++i) v[i] = src[(size_t)(k0 + i) * N + n];
        u32x4* d = (u32x4*)(dst + (size_t)np * DM + k0);
#pragma unroll
        for (int q = 0; q < 4; ++q) { u32x4 a; a.x = pg8::cvt_pk_bf16(v[8 * q], v[8 * q + 1]); a.y = pg8::cvt_pk_bf16(v[8 * q + 2], v[8 * q + 3]); a.z = pg8::cvt_pk_bf16(v[8 * q + 4], v[8 * q + 5]); a.w = pg8::cvt_pk_bf16(v[8 * q + 6], v[8 * q + 7]); d[q] = a; }
    }
}
__device__ __forceinline__ void transpose_item8(const float* __restrict__ src, int N, int nb, int kq, unsigned char* __restrict__ dst, int mode, int lane) {
    const int n = nb * 64 + lane, np = perm_row(n, mode);
#pragma unroll 1
    for (int it = 0; it < 2; ++it) {
        const int k0 = kq * 64 + it * 32; float v[32];
#pragma unroll
        for (int i = 0; i < 32; ++i) v[i] = src[(size_t)(k0 + i) * N + n] * W8_SCALE;
        u32x4* d = (u32x4*)(dst + (size_t)np * DM + k0);
#pragma unroll
        for (int q = 0; q < 2; ++q) { u32x4 a; a.x = pk4_fp8(v[16 * q], v[16 * q + 1], v[16 * q + 2], v[16 * q + 3]); a.y = pk4_fp8(v[16 * q + 4], v[16 * q + 5], v[16 * q + 6], v[16 * q + 7]);
            a.z = pk4_fp8(v[16 * q + 8], v[16 * q + 9], v[16 * q + 10], v[16 * q + 11]); a.w = pk4_fp8(v[16 * q + 12], v[16 * q + 13], v[16 * q + 14], v[16 * q + 15]); d[q] = a; }
    }
}

__device__ __forceinline__ void transpose_batch8w(const float* __restrict__ src, int N, int nb, int k0, unsigned char* __restrict__ dst, int mode, int lane) {
    const int n0 = nb * 256 + lane * 4; f32x4 v[32];
#pragma unroll
    for (int i = 0; i < 32; ++i) v[i] = *(const f32x4*)(src + (size_t)(k0 + i) * N + n0);
#pragma unroll
    for (int c = 0; c < 4; ++c) {
        const int np = perm_row(n0 + c, mode); u32x4* d = (u32x4*)(dst + (size_t)np * DM + k0);
#pragma unroll
        for (int q = 0; q < 2; ++q) { u32x4 a;
            a.x = pk4_fp8(v[16 * q][c] * W8_SCALE, v[16 * q + 1][c] * W8_SCALE, v[16 * q + 2][c] * W8_SCALE, v[16 * q + 3][c] * W8_SCALE);
            a.y = pk4_fp8(v[16 * q + 4][c] * W8_SCALE, v[16 * q + 5][c] * W8_SCALE, v[16 * q + 6][c] * W8_SCALE, v[16 * q + 7][c] * W8_SCALE);
            a.z = pk4_fp8(v[16 * q + 8][c] * W8_SCALE, v[16 * q + 9][c] * W8_SCALE, v[16 * q + 10][c] * W8_SCALE, v[16 * q + 11][c] * W8_SCALE);
            a.w = pk4_fp8(v[16 * q + 12][c] * W8_SCALE, v[16 * q + 13][c] * W8_SCALE, v[16 * q + 14][c] * W8_SCALE, v[16 * q + 15][c] * W8_SCALE);
            d[q] = a; }
    }
}
__device__ __forceinline__ void transpose_batch16w(const float* __restrict__ src, int N, int nb, int k0, bf16* __restrict__ dst, int mode, int lane) {
    const int n0 = nb * 256 + lane * 4; f32x4 v[32];
#pragma unroll
    for (int i = 0; i < 32; ++i) v[i] = *(const f32x4*)(src + (size_t)(k0 + i) * N + n0);
#pragma unroll
    for (int c = 0; c < 4; ++c) {
        const int np = perm_row(n0 + c, mode); u32x4* d = (u32x4*)(dst + (size_t)np * DM + k0);
#pragma unroll
        for (int q = 0; q < 4; ++q) { u32x4 a; a.x = pg8::cvt_pk_bf16(v[8 * q][c], v[8 * q + 1][c]); a.y = pg8::cvt_pk_bf16(v[8 * q + 2][c], v[8 * q + 3][c]); a.z = pg8::cvt_pk_bf16(v[8 * q + 4][c], v[8 * q + 5][c]); a.w = pg8::cvt_pk_bf16(v[8 * q + 6][c], v[8 * q + 7][c]); d[q] = a; }
    }
}
constexpr int XW_BATCHES = 2 * (NEXP * 8 * 16 + NEXP * 4 * 16);
__device__ __forceinline__ void expert_weight_batch(int l, int bi, const float* __restrict__ w_gu, const float* __restrict__ w_dn, unsigned char* __restrict__ Wgu8, unsigned char* __restrict__ Wdn8, int lane) {
    const int item = bi >> 1, k32 = (bi & 1) * 32;
    if (item < NEXP * 8 * 16) { const int kq = item & 15, nb = (item >> 4) & 7, m = l * NEXP + (item >> 7);
        transpose_batch8w(w_gu + (size_t)m * DM * 2048, 2048, nb, kq * 64 + k32, Wgu8 + (size_t)m * 2048 * DM, 1, lane); }
    else { const int it2 = item - NEXP * 8 * 16, kq = it2 & 15, nb = (it2 >> 4) & 3, m = l * NEXP + (it2 >> 6);
        transpose_batch8w(w_dn + (size_t)m * DM * DM, DM, nb, kq * 64 + k32, Wdn8 + (size_t)m * DM * DM, 0, lane); }
}

struct XwMid {
    const float* src; unsigned char* dst; int N, n0, k0, mode; bool on;
    __device__ __forceinline__ void setup(int l, int bi, const float* w_gu, const float* w_dn, unsigned char* Wgu8, unsigned char* Wdn8, int lane) {
        on = bi < XW_BATCHES; const int item = bi >> 1, k32 = (bi & 1) * 32;
        if (item < NEXP * 8 * 16) { const int kq = item & 15, nb = (item >> 4) & 7, m = l * NEXP + (item >> 7); src = w_gu + (size_t)m * DM * 2048; dst = Wgu8 + (size_t)m * 2048 * DM; N = 2048; n0 = nb * 256 + lane * 4; k0 = kq * 64 + k32; mode = 1; }
        else { const int it2 = item - NEXP * 8 * 16, kq = it2 & 15, nb = (it2 >> 4) & 3, m = l * NEXP + (it2 >> 6); src = w_dn + (size_t)m * DM * DM; dst = Wdn8 + (size_t)m * DM * DM; N = DM; n0 = nb * 256 + lane * 4; k0 = kq * 64 + k32; mode = 0; }
    }
    __device__ __forceinline__ void load(f32x4 (&v)[32]) const { if (on) {
#pragma unroll
        for (int i = 0; i < 32; ++i) v[i] = *(const f32x4*)(src + (size_t)(k0 + i) * N + n0); } }
    __device__ __forceinline__ void store(const f32x4 (&v)[32]) const { if (on) {
#pragma unroll
        for (int c = 0; c < 4; ++c) {
            const int np = perm_row(n0 + c, mode); u32x4* d = (u32x4*)(dst + (size_t)np * DM + k0);
#pragma unroll
            for (int q = 0; q < 2; ++q) { u32x4 a;
                a.x = pk4_fp8(v[16 * q][c] * W8_SCALE, v[16 * q + 1][c] * W8_SCALE, v[16 * q + 2][c] * W8_SCALE, v[16 * q + 3][c] * W8_SCALE);
                a.y = pk4_fp8(v[16 * q + 4][c] * W8_SCALE, v[16 * q + 5][c] * W8_SCALE, v[16 * q + 6][c] * W8_SCALE, v[16 * q + 7][c] * W8_SCALE);
                a.z = pk4_fp8(v[16 * q + 8][c] * W8_SCALE, v[16 * q + 9][c] * W8_SCALE, v[16 * q + 10][c] * W8_SCALE, v[16 * q + 11][c] * W8_SCALE);
                a.w = pk4_fp8(v[16 * q + 12][c] * W8_SCALE, v[16 * q + 13][c] * W8_SCALE, v[16 * q + 14][c] * W8_SCALE, v[16 * q + 15][c] * W8_SCALE);
                d[q] = a; }
        } } }
};

__global__ void __launch_bounds__(NTHR, 2) mk_fwd(Args args) {
    extern __shared__ __attribute__((aligned(16))) unsigned char lds_raw[];
    LAS unsigned char* lds = (LAS unsigned char*)lds_raw;
    const int G = gridDim.x, bx = blockIdx.x, NGW = G * NWAVES;
#define PH_IDS() int tid = threadIdx.x; asm volatile("" : "+v"(tid)); const int lane = tid & 63, wave = __builtin_amdgcn_readfirstlane(tid >> 6), gw = bx * NWAVES + wave; (void)lane; (void)gw
    const int vcu = (G % 8 == 0) ? (bx % 8) * (G / 8) + bx / 8 : bx;
    typedef const __attribute__((address_space(4))) Args* KArgs;
    const KArgs ka0 = (KArgs)__builtin_amdgcn_kernarg_segment_ptr();
#define KA() ({ KArgs p_ = ka0; asm volatile("" : "+s"(p_)); p_; })
#define WSP(T, off) ((T*)(A->ws + (off)))
#define DEF_WS() KArgs A = KA(); int* ctl = WSP(int, WS_CTL); float* mod = WSP(float, WS_MOD); float* ropeC = WSP(float, WS_ROPE); float* ropeS = ropeC + 512; float* scal = WSP(float, WS_SCAL); \
    bf16* Win = WSP(bf16, WS_WIN); bf16* Wout = WSP(bf16, WS_WOUT); bf16* Wgu = WSP(bf16, WS_WGU); bf16* Wdn = WSP(bf16, WS_WDN); \
    bf16* H = WSP(bf16, WS_H); bf16* X1 = WSP(bf16, WS_X1); float* X2C = WSP(float, WS_X2C); \
    int* ASGE = WSP(int, WS_TOK + TOK_AE); float* ASGW = WSP(float, WS_TOK + TOK_AW); int* SLOTOF = WSP(int, WS_TOK + TOK_SLOTOF); int* ROWTOK = WSP(int, WS_TOK + TOK_ROWTOK); float* ROWW = WSP(float, WS_TOK + TOK_ROWW); \
    bf16* Qb = WSP(bf16, WS_RA + RA_Q); bf16* Qcb = WSP(bf16, WS_RA + RA_QC); bf16* Kb = WSP(bf16, WS_RA + RA_K); bf16* Vb = WSP(bf16, WS_RA + RA_V); \
    bf16* CPU = WSP(bf16, WS_RA + RA_CPU); bf16* MIX = WSP(bf16, WS_RA + RA_MIX); bf16* XS = WSP(bf16, WS_RA); bf16* Y = WSP(bf16, WS_RA); bf16* ACT = WSP(bf16, WS_RB); \
    float* out = A->out; const float* xl = l == 0 ? A->in[0] : out; const float* xc = l == 0 ? A->in[2] : X2C; \
    const float* modl = mod + (size_t)l * 17 * NMOD * DM; int* ctll = ctl + l * CTL_LSTRIDE; int* wgcnt = ctl + CTL_WGCNT + l * CTL_WGCNT_L; \
    (void)ctl; (void)mod; (void)ropeC; (void)ropeS; (void)scal; (void)Win; (void)Wout; (void)Wgu; (void)Wdn; (void)H; (void)X1; (void)X2C; (void)ASGE; (void)ASGW; (void)SLOTOF; (void)ROWTOK; (void)ROWW; \
    (void)Qb; (void)Qcb; (void)Kb; (void)Vb; (void)CPU; (void)MIX; (void)XS; (void)Y; (void)ACT; (void)out; (void)xl; (void)xc; (void)modl; (void)ctll; (void)wgcnt
    LAS int* lctl = (LAS int*)(lds + LDS_CTL);
    for (int u = threadIdx.x; u < (LDS_BYTES - LDS_CTL) / 4; u += NTHR) ((LAS unsigned*)(lds + LDS_CTL))[u] = 0u;
    __syncthreads();
    XcdBarrier bar = xcd_barrier_post((unsigned*)(ka0->ws + WS_CTL) + CTL_BAR + ka0->bar_region * CTL_BAR_STRIDE, (volatile LAS unsigned*)(lds + LDS_BARW));
    const int lo = ka0->ph_lo, hi = ka0->ph_hi;
#define IN(k) (lo <= (k) && (k) < hi)
#define SEAM(k) do { if (IN(k) && IN((k) + 1)) xcd_barrier(bar); } while (0)

    if (IN(0)) {
        const int l = 0; PH_IDS(); DEF_WS();
        const float* cvec = A->in[1]; const float* c_ctx = A->in[3]; const float* w_mod = A->in[4]; const float* b_mod = A->in[5];
        const float* w_in = A->in[8]; const float* pool_w = A->in[17]; const float* pool_scale = A->in[18]; const float* w_out = A->in[19]; const float* w_gu = A->in[22]; const float* w_dn = A->in[24];
        if (bx < 192) {
            LAS float* sl = (LAS float*)lds + 8704;
            for (int i = tid; i < 17 * DM; i += NTHR) { const float cv = i < 16 * DM ? cvec[i] : c_ctx[i - 16 * DM]; sl[i] = cv * __builtin_amdgcn_rcpf(1.0f + __builtin_amdgcn_exp2f(cv * -1.4426950408889634f)); }
            __syncthreads();
        }
        for (int t = bx; t < 192; t += G) {
            LAS float* red = (LAS float*)lds;
            const LAS float* sl = (const LAS float*)lds + 8704;
            const int l = t / 96, nb = t % 96, n = nb * 64 + lane;
            float acc[17];
#pragma unroll
            for (int r = 0; r < 17; ++r) acc[r] = 0.f;
            const float* W = w_mod + (size_t)l * DM * (NMOD * DM) + n;
#pragma unroll 1
            for (int k0 = wave * 128; k0 < wave * 128 + 128; k0 += 16) {
                float wv[16];
#pragma unroll
                for (int i = 0; i < 16; ++i) wv[i] = W[(size_t)(k0 + i) * (NMOD * DM)];
#pragma unroll
                for (int i = 0; i < 16; ++i)
#pragma unroll
                    for (int r = 0; r < 17; ++r) acc[r] += sl[r * DM + k0 + i] * wv[i];
            }
#pragma unroll
            for (int r = 0; r < 17; ++r) red[(wave * 17 + r) * 64 + lane] = acc[r];
            __syncthreads();
            for (int idx = tid; idx < 17 * 64; idx += NTHR) {
                const int r = idx >> 6, ln = idx & 63; float sm = 0.f;
#pragma unroll
                for (int ww = 0; ww < 8; ++ww) sm += red[(ww * 17 + r) * 64 + ln];
                mod[((size_t)l * 17 + r) * (NMOD * DM) + nb * 64 + ln] = sm + b_mod[l * (NMOD * DM) + nb * 64 + ln];
            }
            __syncthreads();
        }
        if (bx == G - 1) {
            { const int pos = tid >> 3, pair = tid & 7; const float inv = powf(10000.0f, -(float)pair / 8.0f), ang = (float)pos * inv; ropeC[tid] = cosf(ang); ropeS[tid] = sinf(ang); }
            if (tid < DEPTH) {
                const float *lq1 = A->in[11] + tid * 32, *lk1 = A->in[12] + tid * 32, *lq2 = A->in[13] + tid * 32, *lk2 = A->in[14] + tid * 32;
                float s1 = 0.f, s2 = 0.f;
                for (int d = 0; d < 32; ++d) { s1 += lq1[d] * lk1[d]; s2 += lq2[d] * lk2[d]; }
                const float lam_init = 0.8f - 0.6f * expf(-0.3f * (float)tid);
                scal[tid * 2 + 0] = expf(s1) - expf(s2) + lam_init; scal[tid * 2 + 1] = lam_init;
            }
        }
        {
            const float* router_w = A->in[20]; bf16* wrt = WSP(bf16, WS_WRT);
            for (int i = bx * NTHR + tid; i < DEPTH * NEXP * DM; i += G * NTHR) {
                const int ll = i >> 15, e = (i >> 10) & 31, k = i & 1023; const float w = router_w[((size_t)ll * DM + k) * NEXP + e];
                const unsigned hb = f2bf(w); const float hf = __builtin_bit_cast(float, hb << 16);
                wrt[(size_t)ll * 65536 + e * DM + k] = (bf16)hb; wrt[(size_t)ll * 65536 + 32768 + e * DM + k] = (bf16)f2bf(w - hf);
            }
        }
        constexpr int I_OUTT = DEPTH * 4 * 24, I_FOLD = DEPTH * 16 * 4 * 4, I_OUT = I_OUTT + I_FOLD, I_IN = DEPTH * 10 * 32, I_GU = 0, I_DN = 0;
        for (int step = 0; ; ++step) {
            int it;
            if (G == 256) { if (bx >= 192) { if (step > 0) break; it = gw - 192 * NWAVES; if (it >= I_FOLD) break; } else { it = I_FOLD + gw + step * 192 * NWAVES; if (it >= I_OUT + I_IN + I_GU + I_DN) break; } }
            else { it = gw + step * NGW; if (it >= I_OUT + I_IN + I_GU + I_DN) break; }
            int r = it;
            if (r < I_FOLD) {
                const int i4 = r & 3, gi = (r >> 2) & 3, nb = (r >> 4) & 15, l = r >> 8, n = nb * 64 + lane;
                const float* wo = w_out + (size_t)l * DM * DM + (size_t)(768 + gi * 64) * DM + n;
                const float* __restrict__ wp = pool_w + (size_t)l * 16384 + gi * 4096; const float* __restrict__ ps = pool_scale + l * 256 + gi * 64;
                float v[16];
#pragma unroll
                for (int i = 0; i < 16; ++i) v[i] = 0.f;
                for (int cp = 0; cp < 64; ++cp) { const float w = wo[(size_t)cp * DM] * ps[cp];
#pragma unroll
                    for (int i = 0; i < 16; ++i) v[i] += wp[(i4 * 16 + i) * 64 + cp] * w; }
                u32x4 a, b2;
                a.x = f2bf(v[0]) | (f2bf(v[1]) << 16); a.y = f2bf(v[2]) | (f2bf(v[3]) << 16); a.z = f2bf(v[4]) | (f2bf(v[5]) << 16); a.w = f2bf(v[6]) | (f2bf(v[7]) << 16);
                b2.x = f2bf(v[8]) | (f2bf(v[9]) << 16); b2.y = f2bf(v[10]) | (f2bf(v[11]) << 16); b2.z = f2bf(v[12]) | (f2bf(v[13]) << 16); b2.w = f2bf(v[14]) | (f2bf(v[15]) << 16);
                u32x4* d = (u32x4*)(Wout + (size_t)l * DM * DM + (size_t)n * DM + 768 + gi * 64 + i4 * 16); d[0] = a; d[1] = b2;
                continue;
            }
            if (r < I_OUT) { const int q = r - I_FOLD, kb = q % 24, nb = (q / 24) & 3, l = q / 96; transpose_batch16w(w_out + (size_t)l * DM * DM, DM, nb, kb * 32, Wout + (size_t)l * DM * DM, 0, lane); continue; }
            r -= I_OUT;
            if (r < I_IN) { const int kb = r & 31, nb = (r >> 5) % 10, l = (r >> 5) / 10; transpose_batch16w(w_in + (size_t)l * DM * INW, INW, nb, kb * 32, Win + (size_t)l * INW * DM, 2, lane); continue; }
        }
    }
    SEAM(0);

    { constexpr int l = 0;
        const int pb = 1 + 9 * l; const bool has_next = l + 1 < DEPTH;
        const int nmoe = has_next ? TT : TL;

        if (IN(pb + 0) && l == 0) {
            PH_IDS(); DEF_WS(); const float* g = A->in[6] + l * DM;
            f32x4 vn[2][4];
            if (gw * 2 < TT) {
#pragma unroll
                for (int r = 0; r < 2; ++r) { const int row = gw * 2 + r; const float* src = row < TL ? xl + (size_t)row * DM : xc + (size_t)(row - TL) * DM;
#pragma unroll
                    for (int jj = 0; jj < 2; ++jj) { const int col = (lane + 64 * jj) * 8; vn[r][2 * jj] = *(const f32x4*)(src + col); vn[r][2 * jj + 1] = *(const f32x4*)(src + col + 4); } }
            }
            for (int row0 = gw * 2; row0 < TT; row0 += NGW * 2) {
                f32x4 v[2][4]; float ss[2];
#pragma unroll
                for (int r = 0; r < 2; ++r)
#pragma unroll
                    for (int j = 0; j < 4; ++j) v[r][j] = vn[r][j];
                if (row0 + NGW * 2 < TT) {
#pragma unroll
                    for (int r = 0; r < 2; ++r) { const int row = row0 + NGW * 2 + r; const float* src = row < TL ? xl + (size_t)row * DM : xc + (size_t)(row - TL) * DM;
#pragma unroll
                        for (int jj = 0; jj < 2; ++jj) { const int col = (lane + 64 * jj) * 8; vn[r][2 * jj] = *(const f32x4*)(src + col); vn[r][2 * jj + 1] = *(const f32x4*)(src + col + 4); } }
                }
#pragma unroll
                for (int r = 0; r < 2; ++r) {
                    const int row = row0 + r; ss[r] = 0.f;
#pragma unroll
                    for (int jj = 0; jj < 2; ++jj) { const int col = (lane + 64 * jj) * 8;
                        *(u32x4*)((bf16*)ACT + (size_t)row * DM + col) = pack8(v[r][2 * jj], v[r][2 * jj + 1]); }
                }
#pragma unroll
                for (int r = 0; r < 2; ++r) {
                    const int row = row0 + r; const int b = row < TL ? (row >> 12) : 16;
                    const float* sh = modl + (size_t)b * (NMOD * DM); const float* sc = sh + DM;
#pragma unroll
                    for (int j = 0; j < 4; ++j) ss[r] += (v[r][j].x * v[r][j].x + v[r][j].y * v[r][j].y) + (v[r][j].z * v[r][j].z + v[r][j].w * v[r][j].w);
                    const float rstd = __builtin_amdgcn_rsqf(wave_sum(ss[r]) * (1.0f / DM) + EPS);
#pragma unroll
                    for (int jj = 0; jj < 2; ++jj) {
                        const int col = (lane + 64 * jj) * 8; f32x4 y[2];
#pragma unroll
                        for (int h = 0; h < 2; ++h) y[h] = (v[r][2 * jj + h] * rstd) * *(const f32x4*)(g + col + 4 * h) * (*(const f32x4*)(sc + col + 4 * h) + 1.0f) + *(const f32x4*)(sh + col + 4 * h);
                        *(u32x4*)(H + (size_t)row * DM + col) = pack8(y[0], y[1]);
                    }
                }
            }
        }
        if (l == 0)
        SEAM(pb + 0);
        if (IN(pb + 1)) {
            PH_IDS(); DEF_WS(); const float* q_norm_g = A->in[9]; const float* k_norm_g = A->in[10];
            pg8::Gemm g{H, Win + (size_t)l * INW * DM, TT, INW, DM, 0}; InprojOrder S; S.init(has_next ? 10 : 4, G, bx);
            { PG8_LAS float* tb = (PG8_LAS float*)(lds + LDS_EPI);
              for (int i = tid; i < 1088; i += NTHR) tb[i] = i < 512 ? ropeC[i] : (i < 1024 ? ropeS[i - 512] : (i < 1056 ? q_norm_g[l * 32 + i - 1024] : k_norm_g[l * 32 + i - 1056]));
              __syncthreads(); }
            EpiInproj E{Qb, Qcb, Kb, Vb, CPU, (const PG8_LAS float*)(lds + LDS_EPI)};
            pg8::gemm_phase<EpiInproj, InprojOrder, true, true>(lds, g, S, E);
        }
        SEAM(pb + 1);
        if (IN(pb + 2)) {
            PH_IDS(); DEF_WS(); const float* subln_g = A->in[15]; const float* conv_w = A->in[16];
            {
                const float lam = scal[2 * l], oscale = 1.0f - scal[2 * l + 1]; const float* sg = subln_g + l * 64;
                const int vcu = (G % 8 == 0) ? (bx % 8) * (G / 8) + bx / 8 : bx;
                const int nunits = 2048 + (has_next ? 128 : 0);
                int xwb = gw;
                for (int u = vcu; u < nunits; u += G) {
                    const bool latq = u < 2048; const int i = u >> 8, v = u & 255;
                    const int bh = latq ? (v >> 5) * 16 + i * 2 + ((v & 31) >> 4) : u - 2048, qb = latq ? (v & 15) : 0;
                    const bf16* Qu = latq ? Qb + (size_t)bh * SEQ * 64 : Qcb + (size_t)bh * CTXL * 64;
                    bf16* mp = MIX + (latq ? ((size_t)(bh >> 3) * SEQ + qb * 256) : ((size_t)TL + (bh >> 3) * CTXL)) * DM + (bh & 7) * 64;
                    XwMid mid; mid.setup(l, xwb, A->in[22], A->in[24], (unsigned char*)Wgu, (unsigned char*)Wdn, lane);
                    fa::attn_unit(mid, lds, Qu, Kb + (size_t)bh * NKEY * 64, Vb + (size_t)bh * NKEY * 64, qb * 256, latq ? NKEY / 64 : CTXL / 64, lam, oscale, sg, mp, tid);
                    if (xwb < XW_BATCHES) xwb += NGW;
                }
                for (; xwb < XW_BATCHES; xwb += NGW) expert_weight_batch(l, xwb, A->in[22], A->in[24], (unsigned char*)Wgu, (unsigned char*)Wdn, lane);
            }
            {
                const int nrows = has_next ? TT : TL; const float* cw = conv_w + l * 768;
                for (int row0 = gw * 4; row0 < nrows; row0 += NGW * 4) {
                    const bool lat = row0 < TL; const int pos0 = lat ? (row0 & 4095) : ((row0 - TL) & 255), len = lat ? SEQ : CTXL;
                    const bf16* prow = CPU + (size_t)row0 * 768;
                    const bool cv = lane < 32; const int ch = (lane & 31) * 8, half = cv ? 1 : 1 << ((lane - 32) >> 3);
                    const int off0 = half, nk = cv ? 6 : 2 * half + 3, colA = cv ? ch : 512 + ch, colB = cv ? 256 + ch : 512 + ch;
                    u32x4 v[23];
#pragma unroll
                    for (int r = 0; r < 4; ++r) v[r] = *(const u32x4*)(prow + (size_t)r * 768 + colA);
#pragma unroll
                    for (int k = 0; k < 19; ++k) { const int ro = k - off0, p = pos0 + ro; v[4 + k] = (u32x4){0u, 0u, 0u, 0u}; if (k < nk && p >= 0 && p < len) v[4 + k] = *(const u32x4*)(prow + (long)ro * 768 + colB); }
                    if (cv) {
                        f32x4 w0[2], w1[2], w2[2];
#pragma unroll
                        for (int hh = 0; hh < 2; ++hh) { w0[hh] = *(const f32x4*)(cw + ch + 4 * hh); w1[hh] = *(const f32x4*)(cw + 256 + ch + 4 * hh); w2[hh] = *(const f32x4*)(cw + 512 + ch + 4 * hh); }
#pragma unroll
                        for (int r = 0; r < 4; ++r) {
                            f32x4 o[2];
#pragma unroll
                            for (int hh = 0; hh < 2; ++hh) {
                                const f32x4 m = (f32x4){bflo(v[4 + r][2 * hh]), bfhi(v[4 + r][2 * hh]), bflo(v[4 + r][2 * hh + 1]), bfhi(v[4 + r][2 * hh + 1])};
                                const f32x4 c = (f32x4){bflo(v[5 + r][2 * hh]), bfhi(v[5 + r][2 * hh]), bflo(v[5 + r][2 * hh + 1]), bfhi(v[5 + r][2 * hh + 1])};
                                const f32x4 p = (f32x4){bflo(v[6 + r][2 * hh]), bfhi(v[6 + r][2 * hh]), bflo(v[6 + r][2 * hh + 1]), bfhi(v[6 + r][2 * hh + 1])};
                                const f32x4 b = (f32x4){bflo(v[r][2 * hh]), bfhi(v[r][2 * hh]), bflo(v[r][2 * hh + 1]), bfhi(v[r][2 * hh + 1])};
                                o[hh] = b * (w0[hh] * m + w1[hh] * c + w2[hh] * p);
                            }
                            *(u32x4*)(MIX + (size_t)(row0 + r) * DM + 512 + ch) = pack8(o[0], o[1]);
                        }
                    } else {
                        f32x4 s0[4], s1[4];
#pragma unroll
                        for (int r = 0; r < 4; ++r) { s0[r] = (f32x4){0.f, 0.f, 0.f, 0.f}; s1[r] = (f32x4){0.f, 0.f, 0.f, 0.f}; }
#pragma unroll
                        for (int u = 0; u < 19; ++u) {
                            const u32x4 x = v[4 + u];
                            const f32x4 a0 = (f32x4){bflo(x.x), bfhi(x.x), bflo(x.y), bfhi(x.y)}, a1 = (f32x4){bflo(x.z), bfhi(x.z), bflo(x.w), bfhi(x.w)};
#pragma unroll
                            for (int r = 0; r < 4; ++r) { const bool in = (u >= r) && (u < r + 2 * half); const float m = in ? 1.0f : 0.0f; s0[r] += a0 * m; s1[r] += a1 * m; }
                        }
#pragma unroll
                        for (int r = 0; r < 4; ++r) {
                            const int pos = pos0 + r; const int cnt = min(pos + half, len) - max(pos - half, 0);
                            const u32x4 uc = v[r]; const float inv = __builtin_amdgcn_rcpf((float)cnt);
                            const f32x4 d0 = s0[r] * inv - (f32x4){bflo(uc.x), bfhi(uc.x), bflo(uc.y), bfhi(uc.y)}, d1 = s1[r] * inv - (f32x4){bflo(uc.z), bfhi(uc.z), bflo(uc.w), bfhi(uc.w)};
                            *(u32x4*)(MIX + (size_t)(row0 + r) * DM + 768 + ch) = pack8(d0, d1);
                        }
                    }
                }
            }
        }
        SEAM(pb + 2);
        if (IN(pb + 3)) {
            PH_IDS(); DEF_WS();
            const int M = has_next ? TT : TL;
            pg8::Gemm g{MIX, Wout + (size_t)l * DM * DM, M, DM, DM, 0}; PlainOrder S; S.init(M, DM, G, bx);
            EpiResid E{(const bf16*)ACT, modl + 2 * DM, X1, lds};
            pg8::gemm_phase<EpiResid, PlainOrder, true, true>(lds, g, S, E);
        }
        SEAM(pb + 3);
        if (IN(pb + 4)) {
            PH_IDS(); DEF_WS(); const float* router_b = A->in[21]; const float* norm2_g = A->in[7];
            const bf16* wrt_hi = WSP(bf16, WS_WRT) + (size_t)l * 65536; const bf16* wrt_lo = wrt_hi + 32768;
            const float* br = router_b + l * NEXP; const float* g = norm2_g + l * DM;
            constexpr int TP = 2064;
            LAS unsigned char* Thi = lds; LAS unsigned char* Tlo = lds + 32 * TP; LAS unsigned char* PART = lds + 64 * TP; LAS float* LOG = (LAS float*)(lds + 64 * TP + 4096);
            static_assert(64 * TP + 8192 <= LDS_CTL, "router LDS map");
            const int eh = wave & 1, rh = (wave >> 1) & 1, kh = wave >> 2, n16 = lane & 15, q4 = lane >> 4;
            fa::bf16x8 ah[16];
#pragma unroll
            for (int st = 0; st < 16; ++st) { const int k = kh * 512 + 32 * st + 8 * q4;
                ah[st] = *(const fa::bf16x8*)(wrt_hi + (eh * 16 + n16) * DM + k); }
            const bf16* alp = wrt_lo + (eh * 16 + n16) * DM + kh * 512 + 8 * q4;
            const f32x4 brv = *(const f32x4*)(br + eh * 16 + 4 * q4);
            if (tid < 32) lctl[tid] = 0;
            __syncthreads();
            u32x4 xq[4][2];
            if (bx < nmoe / 32) {
#pragma unroll
                for (int rr = 0; rr < 4; ++rr)
#pragma unroll
                    for (int j = 0; j < 2; ++j) xq[rr][j] = *(const u32x4*)(X1 + (size_t)(bx * 32 + wave * 4 + rr) * DM + lane * 16 + 8 * j);
            }
            for (int grp = bx; grp < nmoe / 32; grp += G) {
                const int row0 = grp * 32; const int b = row0 < TL ? (row0 >> 12) : 16;
                const float* sh = modl + (size_t)b * (NMOD * DM) + 3 * DM; const float* sc = sh + DM;
                const int col = lane * 16;
                f32x4 gm[4], sv[4];
#pragma unroll
                for (int j = 0; j < 4; ++j) { gm[j] = *(const f32x4*)(g + col + 4 * j) * (*(const f32x4*)(sc + col + 4 * j) + 1.0f); sv[j] = *(const f32x4*)(sh + col + 4 * j); }
#pragma unroll
                for (int rr = 0; rr < 4; ++rr) {
                    const int rl = wave * 4 + rr, row = row0 + rl; f32x4 v[4]; float ss = 0.f;
#pragma unroll
                    for (int j = 0; j < 2; ++j) { const u32x4 xb = xq[rr][j]; v[2 * j] = (f32x4){bflo(xb.x), bfhi(xb.x), bflo(xb.y), bfhi(xb.y)}; v[2 * j + 1] = (f32x4){bflo(xb.z), bfhi(xb.z), bflo(xb.w), bfhi(xb.w)}; }
#pragma unroll
                    for (int j = 0; j < 4; ++j) ss += (v[j].x * v[j].x + v[j].y * v[j].y) + (v[j].z * v[j].z + v[j].w * v[j].w);
                    const float rstd = __builtin_amdgcn_rsqf(wave_sum(ss) * (1.0f / DM) + EPS);
                    u32x4 h8, hiw[2], low[2];
#pragma unroll
                    for (int j = 0; j < 4; ++j) {
                        const f32x4 h = (v[j] * rstd) * gm[j] + sv[j];
                        h8[j] = pk4_fp8(h.x, h.y, h.z, h.w);
                        const unsigned h0 = pg8::cvt_pk_bf16(h.x, h.y), h1 = pg8::cvt_pk_bf16(h.z, h.w);
                        hiw[j >> 1][2 * (j & 1)] = h0; hiw[j >> 1][2 * (j & 1) + 1] = h1;
                        low[j >> 1][2 * (j & 1)] = pg8::cvt_pk_bf16(h.x - bflo(h0), h.y - bfhi(h0)); low[j >> 1][2 * (j & 1) + 1] = pg8::cvt_pk_bf16(h.z - bflo(h1), h.w - bfhi(h1));
                    }
                    *(u32x4*)((unsigned char*)H + (size_t)row * DM + col) = h8;
#pragma unroll
                    for (int j = 0; j < 2; ++j) { *(LAS u32x4*)(Thi + rl * TP + col * 2 + 16 * j) = hiw[j]; *(LAS u32x4*)(Tlo + rl * TP + col * 2 + 16 * j) = low[j]; }
                }
                __syncthreads();
                if (grp + G < nmoe / 32) {
#pragma unroll
                    for (int rr = 0; rr < 4; ++rr)
#pragma unroll
                        for (int j = 0; j < 2; ++j) xq[rr][j] = *(const u32x4*)(X1 + (size_t)((grp + G) * 32 + wave * 4 + rr) * DM + lane * 16 + 8 * j);
                }
                f32x4 acc = (f32x4){0.f, 0.f, 0.f, 0.f};
#pragma unroll
                for (int st = 0; st < 16; ++st) {
                    const int kb = (kh * 512 + 32 * st + 8 * q4) * 2;
                    const fa::bf16x8 bh = *(const LAS fa::bf16x8*)(Thi + (rh * 16 + n16) * TP + kb), bl = *(const LAS fa::bf16x8*)(Tlo + (rh * 16 + n16) * TP + kb);
                    acc = __builtin_amdgcn_mfma_f32_16x16x32_bf16(ah[st], bh, acc, 0, 0, 0);
                    acc = __builtin_amdgcn_mfma_f32_16x16x32_bf16(ah[st], bl, acc, 0, 0, 0);
                    acc = __builtin_amdgcn_mfma_f32_16x16x32_bf16(*(const fa::bf16x8*)(alp + 32 * st), bh, acc, 0, 0, 0);
                }
                if (kh == 1) *(LAS f32x4*)(PART + (wave & 3) * 1024 + lane * 16) = acc;
                __syncthreads();
                if (kh == 0) { acc += *(const LAS f32x4*)(PART + (wave & 3) * 1024 + lane * 16); acc += brv; *(LAS f32x4*)(LOG + (rh * 16 + n16) * 32 + eh * 16 + 4 * q4) = acc; }
                __syncthreads();
                {
                    const int rr = lane >> 4, j16 = lane & 15, rl = wave * 4 + rr, tok = row0 + rl;
                    const f32x2v xx = *(const LAS f32x2v*)(LOG + rl * 32 + 2 * j16);
                    float x0 = xx[0], x1 = xx[1];
                    float bv[4]; int be[4];
#pragma unroll
                    for (int k = 0; k < 4; ++k) {
                        float v = x0 >= x1 ? x0 : x1; int e = x0 >= x1 ? 2 * j16 : 2 * j16 + 1;
#define TOP_STEP(CTRL) { const float v2 = dpp_movf<CTRL>(v); const int e2 = dpp_movi<CTRL>(e); const bool tk = (v2 > v) || (v2 == v && e2 < e); v = tk ? v2 : v; e = tk ? e2 : e; }
                        TOP_STEP(0xB1) TOP_STEP(0x4E) TOP_STEP(0x141) TOP_STEP(0x140)
#undef TOP_STEP
                        bv[k] = v; be[k] = e;
                        if (e == 2 * j16) x0 = -3.0e38f;
                        if (e == 2 * j16 + 1) x1 = -3.0e38f;
                    }
                    float pe[4], sm = 0.f;
#pragma unroll
                    for (int k = 0; k < 4; ++k) { pe[k] = __builtin_amdgcn_exp2f((bv[k] - bv[0]) * 1.4426950408889634f); sm += pe[k]; }
                    if (j16 < 4) {
                        const int ek = j16 == 0 ? be[0] : j16 == 1 ? be[1] : j16 == 2 ? be[2] : be[3]; const float pk = j16 == 0 ? pe[0] : j16 == 1 ? pe[1] : j16 == 2 ? pe[2] : pe[3];
                        const int rank = atomicAdd((int*)(lctl + ek), 1);
                        ASGE[(size_t)tok * 4 + j16] = ek | (rank << 8); ASGW[(size_t)tok * 4 + j16] = pk * __builtin_amdgcn_rcpf(sm);
                    }
                }
            }
            __syncthreads();
            if (tid < 32) wgcnt[bx * 32 + tid] = lctl[tid];
        }
        SEAM(pb + 4);
        if (IN(pb + 5)) {
            PH_IDS(); DEF_WS();
            {
                LAS int* sc = (LAS int*)lds; const int e = tid & 31, part = tid >> 5, per = (G + 15) >> 4;
                int tot = 0, off = 0;
                for (int j = 0; j < per; ++j) { const int w = part * per + j; if (w < G) { const int cc = wgcnt[w * 32 + e]; tot += cc; if (w < bx) off += cc; } }
                sc[part * 32 + e] = tot; sc[512 + part * 32 + e] = off;
                __syncthreads();
                if (tid < 32) { int t2 = 0, o2 = 0;
#pragma unroll
                    for (int p = 0; p < 16; ++p) { t2 += sc[p * 32 + tid]; o2 += sc[512 + p * 32 + tid]; }
                    lctl[96 + tid] = t2; lctl[64 + tid] = o2; }
            }
            __syncthreads();
            if (tid == 0) {
                int blk = 0;
                for (int e = 0; e < NEXP; ++e) { lctl[32 + e] = blk * 256; blk += (lctl[96 + e] + 255) >> 8; }
                *(LAS int*)(lds + LDS_NBLK) = blk;
                if (bx == 0) ctll[CTL_NBLK] = blk;
            }
            __syncthreads();
            if (tid < NEXP) { const int b0 = lctl[32 + tid] >> 8, nb = (lctl[96 + tid] + 255) >> 8; for (int j = 0; j < nb; ++j) (lds + LDS_BTE)[b0 + j] = (unsigned char)tid; }
            if (bx == 0 && tid < NEXP) { const int b0 = lctl[32 + tid] >> 8, nb = (lctl[96 + tid] + 255) >> 8; for (int j = 0; j < nb; ++j) ctll[CTL_BLKE + b0 + j] = tid; }
            for (int e = bx; e < NEXP; e += G) {
                const int beg = lctl[32 + e] + lctl[96 + e], end = lctl[32 + e] + (((lctl[96 + e] + 255) >> 8) << 8);
                for (int s = beg + tid; s < end; s += NTHR) { ROWTOK[s] = 0; ROWW[s] = 0.f; }
            }
            {
                const int ng = bx < nmoe / 32 ? (nmoe / 32 - bx + G - 1) / G : 0;
                for (int idx = tid; idx < ng * 128; idx += NTHR) {
                    const int grp = bx + (idx >> 7) * G, t7 = idx & 127;
                    const int tok = grp * 32 + (t7 >> 2), k = t7 & 3; const int ev = ASGE[(size_t)tok * 4 + k], e = ev & 255, rank = ev >> 8;
                    const int slot = lctl[32 + e] + lctl[64 + e] + rank;
                    ROWTOK[slot] = tok; ROWW[slot] = ASGW[(size_t)tok * 4 + k]; SLOTOF[(size_t)tok * 4 + k] = slot;
                }
            }
        }
        SEAM(pb + 5);
        if (IN(pb + 6)) {
            PH_IDS(); DEF_WS(); const float* b_gu = A->in[23];
            pg8::Gemm g{H, (const bf16*)((const unsigned char*)Wgu + (size_t)l * NEXP * 2048 * DM), 0, 2048, DM / 2, 0}; GroupedOrder S; S.init(lds, 8, 2048, G, bx, ROWTOK);
            EpiSwiglu E{ctll, b_gu + (size_t)l * NEXP * 2048, (unsigned char*)ACT, lds};
            pg8::gemm_phase<EpiSwiglu, GroupedOrder, true, true, true, true>(lds, g, S, E);
        }
        SEAM(pb + 6);
        if (IN(pb + 7)) {
            PH_IDS(); DEF_WS(); const float* b_dn = A->in[25];
            pg8::Gemm g{ACT, (const bf16*)((const unsigned char*)Wdn + (size_t)l * NEXP * DM * DM), 0, DM, DM / 2, 0}; GroupedOrder S; S.init(lds, 4, 1024, G, bx);
            EpiDown E{ctll, b_dn + (size_t)l * NEXP * DM, ROWW, (unsigned char*)Y, lds};
            pg8::gemm_phase<EpiDown, GroupedOrder, true, true, true>(lds, g, S, E);
        }
        SEAM(pb + 7);
        if (IN(pb + 8)) {
            PH_IDS(); DEF_WS();
            const float* g1n = A->in[6] + (has_next ? (l + 1) * DM : 0); const float* modn = mod + (size_t)(has_next ? l + 1 : l) * 17 * NMOD * DM;
            const int ngr = nmoe >> 2, gpw = (ngr + NGW - 1) / NGW, g0 = gw * gpw, g1 = (g0 + gpw < ngr) ? g0 + gpw : ngr;
            i32x4 sl4n[4];
            if (g0 < g1) {
#pragma unroll
                for (int r = 0; r < 4; ++r) sl4n[r] = *(const i32x4*)(SLOTOF + (size_t)(g0 * 4 + r) * 4);
            }
            f32x4 gt[4], gm[4], sv[4];
            int bcur = -1;
            for (int grp = g0; grp < g1; ++grp) {
                const int row0 = grp * 4;
                const int b = row0 < TL ? (row0 >> 12) : 16;
                const int col = lane * 8;
                i32x4 sl4[4];
#pragma unroll
                for (int r = 0; r < 4; ++r) sl4[r] = sl4n[r];
                if (grp + 1 < g1) {
#pragma unroll
                    for (int r = 0; r < 4; ++r) sl4n[r] = *(const i32x4*)(SLOTOF + (size_t)(row0 + 4 + r) * 4);
                }
                u32x4 xb[4][2];
#pragma unroll
                for (int r = 0; r < 4; ++r) { xb[r][0] = *(const u32x4*)(X1 + (size_t)(row0 + r) * DM + col); xb[r][1] = *(const u32x4*)(X1 + (size_t)(row0 + r) * DM + 512 + col); }
                if (b != bcur) { bcur = b;
                    const float* gp = modl + (size_t)b * (NMOD * DM) + 5 * DM;
#pragma unroll
                    for (int q = 0; q < 4; ++q) gt[q] = *(const f32x4*)(gp + (q >> 1) * 512 + col + 4 * (q & 1)) * Y8_INV;
                    if (has_next) { const float* sh = modn + (size_t)b * (NMOD * DM); const float* sc = sh + DM;
#pragma unroll
                        for (int q = 0; q < 4; ++q) { const int cq = (q >> 1) * 512 + col + 4 * (q & 1); gm[q] = *(const f32x4*)(g1n + cq) * (*(const f32x4*)(sc + cq) + 1.0f); sv[q] = *(const f32x4*)(sh + cq); } }
                }
                u32x2 yv[4][4][2];
#pragma unroll
                for (int r = 0; r < 4; ++r)
#pragma unroll
                    for (int k = 0; k < 4; ++k) { yv[r][k][0] = *(const u32x2*)((const unsigned char*)Y + (size_t)sl4[r][k] * DM + col); yv[r][k][1] = *(const u32x2*)((const unsigned char*)Y + (size_t)sl4[r][k] * DM + 512 + col); }
#pragma unroll
                for (int r = 0; r < 4; ++r) {
                    const int row = row0 + r;
                    float* op = row < TL ? out + (size_t)row * DM : X2C + (size_t)(row - TL) * DM;
                    f32x4 a[4];
#pragma unroll
                    for (int q = 0; q < 4; ++q) a[q] = (f32x4){0.f, 0.f, 0.f, 0.f};
#pragma unroll
                    for (int k = 0; k < 4; ++k)
#pragma unroll
                        for (int q = 0; q < 4; ++q) { const unsigned y = yv[r][k][q >> 1][q & 1]; const auto lo = __builtin_amdgcn_cvt_pk_f32_fp8((int)y, false), hi = __builtin_amdgcn_cvt_pk_f32_fp8((int)y, true); a[q] += (f32x4){lo[0], lo[1], hi[0], hi[1]}; }
                    f32x4 xo[4]; float ss = 0.f;
#pragma unroll
                    for (int q = 0; q < 4; ++q) {
                        xo[q] = (f32x4){bflo(xb[r][q >> 1][(q & 1) * 2]), bfhi(xb[r][q >> 1][(q & 1) * 2]), bflo(xb[r][q >> 1][(q & 1) * 2 + 1]), bfhi(xb[r][q >> 1][(q & 1) * 2 + 1])} + gt[q] * a[q];
                        if (!has_next) *(f32x4*)(op + (q >> 1) * 512 + col + 4 * (q & 1)) = xo[q];
                    }
                    if (has_next) { *(u32x4*)((bf16*)ACT + (size_t)row * DM + col) = pack8(xo[0], xo[1]); *(u32x4*)((bf16*)ACT + (size_t)row * DM + 512 + col) = pack8(xo[2], xo[3]); }
                    if (has_next) {
#pragma unroll
                        for (int q = 0; q < 4; ++q) ss += (xo[q].x * xo[q].x + xo[q].y * xo[q].y) + (xo[q].z * xo[q].z + xo[q].w * xo[q].w);
                        const float rstd = __builtin_amdgcn_rsqf(wave_sum(ss) * (1.0f / DM) + EPS);
                        f32x4 y[4];
#pragma unroll
                        for (int q = 0; q < 4; ++q) y[q] = (xo[q] * rstd) * gm[q] + sv[q];
                        *(u32x4*)(H + (size_t)row * DM + col) = pack8(y[0], y[1]); *(u32x4*)(H + (size_t)row * DM + 512 + col) = pack8(y[2], y[3]);
                    }
                }
            }
        }
        SEAM(pb + 8);
    }
    { constexpr int l = 1;
        const int pb = 1 + 9 * l; const bool has_next = l + 1 < DEPTH;
        const int nmoe = has_next ? TT : TL;

        if (IN(pb + 0) && l == 0) {
            PH_IDS(); DEF_WS(); const float* g = A->in[6] + l * DM;
            f32x4 vn[2][4];
            if (gw * 2 < TT) {
#pragma unroll
                for (int r = 0; r < 2; ++r) { const int row = gw * 2 + r; const float* src = row < TL ? xl + (size_t)row * DM : xc + (size_t)(row - TL) * DM;
#pragma unroll
                    for (int jj = 0; jj < 2; ++jj) { const int col = (lane + 64 * jj) * 8; vn[r][2 * jj] = *(const f32x4*)(src + col); vn[r][2 * jj + 1] = *(const f32x4*)(src + col + 4); } }
            }
            for (int row0 = gw * 2; row0 < TT; row0 += NGW * 2) {
                f32x4 v[2][4]; float ss[2];
#pragma unroll
                for (int r = 0; r < 2; ++r)
#pragma unroll
                    for (int j = 0; j < 4; ++j) v[r][j] = vn[r][j];
                if (row0 + NGW * 2 < TT) {
#pragma unroll
                    for (int r = 0; r < 2; ++r) { const int row = row0 + NGW * 2 + r; const float* src = row < TL ? xl + (size_t)row * DM : xc + (size_t)(row - TL) * DM;
#pragma unroll
                        for (int jj = 0; jj < 2; ++jj) { const int col = (lane + 64 * jj) * 8; vn[r][2 * jj] = *(const f32x4*)(src + col); vn[r][2 * jj + 1] = *(const f32x4*)(src + col + 4); } }
                }
#pragma unroll
                for (int r = 0; r < 2; ++r) {
                    const int row = row0 + r; ss[r] = 0.f;
#pragma unroll
                    for (int jj = 0; jj < 2; ++jj) { const int col = (lane + 64 * jj) * 8;
                        *(u32x4*)((bf16*)ACT + (size_t)row * DM + col) = pack8(v[r][2 * jj], v[r][2 * jj + 1]); }
                }
#pragma unroll
                for (int r = 0; r < 2; ++r) {
                    const int row = row0 + r; const int b = row < TL ? (row >> 12) : 16;
                    const float* sh = modl + (size_t)b * (NMOD * DM); const float* sc = sh + DM;
#pragma unroll
                    for (int j = 0; j < 4; ++j) ss[r] += (v[r][j].x * v[r][j].x + v[r][j].y * v[r][j].y) + (v[r][j].z * v[r][j].z + v[r][j].w * v[r][j].w);
                    const float rstd = __builtin_amdgcn_rsqf(wave_sum(ss[r]) * (1.0f / DM) + EPS);
#pragma unroll
                    for (int jj = 0; jj < 2; ++jj) {
                        const int col = (lane + 64 * jj) * 8; f32x4 y[2];
#pragma unroll
                        for (int h = 0; h < 2; ++h) y[h] = (v[r][2 * jj + h] * rstd) * *(const f32x4*)(g + col + 4 * h) * (*(const f32x4*)(sc + col + 4 * h) + 1.0f) + *(const f32x4*)(sh + col + 4 * h);
                        *(u32x4*)(H + (size_t)row * DM + col) = pack8(y[0], y[1]);
                    }
                }
            }
        }
        if (l == 0)
        SEAM(pb + 0);
        if (IN(pb + 1)) {
            PH_IDS(); DEF_WS(); const float* q_norm_g = A->in[9]; const float* k_norm_g = A->in[10];
            pg8::Gemm g{H, Win + (size_t)l * INW * DM, TT, INW, DM, 0}; InprojOrder S; S.init(has_next ? 10 : 4, G, bx);
            { PG8_LAS float* tb = (PG8_LAS float*)(lds + LDS_EPI);
              for (int i = tid; i < 1088; i += NTHR) tb[i] = i < 512 ? ropeC[i] : (i < 1024 ? ropeS[i - 512] : (i < 1056 ? q_norm_g[l * 32 + i - 1024] : k_norm_g[l * 32 + i - 1056]));
              __syncthreads(); }
            EpiInproj E{Qb, Qcb, Kb, Vb, CPU, (const PG8_LAS float*)(lds + LDS_EPI)};
            pg8::gemm_phase<EpiInproj, InprojOrder, true, true>(lds, g, S, E);
        }
        SEAM(pb + 1);
        if (IN(pb + 2)) {
            PH_IDS(); DEF_WS(); const float* subln_g = A->in[15]; const float* conv_w = A->in[16];
            {
                const float lam = scal[2 * l], oscale = 1.0f - scal[2 * l + 1]; const float* sg = subln_g + l * 64;
                const int vcu = (G % 8 == 0) ? (bx % 8) * (G / 8) + bx / 8 : bx;
                const int nunits = 2048 + (has_next ? 128 : 0);
                int xwb = gw;
                for (int u = vcu; u < nunits; u += G) {
                    const bool latq = u < 2048; const int i = u >> 8, v = u & 255;
                    const int bh = latq ? (v >> 5) * 16 + i * 2 + ((v & 31) >> 4) : u - 2048, qb = latq ? (v & 15) : 0;
                    const bf16* Qu = latq ? Qb + (size_t)bh * SEQ * 64 : Qcb + (size_t)bh * CTXL * 64;
                    bf16* mp = MIX + (latq ? ((size_t)(bh >> 3) * SEQ + qb * 256) : ((size_t)TL + (bh >> 3) * CTXL)) * DM + (bh & 7) * 64;
                    XwMid mid; mid.setup(l, xwb, A->in[22], A->in[24], (unsigned char*)Wgu, (unsigned char*)Wdn, lane);
                    fa::attn_unit(mid, lds, Qu, Kb + (size_t)bh * NKEY * 64, Vb + (size_t)bh * NKEY * 64, qb * 256, latq ? NKEY / 64 : CTXL / 64, lam, oscale, sg, mp, tid);
                    if (xwb < XW_BATCHES) xwb += NGW;
                }
                for (; xwb < XW_BATCHES; xwb += NGW) expert_weight_batch(l, xwb, A->in[22], A->in[24], (unsigned char*)Wgu, (unsigned char*)Wdn, lane);
            }
            {
                const int nrows = has_next ? TT : TL; const float* cw = conv_w + l * 768;
                for (int row0 = gw * 4; row0 < nrows; row0 += NGW * 4) {
                    const bool lat = row0 < TL; const int pos0 = lat ? (row0 & 4095) : ((row0 - TL) & 255), len = lat ? SEQ : CTXL;
                    const bf16* prow = CPU + (size_t)row0 * 768;
                    const bool cv = lane < 32; const int ch = (lane & 31) * 8, half = cv ? 1 : 1 << ((lane - 32) >> 3);
                    const int off0 = half, nk = cv ? 6 : 2 * half + 3, colA = cv ? ch : 512 + ch, colB = cv ? 256 + ch : 512 + ch;
                    u32x4 v[23];
#pragma unroll
                    for (int r = 0; r < 4; ++r) v[r] = *(const u32x4*)(prow + (size_t)r * 768 + colA);
#pragma unroll
                    for (int k = 0; k < 19; ++k) { const int ro = k - off0, p = pos0 + ro; v[4 + k] = (u32x4){0u, 0u, 0u, 0u}; if (k < nk && p >= 0 && p < len) v[4 + k] = *(const u32x4*)(prow + (long)ro * 768 + colB); }
                    if (cv) {
                        f32x4 w0[2], w1[2], w2[2];
#pragma unroll
                        for (int hh = 0; hh < 2; ++hh) { w0[hh] = *(const f32x4*)(cw + ch + 4 * hh); w1[hh] = *(const f32x4*)(cw + 256 + ch + 4 * hh); w2[hh] = *(const f32x4*)(cw + 512 + ch + 4 * hh); }
#pragma unroll
                        for (int r = 0; r < 4; ++r) {
                            f32x4 o[2];
#pragma unroll
                            for (int hh = 0; hh < 2; ++hh) {
                                const f32x4 m = (f32x4){bflo(v[4 + r][2 * hh]), bfhi(v[4 + r][2 * hh]), bflo(v[4 + r][2 * hh + 1]), bfhi(v[4 + r][2 * hh + 1])};
                                const f32x4 c = (f32x4){bflo(v[5 + r][2 * hh]), bfhi(v[5 + r][2 * hh]), bflo(v[5 + r][2 * hh + 1]), bfhi(v[5 + r][2 * hh + 1])};
                                const f32x4 p = (f32x4){bflo(v[6 + r][2 * hh]), bfhi(v[6 + r][2 * hh]), bflo(v[6 + r][2 * hh + 1]), bfhi(v[6 + r][2 * hh + 1])};
                                const f32x4 b = (f32x4){bflo(v[r][2 * hh]), bfhi(v[r][2 * hh]), bflo(v[r][2 * hh + 1]), bfhi(v[r][2 * hh + 1])};
                                o[hh] = b * (w0[hh] * m + w1[hh] * c + w2[hh] * p);
                            }
                            *(u32x4*)(MIX + (size_t)(row0 + r) * DM + 512 + ch) = pack8(o[0], o[1]);
                        }
                    } else {
                        f32x4 s0[4], s1[4];
#pragma unroll
                        for (int r = 0; r < 4; ++r) { s0[r] = (f32x4){0.f, 0.f, 0.f, 0.f}; s1[r] = (f32x4){0.f, 0.f, 0.f, 0.f}; }
#pragma unroll
                        for (int u = 0; u < 19; ++u) {
                            const u32x4 x = v[4 + u];
                            const f32x4 a0 = (f32x4){bflo(x.x), bfhi(x.x), bflo(x.y), bfhi(x.y)}, a1 = (f32x4){bflo(x.z), bfhi(x.z), bflo(x.w), bfhi(x.w)};
#pragma unroll
                            for (int r = 0; r < 4; ++r) { const bool in = (u >= r) && (u < r + 2 * half); const float m = in ? 1.0f : 0.0f; s0[r] += a0 * m; s1[r] += a1 * m; }
                        }
#pragma unroll
                        for (int r = 0; r < 4; ++r) {
                            const int pos = pos0 + r; const int cnt = min(pos + half, len) - max(pos - half, 0);
                            const u32x4 uc = v[r]; const float inv = __builtin_amdgcn_rcpf((float)cnt);
                            const f32x4 d0 = s0[r] * inv - (f32x4){bflo(uc.x), bfhi(uc.x), bflo(uc.y), bfhi(uc.y)}, d1 = s1[r] * inv - (f32x4){bflo(uc.z), bfhi(uc.z), bflo(uc.w), bfhi(uc.w)};
                            *(u32x4*)(MIX + (size_t)(row0 + r) * DM + 768 + ch) = pack8(d0, d1);
                        }
                    }
                }
            }
        }
        SEAM(pb + 2);
        if (IN(pb + 3)) {
            PH_IDS(); DEF_WS();
            const int M = has_next ? TT : TL;
            pg8::Gemm g{MIX, Wout + (size_t)l * DM * DM, M, DM, DM, 0}; PlainOrder S; S.init(M, DM, G, bx);
            EpiResid E{(const bf16*)ACT, modl + 2 * DM, X1, lds};
            pg8::gemm_phase<EpiResid, PlainOrder, true, true>(lds, g, S, E);
        }
        SEAM(pb + 3);
        if (IN(pb + 4)) {
            PH_IDS(); DEF_WS(); const float* router_b = A->in[21]; const float* norm2_g = A->in[7];
            const bf16* wrt_hi = WSP(bf16, WS_WRT) + (size_t)l * 65536; const bf16* wrt_lo = wrt_hi + 32768;
            const float* br = router_b + l * NEXP; const float* g = norm2_g + l * DM;
            constexpr int TP = 2064;
            LAS unsigned char* Thi = lds; LAS unsigned char* Tlo = lds + 32 * TP; LAS unsigned char* PART = lds + 64 * TP; LAS float* LOG = (LAS float*)(lds + 64 * TP + 4096);
            static_assert(64 * TP + 8192 <= LDS_CTL, "router LDS map");
            const int eh = wave & 1, rh = (wave >> 1) & 1, kh = wave >> 2, n16 = lane & 15, q4 = lane >> 4;
            fa::bf16x8 ah[16];
#pragma unroll
            for (int st = 0; st < 16; ++st) { const int k = kh * 512 + 32 * st + 8 * q4;
                ah[st] = *(const fa::bf16x8*)(wrt_hi + (eh * 16 + n16) * DM + k); }
            const bf16* alp = wrt_lo + (eh * 16 + n16) * DM + kh * 512 + 8 * q4;
            const f32x4 brv = *(const f32x4*)(br + eh * 16 + 4 * q4);
            if (tid < 32) lctl[tid] = 0;
            __syncthreads();
            u32x4 xq[4][2];
            if (bx < nmoe / 32) {
#pragma unroll
                for (int rr = 0; rr < 4; ++rr)
#pragma unroll
                    for (int j = 0; j < 2; ++j) xq[rr][j] = *(const u32x4*)(X1 + (size_t)(bx * 32 + wave * 4 + rr) * DM + lane * 16 + 8 * j);
            }
            for (int grp = bx; grp < nmoe / 32; grp += G) {
                const int row0 = grp * 32; const int b = row0 < TL ? (row0 >> 12) : 16;
                const float* sh = modl + (size_t)b * (NMOD * DM) + 3 * DM; const float* sc = sh + DM;
                const int col = lane * 16;
                f32x4 gm[4], sv[4];
#pragma unroll
                for (int j = 0; j < 4; ++j) { gm[j] = *(const f32x4*)(g + col + 4 * j) * (*(const f32x4*)(sc + col + 4 * j) + 1.0f); sv[j] = *(const f32x4*)(sh + col + 4 * j); }
#pragma unroll
                for (int rr = 0; rr < 4; ++rr) {
                    const int rl = wave * 4 + rr, row = row0 + rl; f32x4 v[4]; float ss = 0.f;
#pragma unroll
                    for (int j = 0; j < 2; ++j) { const u32x4 xb = xq[rr][j]; v[2 * j] = (f32x4){bflo(xb.x), bfhi(xb.x), bflo(xb.y), bfhi(xb.y)}; v[2 * j + 1] = (f32x4){bflo(xb.z), bfhi(xb.z), bflo(xb.w), bfhi(xb.w)}; }
#pragma unroll
                    for (int j = 0; j < 4; ++j) ss += (v[j].x * v[j].x + v[j].y * v[j].y) + (v[j].z * v[j].z + v[j].w * v[j].w);
                    const float rstd = __builtin_amdgcn_rsqf(wave_sum(ss) * (1.0f / DM) + EPS);
                    u32x4 h8, hiw[2], low[2];
#pragma unroll
                    for (int j = 0; j < 4; ++j) {
                        const f32x4 h = (v[j] * rstd) * gm[j] + sv[j];
                        h8[j] = pk4_fp8(h.x, h.y, h.z, h.w);
                        const unsigned h0 = pg8::cvt_pk_bf16(h.x, h.y), h1 = pg8::cvt_pk_bf16(h.z, h.w);
                        hiw[j >> 1][2 * (j & 1)] = h0; hiw[j >> 1][2 * (j & 1) + 1] = h1;
                        low[j >> 1][2 * (j & 1)] = pg8::cvt_pk_bf16(h.x - bflo(h0), h.y - bfhi(h0)); low[j >> 1][2 * (j & 1) + 1] = pg8::cvt_pk_bf16(h.z - bflo(h1), h.w - bfhi(h1));
                    }
                    *(u32x4*)((unsigned char*)H + (size_t)row * DM + col) = h8;
#pragma unroll
                    for (int j = 0; j < 2; ++j) { *(LAS u32x4*)(Thi + rl * TP + col * 2 + 16 * j) = hiw[j]; *(LAS u32x4*)(Tlo + rl * TP + col * 2 + 16 * j) = low[j]; }
                }
                __syncthreads();
                if (grp + G < nmoe / 32) {
#pragma unroll
                    for (int rr = 0; rr < 4; ++rr)
#pragma unroll
                        for (int j = 0; j < 2; ++j) xq[rr][j] = *(const u32x4*)(X1 + (size_t)((grp + G) * 32 + wave * 4 + rr) * DM + lane * 16 + 8 * j);
                }
                f32x4 acc = (f32x4){0.f, 0.f, 0.f, 0.f};
#pragma unroll
                for (int st = 0; st < 16; ++st) {
                    const int kb = (kh * 512 + 32 * st + 8 * q4) * 2;
                    const fa::bf16x8 bh = *(const LAS fa::bf16x8*)(Thi + (rh * 16 + n16) * TP + kb), bl = *(const LAS fa::bf16x8*)(Tlo + (rh * 16 + n16) * TP + kb);
                    acc = __builtin_amdgcn_mfma_f32_16x16x32_bf16(ah[st], bh, acc, 0, 0, 0);
                    acc = __builtin_amdgcn_mfma_f32_16x16x32_bf16(ah[st], bl, acc, 0, 0, 0);
                    acc = __builtin_amdgcn_mfma_f32_16x16x32_bf16(*(const fa::bf16x8*)(alp + 32 * st), bh, acc, 0, 0, 0);
                }
                if (kh == 1) *(LAS f32x4*)(PART + (wave & 3) * 1024 + lane * 16) = acc;
                __syncthreads();
                if (kh == 0) { acc += *(const LAS f32x4*)(PART + (wave & 3) * 1024 + lane * 16); acc += brv; *(LAS f32x4*)(LOG + (rh * 16 + n16) * 32 + eh * 16 + 4 * q4) = acc; }
                __syncthreads();
                {
                    const int rr = lane >> 4, j16 = lane & 15, rl = wave * 4 + rr, tok = row0 + rl;
                    const f32x2v xx = *(const LAS f32x2v*)(LOG + rl * 32 + 2 * j16);
                    float x0 = xx[0], x1 = xx[1];
                    float bv[4]; int be[4];
#pragma unroll
                    for (int k = 0; k < 4; ++k) {
                        float v = x0 >= x1 ? x0 : x1; int e = x0 >= x1 ? 2 * j16 : 2 * j16 + 1;
#define TOP_STEP(CTRL) { const float v2 = dpp_movf<CTRL>(v); const int e2 = dpp_movi<CTRL>(e); const bool tk = (v2 > v) || (v2 == v && e2 < e); v = tk ? v2 : v; e = tk ? e2 : e; }
                        TOP_STEP(0xB1) TOP_STEP(0x4E) TOP_STEP(0x141) TOP_STEP(0x140)
#undef TOP_STEP
                        bv[k] = v; be[k] = e;
                        if (e == 2 * j16) x0 = -3.0e38f;
                        if (e == 2 * j16 + 1) x1 = -3.0e38f;
                    }
                    float pe[4], sm = 0.f;
#pragma unroll
                    for (int k = 0; k < 4; ++k) { pe[k] = __builtin_amdgcn_exp2f((bv[k] - bv[0]) * 1.4426950408889634f); sm += pe[k]; }
                    if (j16 < 4) {
                        const int ek = j16 == 0 ? be[0] : j16 == 1 ? be[1] : j16 == 2 ? be[2] : be[3]; const float pk = j16 == 0 ? pe[0] : j16 == 1 ? pe[1] : j16 == 2 ? pe[2] : pe[3];
                        const int rank = atomicAdd((int*)(lctl + ek), 1);
                        ASGE[(size_t)tok * 4 + j16] = ek | (rank << 8); ASGW[(size_t)tok * 4 + j16] = pk * __builtin_amdgcn_rcpf(sm);
                    }
                }
            }
            __syncthreads();
            if (tid < 32) wgcnt[bx * 32 + tid] = lctl[tid];
        }
        SEAM(pb + 4);
        if (IN(pb + 5)) {
            PH_IDS(); DEF_WS();
            {
                LAS int* sc = (LAS int*)lds; const int e = tid & 31, part = tid >> 5, per = (G + 15) >> 4;
                int tot = 0, off = 0;
                for (int j = 0; j < per; ++j) { const int w = part * per + j; if (w < G) { const int cc = wgcnt[w * 32 + e]; tot += cc; if (w < bx) off += cc; } }
                sc[part * 32 + e] = tot; sc[512 + part * 32 + e] = off;
                __syncthreads();
                if (tid < 32) { int t2 = 0, o2 = 0;
#pragma unroll
                    for (int p = 0; p < 16; ++p) { t2 += sc[p * 32 + tid]; o2 += sc[512 + p * 32 + tid]; }
                    lctl[96 + tid] = t2; lctl[64 + tid] = o2; }
            }
            __syncthreads();
            if (tid == 0) {
                int blk = 0;
                for (int e = 0; e < NEXP; ++e) { lctl[32 + e] = blk * 256; blk += (lctl[96 + e] + 255) >> 8; }
                *(LAS int*)(lds + LDS_NBLK) = blk;
                if (bx == 0) ctll[CTL_NBLK] = blk;
            }
            __syncthreads();
            if (tid < NEXP) { const int b0 = lctl[32 + tid] >> 8, nb = (lctl[96 + tid] + 255) >> 8; for (int j = 0; j < nb; ++j) (lds + LDS_BTE)[b0 + j] = (unsigned char)tid; }
            if (bx == 0 && tid < NEXP) { const int b0 = lctl[32 + tid] >> 8, nb = (lctl[96 + tid] + 255) >> 8; for (int j = 0; j < nb; ++j) ctll[CTL_BLKE + b0 + j] = tid; }
            for (int e = bx; e < NEXP; e += G) {
                const int beg = lctl[32 + e] + lctl[96 + e], end = lctl[32 + e] + (((lctl[96 + e] + 255) >> 8) << 8);
                for (int s = beg + tid; s < end; s += NTHR) { ROWTOK[s] = 0; ROWW[s] = 0.f; }
            }
            {
                const int ng = bx < nmoe / 32 ? (nmoe / 32 - bx + G - 1) / G : 0;
                for (int idx = tid; idx < ng * 128; idx += NTHR) {
                    const int grp = bx + (idx >> 7) * G, t7 = idx & 127;
                    const int tok = grp * 32 + (t7 >> 2), k = t7 & 3; const int ev = ASGE[(size_t)tok * 4 + k], e = ev & 255, rank = ev >> 8;
                    const int slot = lctl[32 + e] + lctl[64 + e] + rank;
                    ROWTOK[slot] = tok; ROWW[slot] = ASGW[(size_t)tok * 4 + k]; SLOTOF[(size_t)tok * 4 + k] = slot;
                }
            }
        }
        SEAM(pb + 5);
        if (IN(pb + 6)) {
            PH_IDS(); DEF_WS(); const float* b_gu = A->in[23];
            pg8::Gemm g{H, (const bf16*)((const unsigned char*)Wgu + (size_t)l * NEXP * 2048 * DM), 0, 2048, DM / 2, 0}; GroupedOrder S; S.init(lds, 8, 2048, G, bx, ROWTOK);
            EpiSwiglu E{ctll, b_gu + (size_t)l * NEXP * 2048, (unsigned char*)ACT, lds};
            pg8::gemm_phase<EpiSwiglu, GroupedOrder, true, true, true, true>(lds, g, S, E);
        }
        SEAM(pb + 6);
        if (IN(pb + 7)) {
            PH_IDS(); DEF_WS(); const float* b_dn = A->in[25];
            pg8::Gemm g{ACT, (const bf16*)((const unsigned char*)Wdn + (size_t)l * NEXP * DM * DM), 0, DM, DM / 2, 0}; GroupedOrder S; S.init(lds, 4, 1024, G, bx);
            EpiDown E{ctll, b_dn + (size_t)l * NEXP * DM, ROWW, (unsigned char*)Y, lds};
            pg8::gemm_phase<EpiDown, GroupedOrder, true, true, true>(lds, g, S, E);
        }
        SEAM(pb + 7);
        if (IN(pb + 8)) {
            PH_IDS(); DEF_WS();
            const float* g1n = A->in[6] + (has_next ? (l + 1) * DM : 0); const float* modn = mod + (size_t)(has_next ? l + 1 : l) * 17 * NMOD * DM;
            const int ngr = nmoe >> 2, gpw = (ngr + NGW - 1) / NGW, g0 = gw * gpw, g1 = (g0 + gpw < ngr) ? g0 + gpw : ngr;
            i32x4 sl4n[4];
            if (g0 < g1) {
#pragma unroll
                for (int r = 0; r < 4; ++r) sl4n[r] = *(const i32x4*)(SLOTOF + (size_t)(g0 * 4 + r) * 4);
            }
            f32x4 gt[4], gm[4], sv[4];
            int bcur = -1;
            for (int grp = g0; grp < g1; ++grp) {
                const int row0 = grp * 4;
                const int b = row0 < TL ? (row0 >> 12) : 16;
                const int col = lane * 8;
                i32x4 sl4[4];
#pragma unroll
                for (int r = 0; r < 4; ++r) sl4[r] = sl4n[r];
                if (grp + 1 < g1) {
#pragma unroll
                    for (int r = 0; r < 4; ++r) sl4n[r] = *(const i32x4*)(SLOTOF + (size_t)(row0 + 4 + r) * 4);
                }
                u32x4 xb[4][2];
#pragma unroll
                for (int r = 0; r < 4; ++r) { xb[r][0] = *(const u32x4*)(X1 + (size_t)(row0 + r) * DM + col); xb[r][1] = *(const u32x4*)(X1 + (size_t)(row0 + r) * DM + 512 + col); }
                if (b != bcur) { bcur = b;
                    const float* gp = modl + (size_t)b * (NMOD * DM) + 5 * DM;
#pragma unroll
                    for (int q = 0; q < 4; ++q) gt[q] = *(const f32x4*)(gp + (q >> 1) * 512 + col + 4 * (q & 1)) * Y8_INV;
                    if (has_next) { const float* sh = modn + (size_t)b * (NMOD * DM); const float* sc = sh + DM;
#pragma unroll
                        for (int q = 0; q < 4; ++q) { const int cq = (q >> 1) * 512 + col + 4 * (q & 1); gm[q] = *(const f32x4*)(g1n + cq) * (*(const f32x4*)(sc + cq) + 1.0f); sv[q] = *(const f32x4*)(sh + cq); } }
                }
                u32x2 yv[4][4][2];
#pragma unroll
                for (int r = 0; r < 4; ++r)
#pragma unroll
                    for (int k = 0; k < 4; ++k) { yv[r][k][0] = *(const u32x2*)((const unsigned char*)Y + (size_t)sl4[r][k] * DM + col); yv[r][k][1] = *(const u32x2*)((const unsigned char*)Y + (size_t)sl4[r][k] * DM + 512 + col); }
#pragma unroll
                for (int r = 0; r < 4; ++r) {
                    const int row = row0 + r;
                    float* op = row < TL ? out + (size_t)row * DM : X2C + (size_t)(row - TL) * DM;
                    f32x4 a[4];
#pragma unroll
                    for (int q = 0; q < 4; ++q) a[q] = (f32x4){0.f, 0.f, 0.f, 0.f};
#pragma unroll
                    for (int k = 0; k < 4; ++k)
#pragma unroll
                        for (int q = 0; q < 4; ++q) { const unsigned y = yv[r][k][q >> 1][q & 1]; const auto lo = __builtin_amdgcn_cvt_pk_f32_fp8((int)y, false), hi = __builtin_amdgcn_cvt_pk_f32_fp8((int)y, true); a[q] += (f32x4){lo[0], lo[1], hi[0], hi[1]}; }
                    f32x4 xo[4]; float ss = 0.f;
#pragma unroll
                    for (int q = 0; q < 4; ++q) {
                        xo[q] = (f32x4){bflo(xb[r][q >> 1][(q & 1) * 2]), bfhi(xb[r][q >> 1][(q & 1) * 2]), bflo(xb[r][q >> 1][(q & 1) * 2 + 1]), bfhi(xb[r][q >> 1][(q & 1) * 2 + 1])} + gt[q] * a[q];
                        if (!has_next) *(f32x4*)(op + (q >> 1) * 512 + col + 4 * (q & 1)) = xo[q];
                    }
                    if (has_next) { *(u32x4*)((bf16*)ACT + (size_t)row * DM + col) = pack8(xo[0], xo[1]); *(u32x4*)((bf16*)ACT + (size_t)row * DM + 512 + col) = pack8(xo[2], xo[3]); }
                    if (has_next) {
#pragma unroll
                        for (int q = 0; q < 4; ++q) ss += (xo[q].x * xo[q].x + xo[q].y * xo[q].y) + (xo[q].z * xo[q].z + xo[q].w * xo[q].w);
                        const float rstd = __builtin_amdgcn_rsqf(wave_sum(ss) * (1.0f / DM) + EPS);
                        f32x4 y[4];
#pragma unroll
                        for (int q = 0; q < 4; ++q) y[q] = (xo[q] * rstd) * gm[q] + sv[q];
                        *(u32x4*)(H + (size_t)row * DM + col) = pack8(y[0], y[1]); *(u32x4*)(H + (size_t)row * DM + 512 + col) = pack8(y[2], y[3]);
                    }
                }
            }
        }
        SEAM(pb + 8);
    }
#undef IN
#undef SEAM
}

#ifndef MK_SPLIT
#define MK_SPLIT 0
#endif
extern "C" void kernel_launch(void* const* d_in, const int* in_sizes, int n_in, void* d_out, int out_size, void* d_ws, size_t ws_size, hipStream_t stream) {
    static int grid = 0;
    if (grid == 0) {
        if (n_in != 26 || ws_size < WS_END) { fprintf(stderr, "kernel_launch: need 26 inputs and %zu bytes of workspace (got %d, %zu)\n", (size_t)WS_END, n_in, ws_size); grid = -1; return; }
        int dev = 0, cus = 0, per_cu = 0;
        if (hipGetDevice(&dev) != hipSuccess || hipDeviceGetAttribute(&cus, hipDeviceAttributeMultiprocessorCount, dev) != hipSuccess) { grid = -1; return; }
        if (hipFuncSetAttribute((const void*)mk_fwd, hipFuncAttributeMaxDynamicSharedMemorySize, LDS_BYTES) != hipSuccess) { fprintf(stderr, "kernel_launch: hipFuncSetAttribute failed\n"); grid = -1; return; }
        if (hipOccupancyMaxActiveBlocksPerMultiprocessor(&per_cu, (const void*)mk_fwd, NTHR, LDS_BYTES) != hipSuccess || per_cu < 1) { fprintf(stderr, "kernel_launch: occupancy query says %d\n", per_cu); }
        (void)hipGetLastError();
        grid = cus;
    }
    if (grid < 0) return;
#if MK_SPLIT
    (void)hipMemsetAsync((char*)d_ws + WS_CTL, 0, 1 * MiB, stream);
#else
    (void)hipMemsetAsync((char*)d_ws + WS_CTL + (size_t)CTL_BAR * 4, 0, 16384, stream);
#endif
    Args a; memset(&a, 0, sizeof(a));
    for (int i = 0; i < 26; ++i) a.in[i] = (const float*)d_in[i];
    a.out = (float*)d_out; a.ws = (unsigned char*)d_ws;
#if MK_SPLIT
    for (int p = 0; p < NPHASE; ++p) { a.ph_lo = p; a.ph_hi = p + 1; a.bar_region = p; hipLaunchKernelGGL(mk_fwd, dim3(grid), dim3(NTHR), LDS_BYTES, stream, a); }
#else
    a.ph_lo = 0; a.ph_hi = NPHASE; a.bar_region = 0;
    hipLaunchKernelGGL(mk_fwd, dim3(grid), dim3(NTHR), LDS_BYTES, stream, a);
#endif
}
```
